# Optimizing an MI355X kernel written in HIP

```python
import jax, jax.numpy as jnp
from jax import lax
import numpy as np

D_MODEL = 1024
BATCH = 2
SEQ = 8192
DEPTH = 2

CHUNK = 64
N_META = 16
D_CONV = D_MODEL
CONV_W = 3
N_FOX_HEADS = 16
FOX_HEAD_DIM = 64
D_ATT = N_FOX_HEADS * FOX_HEAD_DIM
N_GROUPS = 4
EXPERTS_PER_GROUP = 8
N_EXPERTS = N_GROUPS * EXPERTS_PER_GROUP
TOP_K_IN_GROUP = 2
D_EXPERT = 512
Q_BLOCK = 128
MOE_BLOCK = 128
EPS = 1e-6
SPLIT_SIZES = (D_CONV, D_CONV, D_CONV, D_ATT, D_ATT, D_ATT, N_FOX_HEADS, D_MODEL, D_MODEL)
IN_COLS = sum(SPLIT_SIZES)

kernel_name = "hybrid_conv_fox_hiermoe_block"


def rms_norm(x, g):
    xf = x.astype(jnp.float32)
    y = xf * lax.rsqrt(jnp.mean(xf * xf, axis=-1, keepdims=True) + EPS)
    return (y * g.astype(jnp.float32)).astype(x.dtype)


def short_gated_conv(b_gate, c_gate, u, conv_w):
    z = c_gate * u
    L = z.shape[1]
    zp = jnp.pad(z, ((0, 0), (CONV_W - 1, 0), (0, 0)))
    y = zp[:, 0:L] * conv_w[0]
    for i in range(1, CONV_W):
        y = y + zp[:, i:i + L] * conv_w[i]
    return b_gate * y


def forgetting_attention(q, k, v, f_logit, q_g, k_g):
    Bn, L, H, hd = q.shape
    q = rms_norm(q, q_g)
    k = rms_norm(k, k_g)
    c = jnp.cumsum(jax.nn.log_sigmoid(f_logit.astype(jnp.float32)), axis=1)
    n_blk = -(-L // Q_BLOCK)
    Lp = n_blk * Q_BLOCK
    pad = Lp - L
    q = jnp.pad(q, ((0, 0), (0, pad), (0, 0), (0, 0)))
    k = jnp.pad(k, ((0, 0), (0, pad), (0, 0), (0, 0)))
    v = jnp.pad(v, ((0, 0), (0, pad), (0, 0), (0, 0)))
    c = jnp.pad(c, ((0, 0), (0, pad), (0, 0)), mode="edge")
    c_k = c.transpose(0, 2, 1)
    q_blocks = q.reshape(Bn, n_blk, Q_BLOCK, H, hd).transpose(1, 0, 2, 3, 4)
    c_blocks = c.reshape(Bn, n_blk, Q_BLOCK, H).transpose(1, 0, 3, 2)
    k_pos = jnp.arange(Lp)
    scale = FOX_HEAD_DIM ** -0.5

    def one_block(args):
        i, q_i, c_i = args
        s = jnp.einsum('bqhd,bkhd->bhqk', q_i, k).astype(jnp.float32) * scale
        s = s + (c_i[..., :, None] - c_k[..., None, :])
        q_pos = i * Q_BLOCK + jnp.arange(Q_BLOCK)
        s = jnp.where(k_pos[None, :] <= q_pos[:, None], s, -jnp.inf)
        p = jax.nn.softmax(s, axis=-1).astype(v.dtype)
        return jnp.einsum('bhqk,bkhd->bqhd', p, v)

    o = lax.map(one_block, (jnp.arange(n_blk), q_blocks, c_blocks))
    return o.transpose(1, 0, 2, 3, 4).reshape(Bn, Lp, H * hd)[:, :L]


def hierarchical_moe(x, w_rg, b_rg, w_re, b_re, w_gate, w_up, w_down):
    Bn, L, D = x.shape
    xf = x.reshape(-1, D)
    N = xf.shape[0]
    g_logits = (xf @ w_rg + b_rg).astype(jnp.float32)
    g_prob = jax.nn.softmax(g_logits, axis=-1)
    g_idx = jnp.argmax(g_logits, axis=-1)
    g_w = jnp.take_along_axis(g_prob, g_idx[:, None], axis=-1)
    e_logits = (xf @ w_re + b_re).astype(jnp.float32).reshape(N, N_GROUPS, EXPERTS_PER_GROUP)
    e_logits = jnp.take_along_axis(e_logits, g_idx[:, None, None], axis=1)[:, 0]
    top_p, top_j = lax.top_k(jax.nn.softmax(e_logits, axis=-1), TOP_K_IN_GROUP)
    weights = g_w * top_p / jnp.sum(top_p, axis=-1, keepdims=True)
    expert = g_idx[:, None] * EXPERTS_PER_GROUP + top_j

    A = N * TOP_K_IN_GROUP
    eid = expert.reshape(-1).astype(jnp.int32)
    tok = jnp.repeat(jnp.arange(N, dtype=jnp.int32), TOP_K_IN_GROUP)
    wt = weights.reshape(-1)
    order = jnp.argsort(eid)
    s_eid = eid[order]
    counts = jnp.zeros((N_EXPERTS,), jnp.int32).at[eid].add(1)
    pcounts = (counts + MOE_BLOCK - 1) // MOE_BLOCK * MOE_BLOCK
    start = jnp.cumsum(counts) - counts
    pend = jnp.cumsum(pcounts)
    pstart = pend - pcounts
    dest = pstart[s_eid] + jnp.arange(A, dtype=jnp.int32) - start[s_eid]
    n_blocks = -(-(A + N_EXPERTS * (MOE_BLOCK - 1)) // MOE_BLOCK)
    P = n_blocks * MOE_BLOCK
    slot_tok = jnp.full((P,), N, jnp.int32).at[dest].set(tok[order])
    slot_w = jnp.zeros((P,), wt.dtype).at[dest].set(wt[order])
    blk_eid = jnp.minimum(jnp.searchsorted(pend, jnp.arange(n_blocks, dtype=jnp.int32) * MOE_BLOCK, side='right'), N_EXPERTS - 1)
    x_pad = jnp.concatenate([xf, jnp.zeros((1, D), xf.dtype)], axis=0)
    xs = x_pad[slot_tok].reshape(n_blocks, MOE_BLOCK, D)

    def expert_block(args):
        e, xb = args
        h = jax.nn.silu(xb @ w_gate[e]) * (xb @ w_up[e])
        return h @ w_down[e]

    ys = lax.map(expert_block, (blk_eid, xs)).reshape(P, D)
    ys = ys * slot_w[:, None]
    out = jnp.zeros((N + 1, D), ys.dtype).at[slot_tok].add(ys)[:N]
    return out.reshape(Bn, L, D).astype(x.dtype)


def setup_inputs(seed: int = 0) -> dict:
    key = jax.random.key(seed)
    ks = jax.random.split(key, 24)
    nrm = lambda k, shape, s: jax.random.normal(k, shape, jnp.float32) * s
    Dm = D_MODEL
    return {
        "x": nrm(ks[0], (BATCH, SEQ, Dm), 1.0),
        "meta_tokens": nrm(ks[1], (N_META, Dm), 1.0),
        "norm1_g": 1.0 + nrm(ks[2], (DEPTH, Dm), 0.02),
        "w_in": nrm(ks[3], (DEPTH, Dm, IN_COLS), Dm ** -0.5),
        "b_forget": jax.random.uniform(ks[4], (DEPTH, N_FOX_HEADS), jnp.float32, 1.0, 4.0),
        "conv_w": nrm(ks[5], (DEPTH, CONV_W, D_CONV), CONV_W ** -0.5),
        "w_conv_out": nrm(ks[6], (DEPTH, D_CONV, Dm), D_CONV ** -0.5),
        "q_norm_g": 1.0 + nrm(ks[7], (DEPTH, FOX_HEAD_DIM), 0.02),
        "k_norm_g": 1.0 + nrm(ks[8], (DEPTH, FOX_HEAD_DIM), 0.02),
        "w_att_out": nrm(ks[9], (DEPTH, D_ATT, Dm), D_ATT ** -0.5),
        "w_merge_out": nrm(ks[10], (DEPTH, Dm, Dm), Dm ** -0.5),
        "norm2_g": 1.0 + nrm(ks[11], (DEPTH, Dm), 0.02),
        "w_router_group": nrm(ks[12], (DEPTH, Dm, N_GROUPS), Dm ** -0.5),
        "b_router_group": nrm(ks[13], (DEPTH, N_GROUPS), 0.01),
        "w_router_expert": nrm(ks[14], (DEPTH, Dm, N_EXPERTS), Dm ** -0.5),
        "b_router_expert": nrm(ks[15], (DEPTH, N_EXPERTS), 0.01),
        "w_exp_gate": nrm(ks[16], (DEPTH, N_EXPERTS, Dm, D_EXPERT), Dm ** -0.5),
        "w_exp_up": nrm(ks[17], (DEPTH, N_EXPERTS, Dm, D_EXPERT), Dm ** -0.5),
        "w_exp_down": nrm(ks[18], (DEPTH, N_EXPERTS, D_EXPERT, Dm), D_EXPERT ** -0.5),
    }


def reference(x, meta_tokens, norm1_g, w_in, b_forget, conv_w, w_conv_out, q_norm_g, k_norm_g,
              w_att_out, w_merge_out, norm2_g, w_router_group, b_router_group, w_router_expert,
              b_router_expert, w_exp_gate, w_exp_up, w_exp_down):
    Bn, S, Dm = x.shape
    meta = jnp.broadcast_to(meta_tokens[None].astype(x.dtype), (Bn, N_META, Dm))
    h = jnp.concatenate([meta, x], axis=1)
    L = h.shape[1]
    split_at = list(np.cumsum(SPLIT_SIZES)[:-1])
    for l in range(DEPTH):
        hn = rms_norm(h, norm1_g[l])
        proj = hn @ w_in[l]
        b_g, c_g, u, q, k, v, f_logit, ga, gb = jnp.split(proj, split_at, axis=-1)
        y_a = short_gated_conv(b_g, c_g, u, conv_w[l]) @ w_conv_out[l]
        q = q.reshape(Bn, L, N_FOX_HEADS, FOX_HEAD_DIM)
        k = k.reshape(Bn, L, N_FOX_HEADS, FOX_HEAD_DIM)
        v = v.reshape(Bn, L, N_FOX_HEADS, FOX_HEAD_DIM)
        attn = forgetting_attention(q, k, v, f_logit + b_forget[l], q_norm_g[l], k_norm_g[l])
        y_b = attn @ w_att_out[l]
        y = (jax.nn.sigmoid(ga) * y_a + jax.nn.sigmoid(gb) * y_b) @ w_merge_out[l]
        h = h + y
        h = h + hierarchical_moe(rms_norm(h, norm2_g[l]), w_router_group[l], b_router_group[l],
                                 w_router_expert[l], b_router_expert[l], w_exp_gate[l],
                                 w_exp_up[l], w_exp_down[l])
    return h[:, N_META:]
```

```cpp
#include <hip/hip_runtime.h>
#include <cstdio>
#include <cstdint>

namespace nv {
constexpr int B_ = 2, S_ = 8192, NMETA = 16, L_ = S_ + NMETA, D_ = 1024, NT = B_ * L_;
constexpr int H_ = 16, HD = 64, INC = 8208, NG = 4, EPG = 8, NE = 32, DE = 512;
constexpr float EPS = 1e-6f;

__global__ void k_embed(const float* __restrict__ x, const float* __restrict__ meta, float* __restrict__ h) {
    const int row = blockIdx.x, b = row / L_, p = row % L_;
    const float* src = p < NMETA ? meta + (size_t)p * D_ : x + ((size_t)b * S_ + (p - NMETA)) * D_;
    for (int d = threadIdx.x; d < D_; d += blockDim.x) h[(size_t)row * D_ + d] = src[d];
}
__global__ void k_rmsnorm(const float* __restrict__ h, const float* __restrict__ g, float* __restrict__ o) {
    __shared__ float red[256];
    const int row = blockIdx.x; const float* hr = h + (size_t)row * D_;
    float s = 0.f; for (int d = threadIdx.x; d < D_; d += 256) { const float v = hr[d]; s += v * v; }
    red[threadIdx.x] = s; __syncthreads();
    for (int o2 = 128; o2 > 0; o2 >>= 1) { if (threadIdx.x < o2) red[threadIdx.x] += red[threadIdx.x + o2]; __syncthreads(); }
    const float r = rsqrtf(red[0] / D_ + EPS);
    for (int d = threadIdx.x; d < D_; d += 256) o[(size_t)row * D_ + d] = hr[d] * r * g[d];
}
__global__ void __launch_bounds__(256) k_gemm(const float* __restrict__ A, int lda, const float* __restrict__ Bm, int ldb, float* __restrict__ C, int ldc, int M, int N, int K,
                                              const int* __restrict__ idx, int idx_stride, const int* __restrict__ cnt, int adiv, size_t b_estride) {
    __shared__ float As[16][64 + 1], Bs[16][64];
    __shared__ int rowA[64], rowC[64];
    const int e = blockIdx.z; int Me = M;
    if (idx) { Me = cnt[e]; Bm += (size_t)e * b_estride; }
    const int m0 = blockIdx.y * 64, n0 = blockIdx.x * 64;
    if (m0 >= Me) return;
    if (threadIdx.x < 64) { const int r = m0 + threadIdx.x; int ra = -1, rc = -1;
        if (r < Me) { if (idx) { const int a = idx[(size_t)e * idx_stride + r]; ra = a / adiv; rc = a; } else { ra = r; rc = r; } }
        rowA[threadIdx.x] = ra; rowC[threadIdx.x] = rc; }
    __syncthreads();
    const int tx = threadIdx.x % 16, ty = threadIdx.x / 16;
    float acc[4][4] = {};
    for (int k0 = 0; k0 < K; k0 += 16) {
        for (int i = threadIdx.x; i < 64 * 16; i += 256) { const int r = i / 16, kk = i % 16; const int ra = rowA[r]; As[kk][r] = ra >= 0 ? A[(size_t)ra * lda + k0 + kk] : 0.f; }
        for (int i = threadIdx.x; i < 16 * 64; i += 256) { const int kk = i / 64, n = i % 64; Bs[kk][n] = (n0 + n < N) ? Bm[(size_t)(k0 + kk) * ldb + n0 + n] : 0.f; }
        __syncthreads();
#pragma unroll
        for (int kk = 0; kk < 16; ++kk) { float a[4], b[4];
#pragma unroll
            for (int i = 0; i < 4; ++i) { a[i] = As[kk][ty * 4 + i]; b[i] = Bs[kk][tx * 4 + i]; }
#pragma unroll
            for (int i = 0; i < 4; ++i)
#pragma unroll
                for (int j = 0; j < 4; ++j) acc[i][j] += a[i] * b[j]; }
        __syncthreads();
    }
#pragma unroll
    for (int i = 0; i < 4; ++i) { const int rc = rowC[ty * 4 + i]; if (rc < 0) continue;
#pragma unroll
        for (int j = 0; j < 4; ++j) { const int n = n0 + tx * 4 + j; if (n < N) C[(size_t)rc * ldc + n] = acc[i][j]; } }
}
__global__ void k_conv(const float* __restrict__ P1, const float* __restrict__ cw, float* __restrict__ yain) {
    const int row = blockIdx.x, p = row % L_;
    for (int d = threadIdx.x; d < D_; d += blockDim.x) {
        float y = 0.f;
        for (int i = 0; i < 3; ++i) { const int pp = p - 2 + i; if (pp < 0) continue; const float* r = P1 + (size_t)(row - 2 + i) * 3072; y += r[1024 + d] * r[2048 + d] * cw[i * D_ + d]; }
        yain[(size_t)row * D_ + d] = P1[(size_t)row * 3072 + d] * y;
    }
}
__global__ void k_qknorm(float* __restrict__ P1, const float* __restrict__ qg, const float* __restrict__ kg) {
    const int row = blockIdx.x, lane = threadIdx.x & 63, w = threadIdx.x >> 6;
    for (int v = w; v < 32; v += 4) { float* p = P1 + (size_t)row * 3072 + v * 64; const float x = p[lane]; float s = x * x;
        for (int o = 1; o < 64; o <<= 1) s += __shfl_xor(s, o);
        const float g = v < 16 ? qg[lane] : kg[lane]; p[lane] = x * rsqrtf(s / 64.f + EPS) * g; }
}
__global__ void k_fscan(const float* __restrict__ f, const float* __restrict__ bf, float* __restrict__ c) {
    __shared__ float part[256];
    const int b = blockIdx.x / H_, h = blockIdx.x % H_, CH = (L_ + 255) / 256; const int p0 = threadIdx.x * CH;
    float s = 0.f;
    for (int i = 0; i < CH; ++i) { const int p = p0 + i; if (p < L_) { const float x = f[((size_t)b * L_ + p) * H_ + h] + bf[h]; s += fminf(x, 0.f) - log1pf(expf(-fabsf(x))); } }
    part[threadIdx.x] = s; __syncthreads();
    if (threadIdx.x == 0) { float run = 0.f; for (int i = 0; i < 256; ++i) { const float t = part[i]; part[i] = run; run += t; } }
    __syncthreads();
    float run = part[threadIdx.x];
    for (int i = 0; i < CH; ++i) { const int p = p0 + i; if (p < L_) { const float x = f[((size_t)b * L_ + p) * H_ + h] + bf[h]; run += fminf(x, 0.f) - log1pf(expf(-fabsf(x))); c[((size_t)b * H_ + h) * L_ + p] = run; } }
}
__global__ void __launch_bounds__(64) k_attn(float* __restrict__ P1, const float* __restrict__ c) {
    __shared__ float Ks[64][64], Vs[64][64], cs[64];
    const int bh = blockIdx.y, b = bh / H_, h = bh % H_, q0 = blockIdx.x * 64, t = q0 + threadIdx.x; const bool valid = t < L_;
    const float* cb = c + ((size_t)b * H_ + h) * L_;
    float q[64], o[64]; float m = -INFINITY, l = 0.f; const float ct = valid ? cb[t] : 0.f;
    { const float* qp = P1 + ((size_t)b * L_ + (valid ? t : 0)) * 3072 + h * 64;
#pragma unroll
      for (int d = 0; d < 64; ++d) { q[d] = qp[d] * 0.125f; o[d] = 0.f; } }
    for (int s0 = 0; s0 <= q0 && s0 < L_; s0 += 64) {
        __syncthreads();
        for (int i = threadIdx.x; i < 64 * 64; i += 64) { const int j = i / 64, d = i % 64; const int s = s0 + j;
            Ks[j][d] = s < L_ ? P1[((size_t)b * L_ + s) * 3072 + 1024 + h * 64 + d] : 0.f; Vs[j][d] = s < L_ ? P1[((size_t)b * L_ + s) * 3072 + 2048 + h * 64 + d] : 0.f; }
        { const int s = s0 + threadIdx.x; cs[threadIdx.x] = s < L_ ? cb[s] : 0.f; }
        __syncthreads();
        for (int j = 0; j < 64; ++j) { const int s = s0 + j; if (s > t || s >= L_) break;
            float sc = 0.f;
#pragma unroll
            for (int d = 0; d < 64; ++d) sc += q[d] * Ks[j][d];
            sc += ct - cs[j];
            if (sc > m) { const float a = __expf(m - sc); l *= a;
#pragma unroll
                for (int d = 0; d < 64; ++d) o[d] *= a;
                m = sc; }
            const float pj = __expf(sc - m); l += pj;
#pragma unroll
            for (int d = 0; d < 64; ++d) o[d] += pj * Vs[j][d];
        }
    }
    if (valid) { float* op = P1 + ((size_t)b * L_ + t) * 3072 + h * 64; const float il = 1.f / l;
#pragma unroll
        for (int d = 0; d < 64; ++d) op[d] = o[d] * il; }
}
__device__ __forceinline__ float sigm(float x) { return 1.f / (1.f + __expf(-x)); }
__global__ void k_gate(float* __restrict__ y, int ldy, const float* __restrict__ g, int ldg, const float* __restrict__ y2, int ld2, int mode) {
    const int row = blockIdx.x;
    for (int d = threadIdx.x; d < D_; d += blockDim.x) { const float s = sigm(g[(size_t)row * ldg + d]); float* yp = y + (size_t)row * ldy + d;
        *yp = mode == 0 ? s * *yp : *yp + s * y2[(size_t)row * ld2 + d]; }
}
__global__ void k_add(float* __restrict__ h, const float* __restrict__ y) { const size_t i = (size_t)blockIdx.x * blockDim.x + threadIdx.x; if (i < (size_t)NT * D_) h[i] += y[i]; }
__global__ void k_router(const float* __restrict__ hn, const float* __restrict__ wg, const float* __restrict__ bg, const float* __restrict__ we, const float* __restrict__ be,
                         int* __restrict__ cnt, int* __restrict__ list, float* __restrict__ wt) {
    const int tok = blockIdx.x * 4 + (threadIdx.x >> 6), lane = threadIdx.x & 63; if (tok >= NT) return;
    float acc[36];
#pragma unroll
    for (int j = 0; j < 36; ++j) acc[j] = 0.f;
    for (int k = lane; k < D_; k += 64) { const float x = hn[(size_t)tok * D_ + k];
#pragma unroll
        for (int j = 0; j < 4; ++j) acc[j] += x * wg[k * 4 + j];
#pragma unroll
        for (int j = 0; j < 32; ++j) acc[4 + j] += x * we[k * 32 + j]; }
#pragma unroll
    for (int j = 0; j < 36; ++j) for (int o = 1; o < 64; o <<= 1) acc[j] += __shfl_xor(acc[j], o);
    __shared__ float sl[4][40];
    if (lane == 0) {
#pragma unroll
        for (int j = 0; j < 36; ++j) sl[threadIdx.x >> 6][j] = acc[j];
    }
    __builtin_amdgcn_s_waitcnt(0);
    if (lane == 0) {
        const float* a = sl[threadIdx.x >> 6];
        int gi = 0; for (int j = 1; j < 4; ++j) if (a[j] + bg[j] > a[gi] + bg[gi]) gi = j;
        const float gmax = a[gi] + bg[gi];
        float gs = 0.f; for (int j = 0; j < 4; ++j) gs += expf(a[j] + bg[j] - gmax);
        const float gw = 1.f / gs;
        const float* el = a + 4 + gi * 8; const float* eb = be + gi * 8;
        int i1 = 0; for (int j = 1; j < 8; ++j) if (el[j] + eb[j] > el[i1] + eb[i1]) i1 = j;
        int i2 = -1; for (int j = 0; j < 8; ++j) { if (j == i1) continue; if (i2 < 0 || el[j] + eb[j] > el[i2] + eb[i2]) i2 = j; }
        const float p2 = expf((el[i2] + eb[i2]) - (el[i1] + eb[i1])); const float w1 = gw / (1.f + p2), w2 = gw * p2 / (1.f + p2);
        const int e1 = gi * 8 + i1, e2 = gi * 8 + i2;
        wt[tok * 2] = w1; wt[tok * 2 + 1] = w2;
        const int s1 = atomicAdd(cnt + e1, 1); list[(size_t)e1 * (2 * NT) + s1] = tok * 2;
        const int s2 = atomicAdd(cnt + e2, 1); list[(size_t)e2 * (2 * NT) + s2] = tok * 2 + 1;
    }
}
__global__ void k_silu_mul(float* __restrict__ g, const float* __restrict__ u) { const size_t i = (size_t)blockIdx.x * blockDim.x + threadIdx.x; if (i < (size_t)2 * NT * DE) { const float x = g[i]; g[i] = x * sigm(x) * u[i]; } }
__global__ void k_moe_add(float* __restrict__ h, const float* __restrict__ Y, const float* __restrict__ wt) {
    const int tok = blockIdx.x;
    for (int d = threadIdx.x; d < D_; d += blockDim.x) h[(size_t)tok * D_ + d] += wt[tok * 2] * Y[(size_t)(tok * 2) * D_ + d] + wt[tok * 2 + 1] * Y[(size_t)(tok * 2 + 1) * D_ + d];
}
__global__ void k_out(const float* __restrict__ h, float* __restrict__ out) {
    const int row = blockIdx.x, b = row / S_, t = row % S_;
    for (int d = threadIdx.x; d < D_; d += blockDim.x) out[(size_t)row * D_ + d] = h[((size_t)b * L_ + NMETA + t) * D_ + d];
}

static void gemm(hipStream_t st, const float* A, int lda, const float* Bm, int ldb, float* C, int ldc, int M, int N, int K) {
    hipLaunchKernelGGL(k_gemm, dim3((N + 63) / 64, (M + 63) / 64, 1), dim3(256), 0, st, A, lda, Bm, ldb, C, ldc, M, N, K, (const int*)nullptr, 0, (const int*)nullptr, 1, (size_t)0);
}
static void forward(void* const* d_in, float* out, unsigned char* ws, hipStream_t st) {
    const float* x = (const float*)d_in[0]; const float* meta = (const float*)d_in[1];
    const size_t RF = (size_t)NT * D_;
    float* h = (float*)ws; float* hn = h + RF; float* Cb = h + 2 * RF; float* Db = h + 5 * RF;
    float* sm = h + 6 * RF;
    float* fl = sm; sm += (size_t)NT * 16; float* cc = sm; sm += (size_t)NT * 16; float* wt = sm; sm += (size_t)NT * 2;
    int* cnt = (int*)sm; sm += 64; int* list = (int*)sm;
    float* G = Cb; float* U = Cb + RF; float* Y = Cb + 2 * RF;
    hipLaunchKernelGGL(k_embed, dim3(NT), dim3(256), 0, st, x, meta, h);
    for (int l = 0; l < 2; ++l) {
        const float* g1 = (const float*)d_in[2] + l * D_; const float* win = (const float*)d_in[3] + (size_t)l * D_ * INC; const float* bfg = (const float*)d_in[4] + l * 16;
        const float* cw = (const float*)d_in[5] + l * 3 * D_; const float* wco = (const float*)d_in[6] + (size_t)l * D_ * D_; const float* qg = (const float*)d_in[7] + l * 64; const float* kg = (const float*)d_in[8] + l * 64;
        const float* wao = (const float*)d_in[9] + (size_t)l * D_ * D_; const float* wmo = (const float*)d_in[10] + (size_t)l * D_ * D_; const float* g2 = (const float*)d_in[11] + l * D_;
        const float* wrg = (const float*)d_in[12] + l * D_ * 4; const float* brg = (const float*)d_in[13] + l * 4; const float* wre = (const float*)d_in[14] + l * D_ * 32; const float* bre = (const float*)d_in[15] + l * 32;
        const float* wg = (const float*)d_in[16] + (size_t)l * NE * D_ * DE; const float* wu = (const float*)d_in[17] + (size_t)l * NE * D_ * DE; const float* wd = (const float*)d_in[18] + (size_t)l * NE * DE * D_;
        hipLaunchKernelGGL(k_rmsnorm, dim3(NT), dim3(256), 0, st, h, g1, hn);
        gemm(st, hn, D_, win, INC, Cb, 3072, NT, 3072, D_);
        hipLaunchKernelGGL(k_conv, dim3(NT), dim3(256), 0, st, Cb, cw, Db);
        gemm(st, hn, D_, win + 6144, INC, fl, 16, NT, 16, D_);
        hipLaunchKernelGGL(k_fscan, dim3(B_ * H_), dim3(256), 0, st, fl, bfg, cc);
        gemm(st, hn, D_, win + 3072, INC, Cb, 3072, NT, 3072, D_);
        hipLaunchKernelGGL(k_qknorm, dim3(NT), dim3(256), 0, st, Cb, qg, kg);
        hipLaunchKernelGGL(k_attn, dim3((L_ + 63) / 64, B_ * H_), dim3(64), 0, st, Cb, cc);
        gemm(st, Db, D_, wco, D_, Cb + 1024, 3072, NT, D_, D_);
        gemm(st, Cb, 3072, wao, D_, Db, D_, NT, D_, D_);
        gemm(st, hn, D_, win + 6160, INC, Cb + 2048, 3072, NT, D_, D_);
        hipLaunchKernelGGL(k_gate, dim3(NT), dim3(256), 0, st, Cb + 1024, 3072, (const float*)(Cb + 2048), 3072, (const float*)nullptr, 0, 0);
        gemm(st, hn, D_, win + 7184, INC, Cb + 2048, 3072, NT, D_, D_);
        hipLaunchKernelGGL(k_gate, dim3(NT), dim3(256), 0, st, Cb + 1024, 3072, (const float*)(Cb + 2048), 3072, (const float*)Db, D_, 1);
        gemm(st, Cb + 1024, 3072, wmo, D_, Db, D_, NT, D_, D_);
        hipLaunchKernelGGL(k_add, dim3((unsigned)((RF + 255) / 256)), dim3(256), 0, st, h, (const float*)Db);
        hipLaunchKernelGGL(k_rmsnorm, dim3(NT), dim3(256), 0, st, h, g2, hn);
        hipMemsetAsync(cnt, 0, 256, st);
        hipLaunchKernelGGL(k_router, dim3((NT + 3) / 4), dim3(256), 0, st, hn, wrg, brg, wre, bre, cnt, list, wt);
        hipLaunchKernelGGL(k_gemm, dim3(DE / 64, (2 * NT + 63) / 64, NE), dim3(256), 0, st, (const float*)hn, D_, wg, DE, G, DE, 0, DE, D_, (const int*)list, 2 * NT, (const int*)cnt, 2, (size_t)D_ * DE);
        hipLaunchKernelGGL(k_gemm, dim3(DE / 64, (2 * NT + 63) / 64, NE), dim3(256), 0, st, (const float*)hn, D_, wu, DE, U, DE, 0, DE, D_, (const int*)list, 2 * NT, (const int*)cnt, 2, (size_t)D_ * DE);
        hipLaunchKernelGGL(k_silu_mul, dim3((unsigned)(((size_t)2 * NT * DE + 255) / 256)), dim3(256), 0, st, G, (const float*)U);
        hipLaunchKernelGGL(k_gemm, dim3(D_ / 64, (2 * NT + 63) / 64, NE), dim3(256), 0, st, (const float*)G, DE, wd, D_, Y, D_, 0, D_, DE, (const int*)list, 2 * NT, (const int*)cnt, 1, (size_t)DE * D_);
        hipLaunchKernelGGL(k_moe_add, dim3(NT), dim3(256), 0, st, h, (const float*)Y, (const float*)wt);
    }
    hipLaunchKernelGGL(k_out, dim3(B_ * S_), dim3(256), 0, st, (const float*)h, out);
}
}

extern "C" void kernel_launch(void* const* d_in, const int* in_sizes, int n_in, void* d_out, int out_size, void* d_ws, size_t ws_size, hipStream_t stream) {
    nv::forward(d_in, (float*)d_out, (unsigned char*)d_ws, stream);
}
```

```cpp
#include <hip/hip_runtime.h>
#include <cstdio>
#include <cstdint>
#include <cmath>
namespace pg8 {
#define PG8_LAS __attribute__((address_space(3)))
typedef unsigned short bf16_t;
typedef short bf16x8 __attribute__((ext_vector_type(8)));
typedef float f32x4 __attribute__((ext_vector_type(4)));
typedef float f32x2 __attribute__((ext_vector_type(2)));
typedef unsigned u32x4 __attribute__((ext_vector_type(4)));
__device__ __forceinline__ float shx(float v, int m, int lane) { return __int_as_float(__builtin_amdgcn_ds_bpermute((lane ^ m) << 2, __float_as_int(v))); }
constexpr int BM = 256, BK = 64, HALF = 128, HTB = HALF * BK * 2  , STAGE_BYTES = 8 * HTB, NXCD = 8, WGM = 8;

__host__ __device__ __forceinline__ int lds_byte(int r, int c) { const int st = (r >> 4) * 2 + (c >> 5), rr = r & 15, cc = c & 31, ob = rr * 64 + cc * 2; return st * 1024 + (ob ^ (((ob >> 9) & 1) << 5)); }
__host__ __device__ __forceinline__ void stage_rc(int b, int& R, int& C) { const int st = b / 1024, sb = b % 1024, swz = sb ^ (((sb >> 9) & 1) << 5); R = (st >> 1) * 16 + swz / 64; C = (st & 1) * 32 + (swz % 64) / 2; }
__host__ __device__ __forceinline__ int perm32(int rho) { const int n = rho >> 4, i = rho & 15; return 8 * (i >> 2) + 4 * n + (i & 3); }

struct Unit { const char* a; const char* b; int kind, pm, pn, aux; };

__device__ __forceinline__ void tile_of(int L, int nM, int nN, int& pm, int& pn) {
    const int nwg = nM * nN; int wgid = L; { const int q = nwg / NXCD, r = nwg % NXCD, xcd = wgid % NXCD, off = wgid / NXCD; wgid = (xcd < r ? xcd * (q + 1) : r * (q + 1) + (xcd - r) * q) + off; }
    const int nig = WGM * nN, gid = wgid / nig, fm = gid * WGM, gsz = (nM - fm) < WGM ? (nM - fm) : WGM;
    pm = fm + ((wgid % nig) % gsz); pn = (wgid % nig) / gsz;
}
__device__ __forceinline__ unsigned cvt_pk_bf16(float lo, float hi) { unsigned r; asm volatile("v_cvt_pk_bf16_f32 %0, %1, %2" : "=v"(r) : "v"(lo), "v"(hi)); return r; }
__device__ __forceinline__ float bf_lo(unsigned w) { return __uint_as_float(w << 16); }
__device__ __forceinline__ float bf_hi(unsigned w) { return __uint_as_float(w & 0xffff0000u); }
__device__ __forceinline__ float sigmoidf_fast(float x) { return __builtin_amdgcn_rcpf(1.0f + __builtin_amdgcn_exp2f(-1.4426950408889634f * x)); }

template <class Epi, class Sched, bool ALIGN_EPI>
__device__ __forceinline__ void gemm_phase(const int tid, PG8_LAS unsigned char* lds, const int K, const Sched& S, const Epi& E) {
    const int wid = __builtin_amdgcn_readfirstlane(tid >> 6), lane = tid & 63, wr = wid >> 2, wc = wid & 3, fr = lane & 15, fq = lane >> 4;
    const int nt = K / BK;
    int sR[2], sC[2]; unsigned voffB[2];
#pragma unroll
    for (int i = 0; i < 2; ++i) { stage_rc(tid * 16 + i * 8192, sR[i], sC[i]); const int Rb = (sR[i] & ~31) + perm32(sR[i] & 31); voffB[i] = (unsigned)(Rb * K + sC[i]) * 2u; }
    const size_t kstep = (size_t)(BK * 2);
    const size_t hstep = (size_t)HALF * K * 2;
    const unsigned ldsw = (unsigned)wid * 1024u;
    const int aoff = lds_byte(wr * 64 + fr, fq * 8), boff = lds_byte(wc * 32 + fr, fq * 8);
#define PG8_SA(b, h) (((b) * 2 + (h)) * HTB)
#define PG8_SB(b, h) ((4 + (b) * 2 + (h)) * HTB)
#define PG8_STAGE(bufoff, gbase, v0, v1) do { \
        __builtin_amdgcn_global_load_lds((const unsigned*)((const char*)(gbase) + (v0)), (PG8_LAS unsigned*)(lds + (bufoff) + ldsw), 16, 0, 0); \
        __builtin_amdgcn_global_load_lds((const unsigned*)((const char*)(gbase) + (v1)), (PG8_LAS unsigned*)(lds + (bufoff) + ldsw + 8192), 16, 0, 0); } while (0)
#define PG8_STAGEB(bufoff, gbase) PG8_STAGE(bufoff, gbase, voffB[0], voffB[1])
#define PG8_LDA(dst, b, h) do { _Pragma("unroll") for (int m = 0; m < 4; ++m) _Pragma("unroll") for (int k = 0; k < 2; ++k) dst[m][k] = *(const PG8_LAS bf16x8*)(lds + PG8_SA(b, h) + aoff + m * 2048 + k * 1024); } while (0)
#define PG8_LDB(dst, b, h) do { _Pragma("unroll") for (int n = 0; n < 2; ++n) _Pragma("unroll") for (int k = 0; k < 2; ++k) dst[n][k] = *(const PG8_LAS bf16x8*)(lds + PG8_SB(b, h) + boff + n * 2048 + k * 1024); } while (0)
#define PG8_MMA(ai, bj, At, Bt) do { __builtin_amdgcn_s_setprio(1); _Pragma("unroll") for (int m = 0; m < 4; ++m) _Pragma("unroll") for (int n = 0; n < 2; ++n) _Pragma("unroll") for (int k = 0; k < 2; ++k) \
        acc[ai][bj][m][n] = __builtin_amdgcn_mfma_f32_16x16x32_bf16(Bt[n][k], At[m][k], acc[ai][bj][m][n], 0, 0, 0); __builtin_amdgcn_s_setprio(0); } while (0)
#define PG8_WAIT_V(n) asm volatile("s_waitcnt vmcnt(" #n ")" ::: "memory")
#define PG8_WAIT_L(n) asm volatile("s_waitcnt lgkmcnt(" #n ")" ::: "memory")
#define PG8_BAR __builtin_amdgcn_s_barrier()
#define PG8_SCHED __builtin_amdgcn_sched_barrier(0)
    Unit cur, nxt; int ui = 0;
    if (!S.next(0, cur)) return;
    f32x4 acc[2][2][4][2];
#pragma unroll
    for (int a = 0; a < 2; ++a)
#pragma unroll
        for (int b = 0; b < 2; ++b)
#pragma unroll
            for (int m = 0; m < 4; ++m)
#pragma unroll
                for (int n = 0; n < 2; ++n) acc[a][b][m][n] = (f32x4){0.f, 0.f, 0.f, 0.f};
    bf16x8 At[4][2], B0[2][2], B1[2][2];
    unsigned vA[2][2], vN[2][2];
    S.voff(cur, K, sR, sC, vA);
    const char* cA = cur.a; const char* cB = cur.b;
    PG8_STAGEB(PG8_SB(0, 0), cB); PG8_STAGEB(PG8_SB(0, 1), cB + hstep); PG8_STAGE(PG8_SA(0, 0), cA, vA[0][0], vA[0][1]); PG8_STAGE(PG8_SA(0, 1), cA, vA[1][0], vA[1][1]);
    if (wr == 1) PG8_BAR;
    PG8_WAIT_V(2); PG8_BAR;
    PG8_STAGEB(PG8_SB(1, 0), cB + kstep); PG8_STAGE(PG8_SA(1, 0), cA + kstep, vA[0][0], vA[0][1]); PG8_STAGEB(PG8_SB(1, 1), cB + hstep + kstep);
    PG8_WAIT_V(6); PG8_BAR;
    for (;;) {
        const bool has_next = S.next(ui + 1, nxt);
        const char* nA = cA; const char* nB = cB;
#pragma unroll
        for (int h = 0; h < 2; ++h) { vN[h][0] = vA[h][0]; vN[h][1] = vA[h][1]; }
        if (has_next) { nA = nxt.a; nB = nxt.b; S.voff(nxt, K, sR, sC, vN); }
        for (int t = 0; t < nt; t += 2) {
            const bool last = (t == nt - 2);
            const char* a1 = cA + (size_t)(t + 1) * kstep;
            const char* a2 = last ? nA : cA + (size_t)(t + 2) * kstep; const char* b2 = last ? nB : cB + (size_t)(t + 2) * kstep;
            const char* a3 = a2 + kstep; const char* b3 = b2 + kstep;
            const unsigned w00 = last ? vN[0][0] : vA[0][0], w01 = last ? vN[0][1] : vA[0][1], w10 = last ? vN[1][0] : vA[1][0], w11 = last ? vN[1][1] : vA[1][1];
            PG8_LDB(B0, 0, 0); PG8_LDB(B1, 0, 1); PG8_SCHED; PG8_LDA(At, 0, 0); PG8_STAGE(PG8_SA(1, 1), a1, vA[1][0], vA[1][1]);
            PG8_WAIT_V(8); PG8_WAIT_L(0); PG8_BAR; PG8_MMA(0, 0, At, B0); PG8_MMA(0, 1, At, B1); PG8_BAR; PG8_SCHED;
            PG8_LDA(At, 0, 1); PG8_STAGEB(PG8_SB(0, 0), b2); PG8_STAGEB(PG8_SB(0, 1), b2 + hstep); PG8_STAGE(PG8_SA(0, 0), a2, w00, w01);
            PG8_WAIT_V(8); PG8_WAIT_L(0); PG8_BAR; PG8_MMA(1, 0, At, B0); PG8_MMA(1, 1, At, B1); PG8_BAR; PG8_SCHED;
            PG8_LDB(B0, 1, 0); PG8_LDB(B1, 1, 1); PG8_SCHED; PG8_LDA(At, 1, 0); PG8_STAGE(PG8_SA(0, 1), a2, w10, w11);
            PG8_WAIT_V(8); PG8_WAIT_L(0); PG8_BAR; PG8_MMA(0, 0, At, B0); PG8_MMA(0, 1, At, B1); PG8_BAR; PG8_SCHED;
            PG8_LDA(At, 1, 1); PG8_STAGEB(PG8_SB(1, 0), b3); PG8_STAGEB(PG8_SB(1, 1), b3 + hstep); PG8_STAGE(PG8_SA(1, 0), a3, w00, w01);
            PG8_WAIT_V(8); PG8_WAIT_L(0); PG8_BAR; PG8_MMA(1, 0, At, B0); PG8_MMA(1, 1, At, B1); PG8_BAR; PG8_SCHED;
        }
        if constexpr (ALIGN_EPI) { if (wr == 0) PG8_BAR; }
        E(acc, cur, wr, wc, fr, fq);
        if (!has_next) break;
#pragma unroll
        for (int a = 0; a < 2; ++a)
#pragma unroll
            for (int b = 0; b < 2; ++b)
#pragma unroll
                for (int m = 0; m < 4; ++m)
#pragma unroll
                    for (int n = 0; n < 2; ++n) acc[a][b][m][n] = (f32x4){0.f, 0.f, 0.f, 0.f};
        cur = nxt; cA = nA; cB = nB; ++ui;
#pragma unroll
        for (int h = 0; h < 2; ++h) { vA[h][0] = vN[h][0]; vA[h][1] = vN[h][1]; }
        if constexpr (ALIGN_EPI) { if (wr == 1) PG8_BAR; }
    }
    PG8_WAIT_V(0);
    if constexpr (!ALIGN_EPI) { if (wr == 0) PG8_BAR; }
    PG8_BAR;
#undef PG8_SA
#undef PG8_SB
#undef PG8_STAGE
#undef PG8_STAGEB
#undef PG8_LDA
#undef PG8_LDB
#undef PG8_MMA
#undef PG8_WAIT_V
#undef PG8_WAIT_L
#undef PG8_BAR
#undef PG8_SCHED
}
}
namespace pg8 {
__device__ __forceinline__ void st8(bf16_t* p, const f32x4 v0, const f32x4 v1) { u32x4 w; w.x = cvt_pk_bf16(v0[0], v0[1]); w.y = cvt_pk_bf16(v0[2], v0[3]); w.z = cvt_pk_bf16(v1[0], v1[1]); w.w = cvt_pk_bf16(v1[2], v1[3]); *(u32x4*)p = w; }
__device__ __forceinline__ f32x4 sig4(const f32x4 v) { return (f32x4){sigmoidf_fast(v[0]), sigmoidf_fast(v[1]), sigmoidf_fast(v[2]), sigmoidf_fast(v[3])}; }
struct EpiG1 {
    bf16_t* act; size_t astride; const float __attribute__((address_space(1)))* qg; float c2;
    long kgoff;
    __device__ __forceinline__ void operator()(const f32x4 (&acc)[2][2][4][2], const Unit& u, int wr, int wc, int fr, int fq) const {
        const int row0 = u.pm * BM + wr * 64 + fr, pn = u.pn;
        if (pn < 8) {
            bf16_t* base = act + astride + pn * 128 + wc * 32 + 8 * fq;
#pragma unroll
            for (int ai = 0; ai < 2; ++ai)
#pragma unroll
                for (int m = 0; m < 4; ++m) st8(base + (size_t)(row0 + ai * HALF + m * 16) * 1024, acc[ai][0][m][0] * acc[ai][1][m][0], acc[ai][0][m][1] * acc[ai][1][m][1]);
        } else if (pn >= 12 && pn < 20) {
            const bool isq = pn < 16; const float __attribute__((address_space(1)))* g = qg + (isq ? 0 : kgoff); bf16_t* base = act + (isq ? 3 : 4) * astride + (4 * (pn & 3) + wc) * 64 + 8 * fq;
            f32x4 gv[2][2];
#pragma unroll
            for (int bj = 0; bj < 2; ++bj)
#pragma unroll
                for (int n = 0; n < 2; ++n) gv[bj][n] = *(const f32x4 __attribute__((address_space(1)))*)(g + 32 * bj + 8 * fq + 4 * n);
            const float sc = isq ? c2 : 1.0f;
#pragma unroll
            for (int ai = 0; ai < 2; ++ai)
#pragma unroll
                for (int m = 0; m < 4; ++m) {
                    float ss = 0.f;
#pragma unroll
                    for (int bj = 0; bj < 2; ++bj)
#pragma unroll
                        for (int n = 0; n < 2; ++n) { const f32x4 x = acc[ai][bj][m][n]; ss += (x[0] * x[0] + x[1] * x[1]) + (x[2] * x[2] + x[3] * x[3]); }
                    { const int ln = fq * 16 + fr; ss += shx(ss, 16, ln); ss += shx(ss, 32, ln); }
                    const float rs = __builtin_amdgcn_rsqf(ss * (1.0f / 64.0f) + 1e-6f) * sc;
                    bf16_t* rowp = base + (size_t)(row0 + ai * HALF + m * 16) * 1024;
#pragma unroll
                    for (int bj = 0; bj < 2; ++bj) st8(rowp + 32 * bj, acc[ai][bj][m][0] * gv[bj][0] * rs, acc[ai][bj][m][1] * gv[bj][1] * rs);
                }
        } else {
            const bool gate = pn >= 24;
            const int bi = pn < 12 ? 2 : pn < 24 ? 5 : pn < 28 ? 6 : 7;
            bf16_t* base = act + bi * astride + (pn & 3) * 256 + wc * 32 + 8 * fq;
#pragma unroll
            for (int ai = 0; ai < 2; ++ai)
#pragma unroll
                for (int m = 0; m < 4; ++m) { bf16_t* rowp = base + (size_t)(row0 + ai * HALF + m * 16) * 1024;
#pragma unroll
                    for (int bj = 0; bj < 2; ++bj) { f32x4 v0 = acc[ai][bj][m][0], v1 = acc[ai][bj][m][1]; if (gate) { v0 = sig4(v0); v1 = sig4(v1); } st8(rowp + bj * HALF, v0, v1); } }
        }
    }
};
struct EpiG2 {
    bf16_t* MG; const bf16_t* SGA; size_t gstride;
    __device__ __forceinline__ void operator()(const f32x4 (&acc)[2][2][4][2], const Unit& u, int wr, int wc, int fr, int fq) const {
        const int row0 = u.pm * BM + wr * 64 + fr, col0 = u.pn * BM + wc * 32 + 8 * fq; const bf16_t* G = SGA + (u.kind ? gstride : 0);
#pragma unroll
        for (int ai = 0; ai < 2; ++ai)
#pragma unroll
            for (int m = 0; m < 4; ++m) { const size_t off = (size_t)(row0 + ai * HALF + m * 16) * 1024 + col0;
#pragma unroll
                for (int bj = 0; bj < 2; ++bj) { const u32x4 g = *(const u32x4*)(G + off + bj * HALF);
                    f32x4 v0 = acc[ai][bj][m][0] * (f32x4){bf_lo(g.x), bf_hi(g.x), bf_lo(g.y), bf_hi(g.y)}, v1 = acc[ai][bj][m][1] * (f32x4){bf_lo(g.z), bf_hi(g.z), bf_lo(g.w), bf_hi(g.w)};
                    if (u.kind) { const u32x4 t = *(const u32x4*)(MG + off + bj * HALF); v0 += (f32x4){bf_lo(t.x), bf_hi(t.x), bf_lo(t.y), bf_hi(t.y)}; v1 += (f32x4){bf_lo(t.z), bf_hi(t.z), bf_lo(t.w), bf_hi(t.w)}; }
                    st8(MG + off + bj * HALF, v0, v1); }
                asm volatile("" ::: "memory"); }
    }
};
struct EpiG3 {
    float* H;
    __device__ __forceinline__ void operator()(const f32x4 (&acc)[2][2][4][2], const Unit& u, int wr, int wc, int fr, int fq) const {
        const int row0 = u.pm * BM + wr * 64 + fr, col0 = u.pn * BM + wc * 32 + 8 * fq;
#pragma unroll
        for (int ai = 0; ai < 2; ++ai)
#pragma unroll
            for (int m = 0; m < 4; ++m) { float* rowp = H + (size_t)(row0 + ai * HALF + m * 16) * 1024 + col0;
#pragma unroll
                for (int bj = 0; bj < 2; ++bj)
#pragma unroll
                    for (int n = 0; n < 2; ++n) { f32x4* p = (f32x4*)(rowp + bj * HALF + 4 * n); *p = *p + acc[ai][bj][m][n]; }
                asm volatile("" ::: "memory"); }
    }
};
struct EpiM1 {
    bf16_t* HACT;
    __device__ __forceinline__ void operator()(const f32x4 (&acc)[2][2][4][2], const Unit& u, int wr, int wc, int fr, int fq) const {
        bf16_t* base = HACT + (size_t)(u.pm * BM + wr * 64 + fr) * 512 + u.pn * 128 + wc * 32 + 8 * fq;
#pragma unroll
        for (int ai = 0; ai < 2; ++ai)
#pragma unroll
            for (int m = 0; m < 4; ++m) { const f32x4 g0 = acc[ai][0][m][0], g1 = acc[ai][0][m][1];
                st8(base + (size_t)(ai * HALF + m * 16) * 512, g0 * sig4(g0) * acc[ai][1][m][0], g1 * sig4(g1) * acc[ai][1][m][1]); }
    }
};
struct EpiM2 {
    bf16_t* Y;
    __device__ __forceinline__ void operator()(const f32x4 (&acc)[2][2][4][2], const Unit& u, int wr, int wc, int fr, int fq) const {
        bf16_t* base = Y + (size_t)(u.pm * BM + wr * 64 + fr) * 1024 + u.pn * BM + wc * 32 + 8 * fq;
#pragma unroll
        for (int ai = 0; ai < 2; ++ai)
#pragma unroll
            for (int m = 0; m < 4; ++m)
#pragma unroll
                for (int bj = 0; bj < 2; ++bj) st8(base + (size_t)(ai * HALF + m * 16) * 1024 + bj * HALF, acc[ai][bj][m][0], acc[ai][bj][m][1]);
    }
};

}
#include <hip/hip_bf16.h>
namespace attn_body {
using bf16=__hip_bfloat16;
using bf16x8=__attribute__((ext_vector_type(8)))short;
using s16x4=__attribute__((ext_vector_type(4)))short;
using f32x16=__attribute__((ext_vector_type(16)))float;
using f32x4=__attribute__((ext_vector_type(4)))float;
using u32x4=__attribute__((ext_vector_type(4)))unsigned;
constexpr int NHEAD=16,SEQ=8192,D=64,DM=NHEAD*D;
constexpr int NW=8,QBLK=32,QB=QBLK*NW,KVBLK=64,NQB=SEQ/QB;
constexpr int META_ROW=16384;
__device__ __forceinline__ int crow(int r,int hi){return (r&3)+8*(r>>2)+4*hi;}
#define SBAR() __builtin_amdgcn_sched_barrier(0)
__device__ __forceinline__ void cmask(f32x16&p0,f32x16&p1,int jb,int qrel,int hi){
  const float NEG=-INFINITY; int kb=64*jb+4*hi;
  #pragma unroll
  for(int r=0;r<16;++r){int kv=kb+(r&3)+8*(r>>2); if(kv>qrel)p0[r]=NEG; if(kv+32>qrel)p1[r]=NEG;}
}
constexpr int NSLOT=3, SLOTB=8192, MAXT=132;
constexpr int LDS_K=0, LDS_V=NSLOT*SLOTB, LDS_WS=2*NSLOT*SLOTB, LDS_OST=LDS_WS+NW*64*4, LDS_BL=LDS_OST+NW*4096, LDS_BYTES=LDS_BL+MAXT*256;
constexpr float C2=0.125f*1.4426950408889634f;
__device__ __forceinline__ void glds16(const void*gsrc,unsigned lds_dst){unsigned keep;
  asm volatile("s_mov_b32 %0, m0\n\ts_mov_b32 m0, %2\n\ts_nop 0\n\tglobal_load_lds_dwordx4 %1, off\n\ts_mov_b32 m0, %0":"=&s"(keep):"v"(gsrc),"s"(lds_dst):"memory");}
typedef float f32x2_t __attribute__((ext_vector_type(2))); typedef __bf16 bf16x2_t __attribute__((ext_vector_type(2)));
__device__ __forceinline__ unsigned cvtpk_s(float lo,float hi){f32x2_t v={lo,hi};bf16x2_t b=__builtin_convertvector(v,bf16x2_t);return __builtin_bit_cast(unsigned,b);}
#define WAIT_BAR(N) asm volatile("s_waitcnt vmcnt(" #N ") lgkmcnt(0)\n\ts_barrier":::"memory")
typedef __attribute__((address_space(3))) const char* lds_cptr;
typedef short v4i16_t __attribute__((ext_vector_type(4)));
__device__ __forceinline__ void kload8(bf16x8*kf,lds_cptr kp){
  kf[0]=*(const __attribute__((address_space(3))) bf16x8*)(kp);      kf[1]=*(const __attribute__((address_space(3))) bf16x8*)(kp+512);
  kf[2]=*(const __attribute__((address_space(3))) bf16x8*)(kp+2048); kf[3]=*(const __attribute__((address_space(3))) bf16x8*)(kp+2560);
  kf[4]=*(const __attribute__((address_space(3))) bf16x8*)(kp+4096); kf[5]=*(const __attribute__((address_space(3))) bf16x8*)(kp+4608);
  kf[6]=*(const __attribute__((address_space(3))) bf16x8*)(kp+6144); kf[7]=*(const __attribute__((address_space(3))) bf16x8*)(kp+6656);
}
__device__ __forceinline__ void kload2(bf16x8*kf,lds_cptr kp,int j){ kf[2*j]=*(const __attribute__((address_space(3))) bf16x8*)(kp+j*2048); kf[2*j+1]=*(const __attribute__((address_space(3))) bf16x8*)(kp+j*2048+512); }
__device__ __forceinline__ s16x4 vtr(lds_cptr p){ return __builtin_bit_cast(s16x4,__builtin_amdgcn_ds_read_tr16_b64_v4i16((__attribute__((address_space(3))) v4i16_t*)p)); }
__device__ __forceinline__ void binit(f32x16&p0,f32x16&p1,lds_cptr bl,float at){
  #pragma unroll
  for(int g=0;g<4;++g){ const f32x4 a=*(const __attribute__((address_space(3))) f32x4*)(bl+32*g), b=*(const __attribute__((address_space(3))) f32x4*)(bl+128+32*g);
    #pragma unroll
    for(int i=0;i<4;++i){p0[4*g+i]=a[i]+at;p1[4*g+i]=b[i]+at;} }
}
__device__ __forceinline__ void pv(f32x16*o,int vb,bf16x8 pa0,bf16x8 pa1,bf16x8 pa2,bf16x8 pa3){
  #pragma unroll
  for(int d0=0;d0<2;++d0){s16x4 lo[4],hi[4];
    #pragma unroll
    for(int ks=0;ks<4;++ks){
      asm volatile("ds_read_b64_tr_b16 %0,%1 offset:%c2":"=&v"(lo[ks]):"v"(vb),"i"(d0*4096+ks*1024):"memory");
      asm volatile("ds_read_b64_tr_b16 %0,%1 offset:%c2":"=&v"(hi[ks]):"v"(vb),"i"(d0*4096+ks*1024+512):"memory");}
    asm volatile("s_waitcnt lgkmcnt(0)":::"memory");SBAR();
    #define PK(k) (bf16x8){lo[k][0],lo[k][1],lo[k][2],lo[k][3],hi[k][0],hi[k][1],hi[k][2],hi[k][3]}
    o[d0]=__builtin_amdgcn_mfma_f32_32x32x16_bf16(pa0,PK(0),o[d0],0,0,0);
    o[d0]=__builtin_amdgcn_mfma_f32_32x32x16_bf16(pa1,PK(1),o[d0],0,0,0);
    o[d0]=__builtin_amdgcn_mfma_f32_32x32x16_bf16(pa2,PK(2),o[d0],0,0,0);
    o[d0]=__builtin_amdgcn_mfma_f32_32x32x16_bf16(pa3,PK(3),o[d0],0,0,0);
    #undef PK
  }
}
#ifndef ATTN_STORE16
#define ATTN_STORE16(p,v) (*(u32x4*)(p)=(v))
#endif
__device__ __forceinline__ void attn_unit(const int tid,int b,int h,int qb,int ts,const bf16*Q,const bf16*__restrict__ K,const bf16*__restrict__ V,bf16*O,const float*__restrict__ cb,const float*__restrict__ cbm,float m0,char*shm){
  const int lane=tid&63,r32=lane&31,hi=lane>>5; const int wid=__builtin_amdgcn_readfirstlane(tid>>6);
  const long rowbase=(long)b*SEQ; const int q0=qb*QB;
  const bf16*Qw=Q+(rowbase+q0+wid*QBLK)*DM+h*D;
  const bf16*Kh=K+rowbase*DM+h*D,*Vh=V+rowbase*DM+h*D;
  const bf16*Km=K+(long)META_ROW*DM+h*D,*Vm=V+(long)META_ROW*DM+h*D;
  const unsigned lds0=(unsigned)(uintptr_t)shm;
  float*wsf=(float*)(shm+LDS_WS)+wid*64;
  constexpr int PRE=2;
  const int NT=(q0+QB)/KVBLK-ts+PRE;
  { float*BLf=(float*)(shm+LDS_BL);
    for(int i=tid;i<NT*64;i+=NW*64){ const int ti=i>>6,j=i&63; float v;
      if(ti==0)v=-INFINITY; else if(ti==1)v=(j<16)?-cbm[j]:-INFINITY; else v=-cb[(ti-PRE+ts)*64+j];
      BLf[i]=v; } }
  const float at=cb[q0+wid*QBLK+r32]-m0;
  const long koff=(long)lane*DM+wid*8, voff=(long)(16*(wid&3)+(lane>>2))*DM+(wid>>2)*32+(lane&3)*8;
  const bf16*ksrc=Kh+koff+(long)(ts-PRE)*KVBLK*DM,*ksrm=Km+koff;
  const bf16*vsrc=Vh+voff+(long)(ts-PRE)*KVBLK*DM,*vsrm=Vm+voff;
  const unsigned kdst=lds0+LDS_K+wid*1024, vdst=lds0+LDS_V+wid*1024;
  #define DMA_K(t,slot) glds16(((t)<PRE)?ksrm:ksrc+(long)(t)*KVBLK*DM,(unsigned)__builtin_amdgcn_readfirstlane(kdst+(slot)))
  #define DMA_V(t,slot) glds16(((t)<PRE)?vsrm:vsrc+(long)(t)*KVBLK*DM,(unsigned)__builtin_amdgcn_readfirstlane(vdst+(slot)))
  const int vb0=(int)(lds0+LDS_V)+((lane>>4)&1)*32+(lane&3)*8+(4*hi+((lane&15)>>2))*64;
  bf16x8 kf[8];
  const lds_cptr shm3=(lds_cptr)shm; const lds_cptr kp0=shm3+LDS_K+hi*1024+r32*16; const lds_cptr vp0=shm3+LDS_V+((lane>>4)&1)*32+(lane&3)*8+(4*hi+((lane&15)>>2))*64;
  lds_cptr blp=shm3+LDS_BL+16*hi;
  DMA_K(0,0);DMA_V(0,0);DMA_K(1,SLOTB);
  bf16x8 qr[4];
  #pragma unroll
  for(int d0=0;d0<4;++d0)qr[d0]=*reinterpret_cast<const bf16x8*>(&Qw[(long)r32*DM+d0*16+hi*8]);
  float l_reg=0.f;f32x16 o[2];o[0]=f32x16{};o[1]=f32x16{};
  const int qrel=wid*QBLK+r32;
  #define CMASK(P0,P1,t) do{int jb_=(t)-(NT-4); if(jb_>=0)cmask(P0,P1,jb_,qrel,hi);}while(0)
  f32x16 pA0,pA1,pB0,pB1;
  int sl_prev=0,sl_cur=0,sl_next=SLOTB;
  #define ROT() do{sl_prev=sl_cur;sl_cur=sl_next;sl_next=(sl_next==(NSLOT-1)*SLOTB)?0:sl_next+SLOTB;}while(0)
  DMA_K(2,2*SLOTB);
  WAIT_BAR(3);
  binit(pA0,pA1,blp,at); blp+=256;
  { const lds_cptr kb=kp0;
    #pragma unroll
    for(int d0=0;d0<4;++d0){
      const bf16x8 b0=*(const __attribute__((address_space(3))) bf16x8*)(kb+d0*2048);
      const bf16x8 b1=*(const __attribute__((address_space(3))) bf16x8*)(kb+d0*2048+512);
      pA0=__builtin_amdgcn_mfma_f32_32x32x16_bf16(b0,qr[d0],pA0,0,0,0);pA1=__builtin_amdgcn_mfma_f32_32x32x16_bf16(b1,qr[d0],pA1,0,0,0);} }
  CMASK(pA0,pA1,0);
  _Pragma("unroll") for(int r=0;r<16;++r){pA0[r]=__builtin_amdgcn_exp2f(pA0[r]);pA1[r]=__builtin_amdgcn_exp2f(pA1[r]);}
  binit(pB0,pB1,blp,at); blp+=256;
  WAIT_BAR(0);
  DMA_K(3,0);DMA_V(1,SLOTB);
  ROT();
  kload8(kf,kp0+sl_cur);
  WAIT_BAR(2);
  s16x4 vlo[8],vhi[8]; u32x4 pw0,pw1,pw2,pw3;
  #define PKW(P,B) cvtpk_s(P[B],P[B+1])
  #define PAF(k) __builtin_bit_cast(bf16x8,pw##k)
  #define VFR(i) (bf16x8){vlo[i][0],vlo[i][1],vlo[i][2],vlo[i][3],vhi[i][0],vhi[i][1],vhi[i][2],vhi[i][3]}
  #define PIN(x) asm volatile("":"+v"(x))
  #define GAPA(MF,A0,A1,A2,A3,W0,W1,PW) do{ MF; sacc+=A0; sacc+=A1; sacc+=A2; sacc+=A3; PIN(sacc); W0; W1; PIN(PW); SBAR(); }while(0)
  #define EX(v) __builtin_amdgcn_exp2f(v)
  #define GAPB(MF,X,B) do{ MF; X[B]=EX(X[B]); X[B+1]=EX(X[B+1]); X[B+2]=EX(X[B+2]); X[B+3]=EX(X[B+3]); PIN(X); SBAR(); }while(0)
  #define VRD(i) do{ vlo[i]=vtr(vp_+(((i)>>2)*4096+((i)&3)*1024)); vhi[i]=vtr(vp_+(((i)>>2)*4096+((i)&3)*1024+512)); }while(0)
  #define KRD(G,j) do{ if(G){ kload2(kf,kp0+sl_next,j); SBAR(); } }while(0)
  #define BRD(G,P,g) do{ if(G){ const f32x4 t_=*(const __attribute__((address_space(3))) f32x4*)(blp+(((g)>>2)*128+((g)&3)*32)); P[4*((g)&3)]=t_[0];P[4*((g)&3)+1]=t_[1];P[4*((g)&3)+2]=t_[2];P[4*((g)&3)+3]=t_[3]; } }while(0)
  #define BAD(G,P,g) do{ if(G){ P[4*((g)&3)]+=at;P[4*((g)&3)+1]+=at;P[4*((g)&3)+2]+=at;P[4*((g)&3)+3]+=at; PIN(P); } }while(0)
  #define STEP(C0,C1,P0,P1,t,GK,GV,GL,GB) do{ SBAR(); \
    const lds_cptr vp_=vp0+sl_prev; \
    VRD(0); SBAR(); float sacc=(P0[0]+P0[1]); \
    GAPA(C0=__builtin_amdgcn_mfma_f32_32x32x16_bf16(kf[0],qr[0],C0,0,0,0), P0[2],P0[3],P0[4],P0[5],     pw0[0]=PKW(P0,0), pw0[1]=PKW(P0,2), pw0); \
    VRD(4); SBAR(); GAPA(C1=__builtin_amdgcn_mfma_f32_32x32x16_bf16(kf[1],qr[0],C1,0,0,0), P0[6],P0[7],P0[8],P0[9],     pw0[2]=PKW(P0,4), pw0[3]=PKW(P0,6), pw0); \
    VRD(1); SBAR(); GAPA(C0=__builtin_amdgcn_mfma_f32_32x32x16_bf16(kf[2],qr[1],C0,0,0,0),   P0[10],P0[11],P0[12],P0[13], pw1[0]=PKW(P0,8), pw1[1]=PKW(P0,10), pw1); \
    VRD(5); SBAR(); GAPA(C1=__builtin_amdgcn_mfma_f32_32x32x16_bf16(kf[3],qr[1],C1,0,0,0),   P0[14],P0[15],P1[0],P1[1],   pw1[2]=PKW(P0,12),pw1[3]=PKW(P0,14), pw1); \
    VRD(2); SBAR(); GAPA(C0=__builtin_amdgcn_mfma_f32_32x32x16_bf16(kf[4],qr[2],C0,0,0,0),   P1[2],P1[3],P1[4],P1[5],     pw2[0]=PKW(P1,0), pw2[1]=PKW(P1,2), pw2); \
    VRD(6); SBAR(); GAPA(C1=__builtin_amdgcn_mfma_f32_32x32x16_bf16(kf[5],qr[2],C1,0,0,0),   P1[6],P1[7],P1[8],P1[9],     pw2[2]=PKW(P1,4), pw2[3]=PKW(P1,6), pw2); \
    VRD(3); SBAR(); GAPA(C0=__builtin_amdgcn_mfma_f32_32x32x16_bf16(kf[6],qr[3],C0,0,0,0),   P1[10],P1[11],P1[12],P1[13], pw3[0]=PKW(P1,8), pw3[1]=PKW(P1,10), pw3); \
    VRD(7); SBAR(); GAPA(C1=__builtin_amdgcn_mfma_f32_32x32x16_bf16(kf[7],qr[3],C1,0,0,0),   P1[14],P1[15],0.f,0.f,       pw3[2]=PKW(P1,12),pw3[3]=PKW(P1,14), pw3); \
    l_reg+=sacc; \
    if(GK){DMA_K((t)+3,sl_cur);} if(GV){DMA_V((t)+1,sl_next);} \
    CMASK(C0,C1,t); \
    SBAR(); \
    BRD(GB,P0,0); GAPB(o[0]=__builtin_amdgcn_mfma_f32_32x32x16_bf16(PAF(0),VFR(0),o[0],0,0,0), C0,0); \
    BRD(GB,P0,1); BAD(GB,P0,0); GAPB(o[1]=__builtin_amdgcn_mfma_f32_32x32x16_bf16(PAF(0),VFR(4),o[1],0,0,0), C0,4); \
    BRD(GB,P0,2); BAD(GB,P0,1); KRD(GL,0); GAPB(o[0]=__builtin_amdgcn_mfma_f32_32x32x16_bf16(PAF(1),VFR(1),o[0],0,0,0), C0,8); \
    BRD(GB,P0,3); BAD(GB,P0,2); KRD(GL,1); GAPB(o[1]=__builtin_amdgcn_mfma_f32_32x32x16_bf16(PAF(1),VFR(5),o[1],0,0,0), C0,12); \
    BRD(GB,P1,4); BAD(GB,P0,3); KRD(GL,2); GAPB(o[0]=__builtin_amdgcn_mfma_f32_32x32x16_bf16(PAF(2),VFR(2),o[0],0,0,0), C1,0); \
    BRD(GB,P1,5); BAD(GB,P1,4); KRD(GL,3); GAPB(o[1]=__builtin_amdgcn_mfma_f32_32x32x16_bf16(PAF(2),VFR(6),o[1],0,0,0), C1,4); \
    BRD(GB,P1,6); BAD(GB,P1,5); GAPB(o[0]=__builtin_amdgcn_mfma_f32_32x32x16_bf16(PAF(3),VFR(3),o[0],0,0,0), C1,8); \
    BRD(GB,P1,7); BAD(GB,P1,6); GAPB(o[1]=__builtin_amdgcn_mfma_f32_32x32x16_bf16(PAF(3),VFR(7),o[1],0,0,0), C1,12); \
    BAD(GB,P1,7); if(GB){blp+=256;} \
    }while(0)
  int t=1;
  #undef CMASK
  #define CMASK(P0,P1,t) do{}while(0)
  for(;t+5<NT;t+=2){
    STEP(pB0,pB1,pA0,pA1,t,true,true,true,true);     WAIT_BAR(2); ROT();
    STEP(pA0,pA1,pB0,pB1,t+1,true,true,true,true);   WAIT_BAR(2); ROT();
  }
  #undef CMASK
  #define CMASK(P0,P1,t) do{int jb_=(t)-(NT-4); if(jb_>=0)cmask(P0,P1,jb_,qrel,hi);}while(0)
  #define ENDW(tt) do{ if((tt)+3<NT){WAIT_BAR(2);} else if((tt)+2<NT){WAIT_BAR(1);} else {WAIT_BAR(0);} }while(0)
  for(;t+1<NT;t+=2){
    STEP(pB0,pB1,pA0,pA1,t,(t+3<NT),(t+1<NT),(t+1<NT),(t+1<NT));       ENDW(t);   ROT();
    STEP(pA0,pA1,pB0,pB1,t+1,(t+4<NT),(t+2<NT),(t+2<NT),(t+2<NT));     ENDW(t+1); ROT();
  }
  STEP(pB0,pB1,pA0,pA1,NT-1,false,false,false,false);
  { float sacc=pB0[0]+pB0[1]; _Pragma("unroll") for(int r=2;r<16;++r)sacc+=pB0[r]; _Pragma("unroll") for(int r=0;r<16;++r)sacc+=pB1[r]; l_reg+=sacc;
    pw0=(u32x4){PKW(pB0,0),PKW(pB0,2),PKW(pB0,4),PKW(pB0,6)};pw1=(u32x4){PKW(pB0,8),PKW(pB0,10),PKW(pB0,12),PKW(pB0,14)};pw2=(u32x4){PKW(pB1,0),PKW(pB1,2),PKW(pB1,4),PKW(pB1,6)};pw3=(u32x4){PKW(pB1,8),PKW(pB1,10),PKW(pB1,12),PKW(pB1,14)};
    SBAR(); pv(o,vb0+sl_cur,PAF(0),PAF(1),PAF(2),PAF(3)); }
  #undef PKW
  #undef PAF
  #undef VFR
  #undef PIN
  #undef GAPA
  #undef GAPB
  #undef EX
  #undef VRD
  #undef KRD
  #undef BRD
  #undef BAD
  #undef STEP
  #undef ENDW
  {auto rr=__builtin_amdgcn_permlane32_swap(__float_as_uint(l_reg),__float_as_uint(l_reg),false,false);l_reg=__uint_as_float(rr[0])+__uint_as_float(rr[1]);}
  if(hi==0)wsf[32+r32]=l_reg;asm volatile("s_waitcnt lgkmcnt(0)":::"memory");
  float rli[16];
  #pragma unroll
  for(int r=0;r<16;++r)rli[r]=__builtin_amdgcn_rcpf(wsf[32+crow(r,hi)]);
  bf16*Ow=O+(rowbase+q0+wid*QBLK)*DM+h*D;
  { bf16*stg=(bf16*)(shm+LDS_OST)+wid*2048;
    #pragma unroll
    for(int r=0;r<16;++r){const int orow=crow(r,hi);
      #pragma unroll
      for(int d0=0;d0<2;++d0)stg[orow*64+d0*32+r32]=__float2bfloat16(o[d0][r]*rli[r]);}
    asm volatile("s_waitcnt lgkmcnt(0)":::"memory");
    #pragma unroll
    for(int i=0;i<4;++i){const int row=i*8+(lane>>3),ch=lane&7; const u32x4 v=*(const u32x4*)(stg+row*64+ch*8); ATTN_STORE16(Ow+(long)row*DM+ch*8,v);} }
  asm volatile("s_waitcnt lgkmcnt(0)\n\ts_barrier":::"memory");
  #undef DMA_K
  #undef DMA_V
  #undef CMASK
  #undef ROT
}
constexpr int ATTN_LDS_BYTES=LDS_BYTES;
#undef SBAR
#undef WAIT_BAR
}
constexpr int NWAVES = 8;
constexpr int BATCH = 2, SEQ = 8192, D = 1024, NH = 16, HD = 64, NMETA = 16, INC = 8208, NE = 32, DE = 512, DEPTH = 2;
constexpr int M = BATCH * SEQ;
constexpr int MROW = M;
constexpr int NTOK = M + NMETA;
constexpr int MP = 16640;
constexpr int SLOTS = 41216;
constexpr float EPS = 1e-6f, LOG2E = 1.4426950408889634f;
constexpr size_t MiB = 1u << 20;
constexpr size_t WS_CTL = 0, CTL_ZERO_BYTES = 1 * MiB;
constexpr size_t WS_FL = 1 * MiB;
constexpr size_t WS_CB = WS_FL + (size_t)MP * 16 * 4;
constexpr size_t WS_CBM = WS_CB + (size_t)32 * SEQ * 4;
constexpr size_t WS_PM = WS_CBM + 1024;
constexpr size_t WS_HNM = WS_PM + (size_t)16 * INC * 4;
constexpr size_t WS_YAINM = WS_HNM + 65536, WS_OM = WS_YAINM + 65536, WS_MGM = WS_OM + 65536;
constexpr size_t WS_RE = WS_MGM + 65536;
constexpr size_t WS_RP = WS_RE + (size_t)MP * 8;
constexpr size_t WS_RW = WS_RP + (size_t)MP * 8;
constexpr size_t WS_LIST = WS_RW + (size_t)MP * 8;
constexpr size_t WS_SMALL_END = WS_LIST + (size_t)NE * MP * 4;
static_assert(WS_SMALL_END <= 16 * MiB, "small buffers");
constexpr size_t WS_WD0 = 16 * MiB, WD_LAYER = 22 * MiB;
constexpr size_t WO_WC = 16 * MiB, WO_WA = 18 * MiB, WO_WM = 20 * MiB;
constexpr size_t WS_WGU = 60 * MiB, WS_WDN = 124 * MiB;
constexpr size_t WS_H = 156 * MiB;
constexpr size_t WS_ACT = 221 * MiB, ACT_STRIDE = (size_t)MP * D * 2;
constexpr size_t WS_XN = WS_ACT, WS_Z = WS_ACT + ACT_STRIDE, WS_BG = WS_ACT + 2 * ACT_STRIDE, WS_Q = WS_ACT + 3 * ACT_STRIDE, WS_K = WS_ACT + 4 * ACT_STRIDE, WS_V = WS_ACT + 5 * ACT_STRIDE,
                 WS_SGA = WS_ACT + 6 * ACT_STRIDE, WS_SGB = WS_ACT + 7 * ACT_STRIDE, WS_YAIN = WS_ACT + 8 * ACT_STRIDE, WS_END = WS_ACT + 9 * ACT_STRIDE;
constexpr size_t WS_MG = WS_Z;
constexpr size_t WS_HACT = WS_BG;
constexpr size_t WS_Y = WS_K;
static_assert(WS_HACT + (size_t)SLOTS * DE * 2 <= WS_K && WS_Y + (size_t)SLOTS * D * 2 <= WS_SGB, "MoE overlays");
constexpr int CW_TMO = 0, CW_CODE = 1, CW_BAR = 4096, CW_CNT = 16384;
constexpr int RING_OFF = 0, RING_BYTES = 131072;
constexpr int LDSCTL_OFF = 162816, MISC_OFF = LDSCTL_OFF + 320;
constexpr int LDS_BYTES = 163840;
constexpr int TOFF_OFF = MISC_OFF + 128;
static_assert(TOFF_OFF + 160 <= LDSCTL_OFF + 768 && LDSCTL_OFF + 768 + 19 * 8 <= LDS_BYTES && attn_body::ATTN_LDS_BYTES <= RING_BYTES, "LDS map");

#define GAS __attribute__((address_space(1)))
#define LAS __attribute__((address_space(3)))
typedef unsigned short bf16;
typedef unsigned v4u __attribute__((ext_vector_type(4)));
typedef unsigned v2u __attribute__((ext_vector_type(2)));
typedef float f32x4 __attribute__((ext_vector_type(4)));
typedef GAS unsigned gu32;
#define RLX_AGENT __ATOMIC_RELAXED, __HIP_MEMORY_SCOPE_AGENT
#define LDS_WAIT() asm volatile("s_waitcnt lgkmcnt(0)" ::: "memory")
#define VM_WAIT() asm volatile("s_waitcnt vmcnt(0)" ::: "memory")
__device__ __forceinline__ unsigned f2bf(float f) { unsigned u = __builtin_bit_cast(unsigned, f); return (u + 0x7fffu + ((u >> 16) & 1u)) >> 16; }
__device__ __forceinline__ unsigned pk2(float lo, float hi) { return f2bf(lo) | (f2bf(hi) << 16); }
__device__ __forceinline__ float bflo(unsigned w) { return __uint_as_float(w << 16); }
__device__ __forceinline__ float bfhi(unsigned w) { return __uint_as_float(w & 0xffff0000u); }

#define XB_TMO      128
#define XB_XCNT(j)  (256  + 64 * (j))
#define XB_XSUB(j)  (1280 + 64 * (j))
#define XB_XGEN(j)  (2304 + 64 * (j))
#define XB_TOP      3328
#define XB_TOPGEN   3392
#define XCD_BAR_WORDS 3456
#define XB_SPIN_CAP (1u << 18)
__device__ __forceinline__ unsigned xb_ld(unsigned* p)              { return __hip_atomic_load(p, __ATOMIC_RELAXED, __HIP_MEMORY_SCOPE_AGENT); }
__device__ __forceinline__ unsigned xb_add(unsigned* p, unsigned v) { return __hip_atomic_fetch_add(p, v, __ATOMIC_RELAXED, __HIP_MEMORY_SCOPE_AGENT); }
__device__ __forceinline__ unsigned xb_xcc_id() { return (unsigned)__builtin_amdgcn_s_getreg((3 << 11) | 20) & 0xFu; }
#define XB_SPIN(cond, bar) do { unsigned _sp = 0; while (cond) { __builtin_amdgcn_s_sleep(1); \
    if ((++_sp & 255u) == 0u) { if (xb_ld(&(bar)[XB_TMO])) break; if (_sp > XB_SPIN_CAP) { atomicAdd(&(bar)[XB_TMO], 1u); break; } } } } while (0)
struct XcdBarrier { unsigned* bar; unsigned x; volatile LAS unsigned* st; };
__device__ __forceinline__ XcdBarrier xcd_barrier_post(unsigned* bar, volatile LAS unsigned* st) {
    XcdBarrier b; b.bar = bar; b.x = xb_xcc_id(); b.st = st;
    if (threadIdx.x == 0) (void)xb_add(&bar[XB_XCNT(b.x)], 1u);
    return b;
}
__device__ __forceinline__ void xcd_barrier_complete(unsigned* bar, unsigned x, unsigned& nloc, unsigned& nx) {
    const unsigned G = gridDim.x * gridDim.y * gridDim.z;
    unsigned sum, cnt, mine, sp = 0u;
    for (;;) {
        sum = 0u; cnt = 0u; mine = 0u;
#pragma unroll
        for (unsigned j = 0; j < 16; ++j) { const unsigned c = xb_ld(&bar[XB_XCNT(j)]); sum += c; cnt += (c > 0u) ? 1u : 0u; mine = (j == x) ? c : mine; }
        if (sum == G) break;
        __builtin_amdgcn_s_sleep(1);
        if ((++sp & 255u) == 0u) { if (xb_ld(&bar[XB_TMO])) break; if (sp > XB_SPIN_CAP) { atomicAdd(&bar[XB_TMO], 1u); break; } }
    }
    nloc = mine > 0u ? mine : 1u; nx = cnt > 0u ? cnt : 1u;
}
__device__ __forceinline__ void xcd_barrier(const XcdBarrier& b) {
    asm volatile("s_waitcnt vmcnt(0)" ::: "memory");
    __syncthreads();
    if (threadIdx.x == 0) {
        unsigned* bar = b.bar;
        __builtin_amdgcn_s_waitcnt(0);
        unsigned nloc = b.st[0], nx = b.st[1];
        if (nloc == 0u) { xcd_barrier_complete(bar, b.x, nloc, nx); b.st[0] = nloc; b.st[1] = nx; }
        const unsigned old = xb_add(&bar[XB_XSUB(b.x)], 1u);
        const unsigned gen = old / nloc;
        if (old + 1u == (gen + 1u) * nloc) {
            __builtin_amdgcn_fence(__ATOMIC_RELEASE, "agent");
            asm volatile("s_waitcnt vmcnt(0)" ::: "memory");
            const unsigned og = xb_add(&bar[XB_TOP], 1u);
            const unsigned tg = og / nx;
            if (og + 1u == (tg + 1u) * nx) xb_add(&bar[XB_TOPGEN], 1u);
            else XB_SPIN(xb_ld(&bar[XB_TOPGEN]) == tg, bar);
            __builtin_amdgcn_fence(__ATOMIC_ACQUIRE, "agent");
            xb_add(&bar[XB_XGEN(b.x)], 1u);
            asm volatile("s_waitcnt vmcnt(0)" ::: "memory");
        } else {
            XB_SPIN(xb_ld(&bar[XB_XGEN(b.x)]) == gen, bar);
            __builtin_amdgcn_fence(__ATOMIC_ACQUIRE, "agent");
            asm volatile("s_waitcnt vmcnt(0)" ::: "memory");
        }
    }
    __syncthreads();
}

struct Frame {
    LAS unsigned char* lds; volatile LAS unsigned* MISC; gu32* ctl; unsigned char* ws;
    int tid, lane, wave, vcu, G, gw, NGW;
    float* out;
};
constexpr int INP_OFF = LDSCTL_OFF + 768;
typedef const float GAS* gcf;
__device__ __forceinline__ gcf inp_ld(Frame& F, int i) { const unsigned long long p = *(volatile LAS unsigned long long*)(F.lds + INP_OFF + 8 * i);
    const unsigned lo = __builtin_amdgcn_readfirstlane((unsigned)p), hi = __builtin_amdgcn_readfirstlane((unsigned)(p >> 32)); return (gcf)(((unsigned long long)hi << 32) | lo); }
#define INP(i) inp_ld(F, i)
__device__ __forceinline__ float wave_sum_l(float v, int lane) {
#pragma unroll
    for (int o = 1; o < 64; o <<= 1) v += pg8::shx(v, o, lane);
    return v;
}
__device__ __forceinline__ float wave_max_l(float v, int lane) {
#pragma unroll
    for (int o = 1; o < 64; o <<= 1) v = fmaxf(v, pg8::shx(v, o, lane));
    return v;
}
#define wave_sum(v) wave_sum_l(v, F.lane)
#define wave_max(v) wave_max_l(v, F.lane)
__device__ __forceinline__ void tr_block(gcf src, int ld, bf16* dst, int Kd, LAS float* scr, int lane) {
#pragma unroll 8
    for (int i = 0; i < 32; ++i) { const int kk = 2 * i + (lane >> 5); scr[kk * 33 + (lane & 31)] = src[(size_t)kk * ld + (lane & 31)]; }
    LDS_WAIT(); asm volatile("" ::: "memory");
    const int c = lane & 7;
#pragma unroll
    for (int j = 0; j < 4; ++j) { const int n = (lane >> 3) + 8 * j; const LAS float* s = scr + (8 * c) * 33 + n;
        v4u o; o.x = pk2(s[0 * 33], s[1 * 33]); o.y = pk2(s[2 * 33], s[3 * 33]); o.z = pk2(s[4 * 33], s[5 * 33]); o.w = pk2(s[6 * 33], s[7 * 33]);
        *(GAS v4u*)(dst + (size_t)n * Kd + 8 * c) = o; }
    LDS_WAIT(); asm volatile("" ::: "memory");
}
__device__ __forceinline__ int win_src_col(int n0) {
    const int pn = n0 >> 8, p = n0 & 255;
    if (pn < 8) return ((p >> 7) ? 2048 : 1024) + 128 * pn + (p & 127);
    if (pn < 12) return 256 * (pn - 8) + p;
    if (pn < 20) return (pn < 16 ? 3072 : 4096) + 256 * (pn & 3) + 64 * ((p >> 5) & 3) + 32 * (p >> 7);
    if (pn < 24) return 5120 + 256 * (pn & 3) + p;
    if (pn < 28) return 6160 + 256 * (pn & 3) + p;
    return 7184 + 256 * (pn & 3) + p;
}
constexpr int IT_WIN = 16 * 256, IT_SQ = 16 * 32, IT_DENSE = IT_WIN + 3 * IT_SQ;
constexpr int IT_GU = 16 * 32, IT_DN = 8 * 32, IT_EXP = IT_GU + IT_DN, IT_EXPL = NE * IT_EXP;
__device__ __forceinline__ void conv_dense_item(Frame& F, int l, int it, LAS float* scr) {
    unsigned char* wl = F.ws + WS_WD0 + (size_t)l * WD_LAYER;
    if (it < IT_WIN) { const int kb = it >> 8, nb = it & 255; tr_block(INP(3) + (size_t)l * D * INC + (size_t)(64 * kb) * INC + win_src_col(32 * nb), INC, (bf16*)wl + (size_t)(32 * nb) * D + 64 * kb, D, scr, F.lane); return; }
    it -= IT_WIN; const int w = it / IT_SQ, r = it % IT_SQ, kb = r >> 5, nb = r & 31;
    const size_t so = (size_t)l * D * D + (size_t)(64 * kb) * D + 32 * nb, dof = (size_t)(32 * nb) * D + 64 * kb;
    if (w == 0) tr_block(INP(6) + so, D, (bf16*)(wl + WO_WC) + dof, D, scr, F.lane);
    else if (w == 1) tr_block(INP(9) + so, D, (bf16*)(wl + WO_WA) + dof, D, scr, F.lane);
    else tr_block(INP(10) + so, D, (bf16*)(wl + WO_WM) + dof, D, scr, F.lane);
}
__device__ __forceinline__ void conv_expert_item(Frame& F, int l, int it, LAS float* scr) {
    const int e = it / IT_EXP; int r = it % IT_EXP;
    if (r < IT_GU) { const int kb = r >> 5, nb = r & 31, n0 = 32 * nb, ct = n0 >> 8, p = n0 & 255;
        const size_t so = ((size_t)l * NE + e) * D * DE + (size_t)(64 * kb) * DE + 128 * ct + (p & 127); bf16* dst = (bf16*)(F.ws + WS_WGU) + (size_t)e * D * D + (size_t)n0 * D + 64 * kb;
        if (p >> 7) tr_block(INP(17) + so, DE, dst, D, scr, F.lane); else tr_block(INP(16) + so, DE, dst, D, scr, F.lane);
        return; }
    r -= IT_GU; const int kb = r >> 5, nb = r & 31;
    tr_block(INP(18) + ((size_t)l * NE + e) * DE * D + (size_t)(64 * kb) * D + 32 * nb, D, (bf16*)(F.ws + WS_WDN) + (size_t)e * D * DE + (size_t)(32 * nb) * DE + 64 * kb, DE, scr, F.lane);
}
__device__ __forceinline__ void build_toff(Frame& F, int l) {
    LAS int* toff = (LAS int*)(F.lds + TOFF_OFF);
    if (F.tid == 0) { int run = 0; for (int e = 0; e < NE; ++e) { toff[e] = run; run += ((int)__hip_atomic_load(F.ctl + CW_CNT + 64 * l + e, RLX_AGENT) + 255) >> 8; } toff[NE] = run; }
    __syncthreads();
}
namespace pg8 {
struct SchedDense {
    const char* A; const char* B; int nM, nN, G, c, K;
    __device__ __forceinline__ bool next(int i, Unit& u) const { const int L = i * G + c; if (L >= nM * nN) return false; int pm, pn; tile_of(L, nM, nN, pm, pn); u.pm = pm; u.pn = pn; u.kind = 0; u.aux = 0;
        u.a = A + (size_t)pm * BM * K * 2; u.b = B + (size_t)pn * BM * K * 2; return true; }
    __device__ __forceinline__ void voff(const Unit&, int K_, const int (&R)[2], const int (&C)[2], unsigned (&vo)[2][2]) const {
#pragma unroll
        for (int h = 0; h < 2; ++h)
#pragma unroll
            for (int i = 0; i < 2; ++i) vo[h][i] = (unsigned)((R[i] + HALF * h) * K_ + C[i]) * 2u; }
};
struct SchedPair {
    const char *A0, *B0; long dA, dB; int c, lim;
    __device__ __forceinline__ bool next(int i, Unit& u) const { if (i >= lim) return false; int pm, pn; tile_of(c, 64, 4, pm, pn); u.pm = pm; u.pn = pn; u.kind = i; u.aux = 0;
        u.a = A0 + (i ? dA : 0) + (size_t)pm * BM * 1024 * 2; u.b = B0 + (i ? dB : 0) + (size_t)pn * BM * 1024 * 2; return true; }
    __device__ __forceinline__ void voff(const Unit&, int K_, const int (&R)[2], const int (&C)[2], unsigned (&vo)[2][2]) const {
#pragma unroll
        for (int h = 0; h < 2; ++h)
#pragma unroll
            for (int i = 0; i < 2; ++i) vo[h][i] = (unsigned)((R[i] + HALF * h) * K_ + C[i]) * 2u; }
};
struct SchedMoe {
    const char* A; const char* B; const int* list; const unsigned* cnt; const PG8_LAS int* toff; int G, c, K; size_t bstride; bool gather;
    __device__ __forceinline__ bool next(int i, Unit& u) const {
        const int L = i * G + c, total = __builtin_amdgcn_readfirstlane(toff[32]); if (L >= 4 * total) return false;
        const int rt = L >> 2, ct = L & 3; int e = 0; while (__builtin_amdgcn_readfirstlane(toff[e + 1]) <= rt) ++e;
        u.pm = rt; u.pn = ct; u.kind = e; u.aux = rt - __builtin_amdgcn_readfirstlane(toff[e]);
        u.a = gather ? A : A + (size_t)rt * BM * K * 2; u.b = B + (size_t)e * bstride + (size_t)ct * BM * K * 2; return true; }
    __device__ __forceinline__ void voff(const Unit& u, int K_, const int (&R)[2], const int (&C)[2], unsigned (&vo)[2][2]) const {
        const int n = (int)cnt[u.kind];
#pragma unroll
        for (int h = 0; h < 2; ++h)
#pragma unroll
            for (int i = 0; i < 2; ++i) { int row = R[i] + HALF * h;
                if (gather) { const int r = u.aux * BM + row; row = r < n ? (list[(size_t)u.kind * 16640 + r] >> 1) : 0; }
                vo[h][i] = (unsigned)(row * K_ + C[i]) * 2u; } }
};
}

__device__ __forceinline__ int slot_of(Frame& F, int tok, int k) {
    const LAS int* toff = (const LAS int*)(F.lds + TOFF_OFF);
    const int e = ((const int*)(F.ws + WS_RE))[tok * 2 + k], p = ((const int*)(F.ws + WS_RP))[tok * 2 + k];
    return 256 * toff[e] + p;
}
__device__ __forceinline__ void load_h_row(Frame& F, int l, int row, f32x4 (&v)[4]) {
    if (l == 0) { gcf src = row >= M ? INP(1) + (size_t)(row - M) * D : INP(0) + (size_t)row * D;
#pragma unroll
        for (int j = 0; j < 4; ++j) v[j] = ((const f32x4 GAS*)src)[F.lane + 64 * j]; return; }
    const float* hr = (const float*)(F.ws + WS_H) + (size_t)row * D;
    const int s0 = slot_of(F, row, 0), s1 = slot_of(F, row, 1); const float w0 = ((const float*)(F.ws + WS_RW))[row * 2], w1 = ((const float*)(F.ws + WS_RW))[row * 2 + 1];
    const bf16* y0 = (const bf16*)(F.ws + WS_Y) + (size_t)s0 * D; const bf16* y1 = (const bf16*)(F.ws + WS_Y) + (size_t)s1 * D;
#pragma unroll
    for (int j = 0; j < 4; ++j) { const f32x4 h = ((const f32x4*)hr)[F.lane + 64 * j]; const v2u a = ((const v2u*)y0)[F.lane + 64 * j], b = ((const v2u*)y1)[F.lane + 64 * j];
        v[j] = h + w0 * (f32x4){bflo(a.x), bfhi(a.x), bflo(a.y), bfhi(a.y)} + w1 * (f32x4){bflo(b.x), bfhi(b.x), bflo(b.y), bfhi(b.y)}; }
}
__device__ __forceinline__ void phase_t1(Frame& F, int l) {
    LAS float* wf = (LAS float*)(F.lds);
    { gcf win = INP(3) + (size_t)l * D * INC + 6144;
      for (int i = F.tid; i < 16 * D; i += NWAVES * 64) { const int k = i >> 4, j = i & 15; wf[j * D + k] = win[(size_t)k * INC + j]; } }
    if (l > 0) build_toff(F, l - 1); else __syncthreads();
    gcf g1 = INP(2) + (size_t)l * D; gcf bfg = INP(4) + l * 16;
    float* H = (float*)(F.ws + WS_H); bf16* XN = (bf16*)(F.ws + WS_XN); float* FL = (float*)(F.ws + WS_FL); float* HNM = (float*)(F.ws + WS_HNM);
    for (int row = F.gw; row < NTOK; row += F.NGW) {
        f32x4 v[4]; load_h_row(F, l, row, v);
        float ss = 0.f;
#pragma unroll
        for (int j = 0; j < 4; ++j) { ((f32x4*)(H + (size_t)row * D))[F.lane + 64 * j] = v[j]; ss += (v[j].x * v[j].x + v[j].y * v[j].y) + (v[j].z * v[j].z + v[j].w * v[j].w); }
        const float rstd = __builtin_amdgcn_rsqf(wave_sum(ss) * (1.f / D) + EPS);
#pragma unroll
        for (int j = 0; j < 4; ++j) { v[j] = v[j] * rstd * ((const f32x4 GAS*)g1)[F.lane + 64 * j];
            v2u o; o.x = pk2(v[j].x, v[j].y); o.y = pk2(v[j].z, v[j].w); ((v2u*)(XN + (size_t)row * D))[F.lane + 64 * j] = o;
            if (row >= M) ((f32x4*)(HNM + (size_t)(row - M) * D))[F.lane + 64 * j] = v[j]; }
        float mine = 0.f;
#pragma unroll 1
        for (int jh = 0; jh < 16; ++jh) { float s = 0.f;
#pragma unroll
            for (int j = 0; j < 4; ++j) { const f32x4 w = *(const LAS f32x4*)(wf + jh * D + 4 * F.lane + 256 * j); s += (v[j].x * w.x + v[j].y * w.y) + (v[j].z * w.z + v[j].w * w.w); }
            s = wave_sum(s); mine = (F.lane == jh) ? s : mine; }
        if (F.lane < 16) { const float f = mine + bfg[F.lane]; FL[(size_t)row * 16 + F.lane] = (fminf(f, 0.f) - log1pf(expf(-fabsf(f)))) * LOG2E; }
    }
    LAS float* scr = (LAS float*)(F.lds + 65536 + F.wave * 8448);
    if (l == 0) {
        for (int it = F.gw; it < 2 * IT_DENSE; it += F.NGW) conv_dense_item(F, it / IT_DENSE, it % IT_DENSE, scr);
    }
    for (int it = F.gw; it < IT_EXPL; it += F.NGW) conv_expert_item(F, l, it, scr);
}
__device__ __forceinline__ LAS float* meta_slice(Frame& F, const float* A, gcf W, int ld, int col0, int slot) {
    LAS float* Al = (LAS float*)F.lds; LAS float* red = (LAS float*)(F.lds + 65536); LAS float* out = (LAS float*)(F.lds + 98304 + 4096 * slot);
    __syncthreads();
    for (int i = F.tid; i < 16 * D; i += NWAVES * 64) { const int r = i >> 10, k = i & 1023; Al[k * 16 + r] = A[i]; }
    __syncthreads();
    float acc[16];
#pragma unroll
    for (int r = 0; r < 16; ++r) acc[r] = 0.f;
    gcf wp = W + col0 + F.lane; const int k0 = F.wave * 128;
#pragma unroll 4
    for (int k = k0; k < k0 + 128; ++k) { const float w = wp[(size_t)k * ld];
#pragma unroll
        for (int q = 0; q < 4; ++q) { const f32x4 a = *(const LAS f32x4*)(Al + k * 16 + 4 * q); acc[4 * q] += a.x * w; acc[4 * q + 1] += a.y * w; acc[4 * q + 2] += a.z * w; acc[4 * q + 3] += a.w * w; } }
#pragma unroll
    for (int r = 0; r < 16; ++r) red[(F.wave * 16 + r) * 64 + F.lane] = acc[r];
    __syncthreads();
#pragma unroll
    for (int q = 0; q < 2; ++q) { const int o = F.tid * 2 + q; float s = 0.f;
#pragma unroll
        for (int g = 0; g < 8; ++g) s += red[g * 1024 + o];
        out[o] = s; }
    __syncthreads();
    return out;
}
__device__ __forceinline__ void g1_side(Frame& F, int l) {
    const int c = blockIdx.x;
    const float* FL = (const float*)(F.ws + WS_FL);
    if (c < 32) {
        const int b = c >> 4, h = c & 15; LAS float* wsum = (LAS float*)(F.lds);
        float x[16]; float run = 0.f;
#pragma unroll
        for (int i = 0; i < 16; ++i) { run += FL[((size_t)b * SEQ + F.tid * 16 + i) * 16 + h]; x[i] = run; }
        float inc = run;
#pragma unroll
        for (int o = 1; o < 64; o <<= 1) { const float t = __int_as_float(__builtin_amdgcn_ds_bpermute(((F.lane - o) & 63) << 2, __float_as_int(inc))); if (F.lane >= o) inc += t; }
        if (F.lane == 63) wsum[F.wave] = inc;
        __syncthreads();
        float base = inc - run;
        for (int w = 0; w < F.wave; ++w) base += wsum[w];
        float* CB = (float*)(F.ws + WS_CB) + (size_t)c * SEQ + F.tid * 16;
#pragma unroll
        for (int i = 0; i < 16; ++i) CB[i] = base + x[i];
        if (c < 16 && F.tid == 0) { float cm[16]; float r2 = 0.f;
#pragma unroll
            for (int j = 0; j < 16; ++j) { r2 += FL[(size_t)(MROW + j) * 16 + c]; cm[j] = r2; }
#pragma unroll
            for (int j = 0; j < 16; ++j) ((float*)(F.ws + WS_CBM))[c * 16 + j] = cm[j] - r2; }
        __syncthreads();
    }
    if (c < 128) {
        const int col0 = c < 96 ? 64 * c : 6160 + 64 * (c - 96);
        LAS float* out = meta_slice(F, (const float*)(F.ws + WS_HNM), INP(3) + (size_t)l * D * INC, INC, col0, 0);
        float* PM = (float*)(F.ws + WS_PM);
#pragma unroll
        for (int rr = 0; rr < 2; ++rr) { const int r = 2 * F.wave + rr; float v = out[r * 64 + F.lane];
            if (col0 >= 3072 && col0 < 5120) { const float ss = wave_sum(v * v); const float g = (col0 < 4096 ? INP(7) : INP(8))[l * 64 + F.lane]; v = v * __builtin_amdgcn_rsqf(ss * (1.f / 64.f) + EPS) * g; }
            if (col0 >= 6160) v = 1.f / (1.f + __expf(-v));
            PM[(size_t)r * INC + col0 + F.lane] = v;
            if (col0 >= 4096 && col0 < 5120) ((bf16*)(F.ws + WS_K))[(size_t)(MROW + r) * D + (col0 - 4096) + F.lane] = (bf16)f2bf(v);
            if (col0 >= 5120 && col0 < 6144) ((bf16*)(F.ws + WS_V))[(size_t)(MROW + r) * D + (col0 - 5120) + F.lane] = (bf16)f2bf(v); }
        __syncthreads();
    }
}
__device__ __forceinline__ void a1_side(Frame& F, int l) {
    gcf cw = INP(5) + (size_t)l * 3 * D; const float* PM = (const float*)(F.ws + WS_PM);
    const bf16* Z = (const bf16*)(F.ws + WS_Z); const bf16* BG = (const bf16*)(F.ws + WS_BG); bf16* YAIN = (bf16*)(F.ws + WS_YAIN);
    for (int ci = F.gw; ci < M / 8; ci += F.NGW) {
        const int m0 = ci * 8, t0 = m0 & (SEQ - 1);
#pragma unroll
        for (int j = 0; j < 2; ++j) { const int d0 = 8 * F.lane + 512 * j;
            float w0[8], w1[8], w2[8], zp2[8], zp1[8];
#pragma unroll
            for (int i = 0; i < 8; ++i) { w0[i] = cw[d0 + i]; w1[i] = cw[D + d0 + i]; w2[i] = cw[2 * D + d0 + i]; }
            if (t0 == 0) {
#pragma unroll
                for (int i = 0; i < 8; ++i) { zp2[i] = PM[(size_t)14 * INC + 1024 + d0 + i] * PM[(size_t)14 * INC + 2048 + d0 + i]; zp1[i] = PM[(size_t)15 * INC + 1024 + d0 + i] * PM[(size_t)15 * INC + 2048 + d0 + i]; }
            } else { const v4u a = *(const v4u*)(Z + (size_t)(m0 - 2) * D + d0), b = *(const v4u*)(Z + (size_t)(m0 - 1) * D + d0);
                zp2[0] = bflo(a.x); zp2[1] = bfhi(a.x); zp2[2] = bflo(a.y); zp2[3] = bfhi(a.y); zp2[4] = bflo(a.z); zp2[5] = bfhi(a.z); zp2[6] = bflo(a.w); zp2[7] = bfhi(a.w);
                zp1[0] = bflo(b.x); zp1[1] = bfhi(b.x); zp1[2] = bflo(b.y); zp1[3] = bfhi(b.y); zp1[4] = bflo(b.z); zp1[5] = bfhi(b.z); zp1[6] = bflo(b.w); zp1[7] = bfhi(b.w); }
#pragma unroll
            for (int r = 0; r < 8; ++r) { const v4u zz = *(const v4u*)(Z + (size_t)(m0 + r) * D + d0), gg = *(const v4u*)(BG + (size_t)(m0 + r) * D + d0);
                float z[8], g[8], y[8];
                z[0] = bflo(zz.x); z[1] = bfhi(zz.x); z[2] = bflo(zz.y); z[3] = bfhi(zz.y); z[4] = bflo(zz.z); z[5] = bfhi(zz.z); z[6] = bflo(zz.w); z[7] = bfhi(zz.w);
                g[0] = bflo(gg.x); g[1] = bfhi(gg.x); g[2] = bflo(gg.y); g[3] = bfhi(gg.y); g[4] = bflo(gg.z); g[5] = bfhi(gg.z); g[6] = bflo(gg.w); g[7] = bfhi(gg.w);
#pragma unroll
                for (int i = 0; i < 8; ++i) { y[i] = g[i] * (w0[i] * zp2[i] + w1[i] * zp1[i] + w2[i] * z[i]); zp2[i] = zp1[i]; zp1[i] = z[i]; }
                v4u o; o.x = pk2(y[0], y[1]); o.y = pk2(y[2], y[3]); o.z = pk2(y[4], y[5]); o.w = pk2(y[6], y[7]);
                *(GAS v4u*)(YAIN + (size_t)(m0 + r) * D + d0) = o; }
        }
    }
    if (blockIdx.x == 0) {
        float* YAINM = (float*)(F.ws + WS_YAINM); float* OM = (float*)(F.ws + WS_OM); const float* CBM = (const float*)(F.ws + WS_CBM);
        for (int i = F.tid; i < 16 * D; i += NWAVES * 64) { const int r = i >> 10, d = i & 1023; float y = 0.f;
#pragma unroll
            for (int q = 0; q < 3; ++q) { const int rr = r - 2 + q; if (rr >= 0) y += PM[(size_t)rr * INC + 1024 + d] * PM[(size_t)rr * INC + 2048 + d] * cw[q * D + d]; }
            YAINM[i] = PM[(size_t)r * INC + d] * y; }
        if (F.tid < 256) { const int h = F.tid >> 4, r = F.tid & 15;
            const float* q = PM + (size_t)r * INC + 3072 + 64 * h; float sc[16]; float mx = -INFINITY;
#pragma unroll
            for (int s = 0; s < 16; ++s) { float dsum = 0.f; const float* k = PM + (size_t)s * INC + 4096 + 64 * h;
                for (int d = 0; d < 64; ++d) dsum += q[d] * k[d];
                sc[s] = (s <= r) ? dsum * attn_body::C2 + (CBM[h * 16 + r] - CBM[h * 16 + s]) : -INFINITY; mx = fmaxf(mx, sc[s]); }
            float lsum = 0.f;
#pragma unroll
            for (int s = 0; s < 16; ++s) { sc[s] = __builtin_amdgcn_exp2f(sc[s] - mx); lsum += sc[s]; }
            const float il = 1.f / lsum;
            for (int d = 0; d < 64; ++d) { float o = 0.f;
#pragma unroll
                for (int s = 0; s < 16; ++s) o += sc[s] * PM[(size_t)s * INC + 5120 + 64 * h + d];
                OM[(size_t)r * D + 64 * h + d] = o * il; } }
    }
}
__device__ __forceinline__ void g2_side(Frame& F, int l) {
    if (blockIdx.x >= 16) return;
    const int col0 = 64 * blockIdx.x; const float* PM = (const float*)(F.ws + WS_PM);
    LAS float* ya = meta_slice(F, (const float*)(F.ws + WS_YAINM), INP(6) + (size_t)l * D * D, D, col0, 0);
    LAS float* yb = meta_slice(F, (const float*)(F.ws + WS_OM), INP(9) + (size_t)l * D * D, D, col0, 1);
#pragma unroll
    for (int q = 0; q < 2; ++q) { const int o = F.tid * 2 + q, r = o >> 6, cc = o & 63;
        ((float*)(F.ws + WS_MGM))[(size_t)r * D + col0 + cc] = PM[(size_t)r * INC + 6160 + col0 + cc] * ya[o] + PM[(size_t)r * INC + 7184 + col0 + cc] * yb[o]; }
    __syncthreads();
}
__device__ __forceinline__ void g3_side(Frame& F, int l) {
    if (blockIdx.x >= 16) return;
    const int col0 = 64 * blockIdx.x;
    LAS float* y = meta_slice(F, (const float*)(F.ws + WS_MGM), INP(10) + (size_t)l * D * D, D, col0, 0);
#pragma unroll
    for (int q = 0; q < 2; ++q) { const int o = F.tid * 2 + q, r = o >> 6, cc = o & 63; ((float*)(F.ws + WS_H))[(size_t)(MROW + r) * D + col0 + cc] += y[o]; }
    __syncthreads();
}
__device__ __forceinline__ void phase_t2(Frame& F, int l) {
    LAS float* wr = (LAS float*)F.lds;
    { gcf wg = INP(12) + (size_t)l * D * 4; gcf we = INP(14) + (size_t)l * D * NE;
      for (int i = F.tid; i < D * 36; i += NWAVES * 64) { const int k = i / 36, c = i % 36; wr[i] = c < 4 ? wg[k * 4 + c] : we[k * NE + c - 4]; } }
    LAS int* lcnt = (LAS int*)(F.lds + 147456); LAS int* lbase = lcnt + 32; LAS int* rec = lbase + 32; LAS float* recw = (LAS float*)(rec + 80 * 4);
    if (F.tid < 32) lcnt[F.tid] = 0;
    __syncthreads();
    gcf g2 = INP(11) + (size_t)l * D; gcf bg = INP(13) + l * 4; gcf be = INP(15) + l * NE;
    const float* H = (const float*)(F.ws + WS_H); bf16* XN = (bf16*)(F.ws + WS_XN);
    const int c = blockIdx.x, nrows = (c < 16 && F.wave == 0) ? 9 : 8;
    for (int i = 0; i < nrows; ++i) {
        const int sl = i < 8 ? 8 * F.wave + i : 64, row = i < 8 ? 64 * c + sl : MROW + c;
        float x[16]; float ss = 0.f;
#pragma unroll
        for (int jj = 0; jj < 16; ++jj) { x[jj] = H[(size_t)row * D + F.lane + 64 * jj]; ss += x[jj] * x[jj]; }
        const float rstd = __builtin_amdgcn_rsqf(wave_sum(ss) * (1.f / D) + EPS);
        float acc[36];
#pragma unroll
        for (int q = 0; q < 36; ++q) acc[q] = 0.f;
#pragma unroll
        for (int jj = 0; jj < 16; ++jj) { const float hn = x[jj] * rstd * g2[F.lane + 64 * jj]; XN[(size_t)row * D + F.lane + 64 * jj] = (bf16)f2bf(hn);
            const LAS float* wrow = wr + (F.lane + 64 * jj) * 36;
#pragma unroll
            for (int q = 0; q < 9; ++q) { const f32x4 w = *(const LAS f32x4*)(wrow + 4 * q); acc[4 * q] += hn * w.x; acc[4 * q + 1] += hn * w.y; acc[4 * q + 2] += hn * w.z; acc[4 * q + 3] += hn * w.w; } }
#pragma unroll
        for (int q = 0; q < 36; ++q) acc[q] = wave_sum(acc[q]);
        float gl[4]; int gi = 0;
#pragma unroll
        for (int j = 0; j < 4; ++j) gl[j] = acc[j] + bg[j];
        float gb = gl[0];
#pragma unroll
        for (int j = 1; j < 4; ++j) if (gl[j] > gb) { gb = gl[j]; gi = j; }
        float gs = 0.f;
#pragma unroll
        for (int j = 0; j < 4; ++j) gs += expf(gl[j] - gb);
        const float gw = 1.f / gs;
        float el[8];
#pragma unroll
        for (int j = 0; j < 8; ++j) el[j] = (gi == 0 ? acc[4 + j] : gi == 1 ? acc[12 + j] : gi == 2 ? acc[20 + j] : acc[28 + j]) + be[gi * 8 + j];
        int i1 = 0; float b1 = el[0];
#pragma unroll
        for (int j = 1; j < 8; ++j) if (el[j] > b1) { b1 = el[j]; i1 = j; }
        int i2 = -1; float b2 = -INFINITY;
#pragma unroll
        for (int j = 0; j < 8; ++j) if (j != i1 && (i2 < 0 || el[j] > b2)) { b2 = el[j]; i2 = j; }
        const float p2 = expf(b2 - b1), w1 = gw / (1.f + p2), w2 = gw * p2 / (1.f + p2);
        if (F.lane == 0) { const int e1 = gi * 8 + i1, e2 = gi * 8 + i2;
            rec[sl * 4 + 0] = e1; rec[sl * 4 + 1] = __hip_atomic_fetch_add(lcnt + e1, 1, __ATOMIC_RELAXED, __HIP_MEMORY_SCOPE_WORKGROUP);
            rec[sl * 4 + 2] = e2; rec[sl * 4 + 3] = __hip_atomic_fetch_add(lcnt + e2, 1, __ATOMIC_RELAXED, __HIP_MEMORY_SCOPE_WORKGROUP);
            recw[sl * 2] = w1; recw[sl * 2 + 1] = w2; }
    }
    __syncthreads();
    if (F.tid < 32) { const int n = lcnt[F.tid]; lbase[F.tid] = n ? (int)__hip_atomic_fetch_add(F.ctl + CW_CNT + 64 * l + F.tid, (unsigned)n, RLX_AGENT) : 0; }
    __syncthreads();
    if (F.tid < 65 && (F.tid < 64 || c < 16)) { const int sl = F.tid, tok = sl < 64 ? 64 * c + sl : MROW + c;
#pragma unroll
        for (int k = 0; k < 2; ++k) { const int e = rec[sl * 4 + 2 * k], pos = lbase[e] + rec[sl * 4 + 2 * k + 1];
            ((int*)(F.ws + WS_LIST))[(size_t)e * MP + pos] = 2 * tok + k; ((int*)(F.ws + WS_RE))[2 * tok + k] = e; ((int*)(F.ws + WS_RP))[2 * tok + k] = pos; ((float*)(F.ws + WS_RW))[2 * tok + k] = recw[sl * 2 + k]; } }
}
__device__ __forceinline__ void a1_meta(Frame& F, int l) {
    if (blockIdx.x >= 16) return;
    const int h = blockIdx.x; gcf cw = INP(5) + (size_t)l * 3 * D; const float* PM = (const float*)(F.ws + WS_PM);
    float* YAINM = (float*)(F.ws + WS_YAINM); float* OM = (float*)(F.ws + WS_OM); const float* CBM = (const float*)(F.ws + WS_CBM);
#pragma unroll
    for (int q2 = 0; q2 < 2; ++q2) { const int o = F.tid * 2 + q2, r = o >> 6, d = 64 * h + (o & 63); float y = 0.f;
#pragma unroll
        for (int q = 0; q < 3; ++q) { const int rr = r - 2 + q; if (rr >= 0) y += PM[(size_t)rr * INC + 1024 + d] * PM[(size_t)rr * INC + 2048 + d] * cw[q * D + d]; }
        YAINM[(size_t)r * D + d] = PM[(size_t)r * INC + d] * y; }
    LAS float* sc = (LAS float*)F.lds;
    __syncthreads();
    if (F.tid < 256) { const int r = F.tid >> 4, s = F.tid & 15; const f32x4* q = (const f32x4*)(PM + (size_t)r * INC + 3072 + 64 * h); const f32x4* k = (const f32x4*)(PM + (size_t)s * INC + 4096 + 64 * h); float dsum = 0.f;
#pragma unroll
        for (int d = 0; d < 16; ++d) { const f32x4 a = q[d], b = k[d]; dsum += (a.x * b.x + a.y * b.y) + (a.z * b.z + a.w * b.w); }
        sc[F.tid] = (s <= r) ? dsum * attn_body::C2 + (CBM[h * 16 + r] - CBM[h * 16 + s]) : -INFINITY; }
    __syncthreads();
    if (F.tid < 16) { float mx = -INFINITY, ls = 0.f;
#pragma unroll
        for (int s = 0; s < 16; ++s) mx = fmaxf(mx, sc[F.tid * 16 + s]);
        float p[16];
#pragma unroll
        for (int s = 0; s < 16; ++s) { p[s] = __builtin_amdgcn_exp2f(sc[F.tid * 16 + s] - mx); ls += p[s]; }
        const float il = 1.f / ls;
#pragma unroll
        for (int s = 0; s < 16; ++s) sc[F.tid * 16 + s] = p[s] * il; }
    __syncthreads();
#pragma unroll
    for (int q2 = 0; q2 < 2; ++q2) { const int o = F.tid * 2 + q2, r = o >> 6, d = o & 63; float acc = 0.f;
#pragma unroll
        for (int s = 0; s < 16; ++s) acc += sc[r * 16 + s] * PM[(size_t)s * INC + 5120 + 64 * h + d];
        OM[(size_t)r * D + 64 * h + d] = acc; }
    __syncthreads();
}
__device__ __forceinline__ void phase_attn(Frame& F, int l, char* lds_generic) {
    const float mq = wave_max(fabsf(INP(7)[l * 64 + F.lane])), mk = wave_max(fabsf(INP(8)[l * 64 + F.lane]));
    const float m0 = 8.f * LOG2E * mq * mk * 1.02f + 0.25f;
    const attn_body::bf16* Q = (const attn_body::bf16*)(F.ws + WS_Q); const attn_body::bf16* K = (const attn_body::bf16*)(F.ws + WS_K); const attn_body::bf16* V = (const attn_body::bf16*)(F.ws + WS_V);
    for (int L = F.vcu; L < 1024; L += F.G) { const int i = L >> 8, v = L & 255, bh = v >> 3, s = v & 7; const int qb = (i == 0) ? s : (i == 1) ? 15 - s : (i == 2) ? 16 + s : 31 - s;
        attn_body::attn_unit(F.tid, bh >> 4, bh & 15, qb, 0, Q, K, V, (attn_body::bf16*)(F.ws + WS_Q), (const float*)(F.ws + WS_CB) + (size_t)bh * SEQ, (const float*)(F.ws + WS_CBM) + (bh & 15) * 16, m0, lds_generic); }
}
__device__ __forceinline__ void phase_out(Frame& F) {
    build_toff(F, 1);
    for (int row = F.gw; row < M; row += F.NGW) { f32x4 v[4]; load_h_row(F, 1, row, v);
#pragma unroll
        for (int j = 0; j < 4; ++j) ((f32x4*)(F.out + (size_t)row * D))[F.lane + 64 * j] = v[j]; }
}

#ifndef MK_N_LAUNCHES
#define MK_N_LAUNCHES 1
#endif
constexpr int N_PHASES = 17;
struct Args { const float* in[19]; float* out; unsigned char* ws; int ph_lo, ph_hi, li, two; };
__global__ void __launch_bounds__(NWAVES * 64, 2) fwd_kernel(Args args) {
    extern __shared__ __attribute__((aligned(16))) unsigned char lds[];
    Frame F;
    F.lds = (LAS unsigned char*)lds; F.MISC = (volatile LAS unsigned*)(F.lds + MISC_OFF);
    F.tid = threadIdx.x; F.lane = F.tid & 63; F.wave = __builtin_amdgcn_readfirstlane(F.tid >> 6);
    F.G = gridDim.x; { const int bx = blockIdx.x; F.vcu = (F.G % 8 == 0) ? (bx % 8) * (F.G / 8) + bx / 8 : bx; }
    F.gw = F.vcu * NWAVES + F.wave; F.NGW = F.G * NWAVES;
    F.ws = args.ws; F.ctl = (gu32*)(args.ws + WS_CTL); F.out = args.out;
    for (int u = F.tid; u < (LDS_BYTES - LDSCTL_OFF) / 4; u += NWAVES * 64) ((LAS unsigned*)(F.lds + LDSCTL_OFF))[u] = 0u;
    __syncthreads();
    if (F.tid == 0) {
#pragma unroll
        for (int i = 0; i < 19; ++i) *(LAS unsigned long long*)(F.lds + INP_OFF + 8 * i) = (unsigned long long)args.in[i]; }
    __syncthreads();
    XcdBarrier bar = xcd_barrier_post((unsigned*)(F.ctl + CW_BAR) + args.li * XCD_BAR_WORDS, F.MISC + 8);
    const int lo = args.ph_lo, hi = args.ph_hi; int ph = 0; const int wave_s = F.wave;
#ifndef SUBMASK
#define SUBMASK 7
#endif
#ifndef PHMASK
#define PHMASK 0x1ff
#endif
#define PHB(k) if (((PHMASK >> (k)) & 1) && lo <= ph && ph < hi) { { int ot_ = wave_s * 64 + (int)__builtin_amdgcn_mbcnt_hi(~0u, __builtin_amdgcn_mbcnt_lo(~0u, 0u)); asm volatile("" : "+v"(ot_)); F.tid = ot_; F.lane = ot_ & 63; F.wave = __builtin_amdgcn_readfirstlane(ot_ >> 6); F.gw = F.vcu * NWAVES + F.wave; size_t z_ = 0; asm volatile("" : "+s"(z_)); F.ws = args.ws + z_; F.ctl = (gu32*)(F.ws + WS_CTL); }
#define PH_END   if (ph + 1 < hi) xcd_barrier(bar); } ++ph;
    if (lo == 0) {
        for (int i = F.gw * 64 + F.lane; i < 2 * 64 * D / 8; i += F.NGW * 64) { const int wbuf = i / (64 * D / 8), r = i % (64 * D / 8);
            ((GAS v4u*)(F.ws + (wbuf ? WS_V : WS_K) + (size_t)MROW * D * 2))[r] = (v4u){0u, 0u, 0u, 0u}; } }
    for (int l = 0; l < DEPTH; ++l) {
        unsigned char* wl = F.ws + WS_WD0 + (size_t)l * WD_LAYER;
        PHB(0) phase_t1(F, l); PH_END
        PHB(1) if (SUBMASK & 1) g1_side(F, l); if (SUBMASK & 2)
            { pg8::SchedDense S{(const char*)(F.ws + WS_XN), (const char*)wl, 64, 32, F.G, (int)blockIdx.x, D};
              pg8::EpiG1 E{(bf16*)(F.ws + WS_ACT), ACT_STRIDE / 2, INP(7) + l * 64, attn_body::C2, (long)(INP(8) - INP(7))};
              pg8::gemm_phase<pg8::EpiG1, pg8::SchedDense, true>(F.tid, F.lds + RING_OFF, D, S, E); }
        PH_END
        PHB(2) if (SUBMASK & 1) a1_side(F, l); if (SUBMASK & 2) a1_meta(F, l); if (SUBMASK & 4) phase_attn(F, l, (char*)lds + RING_OFF); PH_END
        PHB(3) if (SUBMASK & 1) g2_side(F, l); if (SUBMASK & 2)
            { pg8::SchedPair S{(const char*)(F.ws + WS_YAIN), (const char*)(wl + WO_WC), (long)WS_Q - (long)WS_YAIN, (long)WO_WA - (long)WO_WC, (int)blockIdx.x, args.two};
              pg8::EpiG2 E{(bf16*)(F.ws + WS_MG), (const bf16*)(F.ws + WS_SGA), ACT_STRIDE / 2};
              if (blockIdx.x < 256) pg8::gemm_phase<pg8::EpiG2, pg8::SchedPair, true>(F.tid, F.lds + RING_OFF, D, S, E); }
        PH_END
        PHB(4) g3_side(F, l);
            { pg8::SchedDense S{(const char*)(F.ws + WS_MG), (const char*)(wl + WO_WM), 64, 4, F.G, (int)blockIdx.x, D};
              pg8::EpiG3 E{(float*)(F.ws + WS_H)};
              pg8::gemm_phase<pg8::EpiG3, pg8::SchedDense, true>(F.tid, F.lds + RING_OFF, D, S, E); }
        PH_END
        PHB(5) phase_t2(F, l); PH_END
        PHB(6) build_toff(F, l);
            { pg8::SchedMoe S{(const char*)(F.ws + WS_XN), (const char*)(F.ws + WS_WGU), (const int*)(F.ws + WS_LIST), (const unsigned*)(F.ctl + CW_CNT + 64 * l), (const LAS int*)(F.lds + TOFF_OFF), F.G, F.vcu, D, (size_t)D * D * 2, true};
              pg8::EpiM1 E{(bf16*)(F.ws + WS_HACT)};
              pg8::gemm_phase<pg8::EpiM1, pg8::SchedMoe, true>(F.tid, F.lds + RING_OFF, D, S, E); }
        PH_END
        PHB(7) build_toff(F, l);
            { pg8::SchedMoe S{(const char*)(F.ws + WS_HACT), (const char*)(F.ws + WS_WDN), (const int*)(F.ws + WS_LIST), (const unsigned*)(F.ctl + CW_CNT + 64 * l), (const LAS int*)(F.lds + TOFF_OFF), F.G, F.vcu, DE, (size_t)D * DE * 2, false};
              pg8::EpiM2 E{(bf16*)(F.ws + WS_Y)};
              pg8::gemm_phase<pg8::EpiM2, pg8::SchedMoe, true>(F.tid, F.lds + RING_OFF, DE, S, E); }
        PH_END
    }
    PHB(8) phase_out(F); PH_END
#undef PHB
#undef PH_END
}

extern "C" void kernel_launch(void* const* d_in, const int* in_sizes, int n_in, void* d_out, int out_size, void* d_ws, size_t ws_size, hipStream_t stream) {
    static int grid = 0;
    if (grid == 0) {
        if (n_in != 19 || in_sizes[0] != M * D || out_size != M * D || ws_size < WS_END) { fprintf(stderr, "kernel_launch: unexpected shapes / workspace (n_in %d, in0 %d, out %d, ws %zu, need %zu); nothing launched\n", n_in, n_in > 0 ? in_sizes[0] : -1, out_size, ws_size, (size_t)WS_END); grid = -1; return; }
        int dev = 0, cus = 0, per_cu = 0;
        if (hipGetDevice(&dev) != hipSuccess || hipDeviceGetAttribute(&cus, hipDeviceAttributeMultiprocessorCount, dev) != hipSuccess) { grid = -1; return; }
        if (hipFuncSetAttribute((const void*)fwd_kernel, hipFuncAttributeMaxDynamicSharedMemorySize, LDS_BYTES) != hipSuccess) { fprintf(stderr, "kernel_launch: hipFuncSetAttribute failed\n"); grid = -1; return; }
        if (hipOccupancyMaxActiveBlocksPerMultiprocessor(&per_cu, (const void*)fwd_kernel, NWAVES * 64, LDS_BYTES) != hipSuccess || per_cu < 1) fprintf(stderr, "kernel_launch: note: occupancy query reports %d workgroups per CU\n", per_cu);
        (void)hipGetLastError();
        grid = cus;
        if (grid != 256) fprintf(stderr, "kernel_launch: note: %d CUs (tuned for 256)\n", grid);
    }
    if (grid < 0) return;
    if (hipMemsetAsync((char*)d_ws + WS_CTL, 0, CTL_ZERO_BYTES, stream) != hipSuccess) return;
    Args a{};
    for (int i = 0; i < 19; ++i) a.in[i] = (const float*)d_in[i];
    a.out = (float*)d_out; a.ws = (unsigned char*)d_ws; a.two = 2;
#if MK_N_LAUNCHES == 1
    a.ph_lo = 0; a.ph_hi = N_PHASES; a.li = 0;
    hipLaunchKernelGGL(fwd_kernel, dim3(grid), dim3(NWAVES * 64), LDS_BYTES, stream, a);
#else
    for (int p = 0; p < N_PHASES; ++p) { a.ph_lo = p; a.ph_hi = p + 1; a.li = 0; hipLaunchKernelGGL(fwd_kernel, dim3(grid), dim3(NWAVES * 64), LDS_BYTES, stream, a); }
#endif
}
```

```cpp
#include <hip/hip_runtime.h>
#include <cstdio>
#include <cstdint>
#include <cmath>
namespace pg8 {
#define PG8_LAS __attribute__((address_space(3)))
typedef unsigned short bf16_t;
typedef short bf16x8 __attribute__((ext_vector_type(8)));
typedef float f32x4 __attribute__((ext_vector_type(4)));
typedef float f32x2 __attribute__((ext_vector_type(2)));
typedef unsigned u32x4 __attribute__((ext_vector_type(4)));
__device__ __forceinline__ float shx(float v, int m, int lane) { return __int_as_float(__builtin_amdgcn_ds_bpermute((lane ^ m) << 2, __float_as_int(v))); }
constexpr int BM = 256, BK = 64, HALF = 128, HTB = HALF * BK * 2  , STAGE_BYTES = 8 * HTB, NXCD = 8, WGM = 8;

__host__ __device__ __forceinline__ int lds_byte(int r, int c) { const int st = (r >> 4) * 2 + (c >> 5), rr = r & 15, cc = c & 31, ob = rr * 64 + cc * 2; return st * 1024 + (ob ^ (((ob >> 9) & 1) << 5)); }
__host__ __device__ __forceinline__ void stage_rc(int b, int& R, int& C) { const int st = b / 1024, sb = b % 1024, swz = sb ^ (((sb >> 9) & 1) << 5); R = (st >> 1) * 16 + swz / 64; C = (st & 1) * 32 + (swz % 64) / 2; }
__host__ __device__ __forceinline__ int perm32(int rho) { const int n = rho >> 4, i = rho & 15; return 8 * (i >> 2) + 4 * n + (i & 3); }

struct Unit { const char* a; const char* b; int kind, pm, pn, aux; };

__device__ __forceinline__ void tile_of(int L, int nM, int nN, int& pm, int& pn) {
    const int nwg = nM * nN; int wgid = L; { const int q = nwg / NXCD, r = nwg % NXCD, xcd = wgid % NXCD, off = wgid / NXCD; wgid = (xcd < r ? xcd * (q + 1) : r * (q + 1) + (xcd - r) * q) + off; }
    const int nig = WGM * nN, gid = wgid / nig, fm = gid * WGM, gsz = (nM - fm) < WGM ? (nM - fm) : WGM;
    pm = fm + ((wgid % nig) % gsz); pn = (wgid % nig) / gsz;
}
__device__ __forceinline__ unsigned cvt_pk_bf16(float lo, float hi) { unsigned r; asm volatile("v_cvt_pk_bf16_f32 %0, %1, %2" : "=v"(r) : "v"(lo), "v"(hi)); return r; }
__device__ __forceinline__ float bf_lo(unsigned w) { return __uint_as_float(w << 16); }
__device__ __forceinline__ float bf_hi(unsigned w) { return __uint_as_float(w & 0xffff0000u); }
__device__ __forceinline__ float sigmoidf_fast(float x) { return __builtin_amdgcn_rcpf(1.0f + __builtin_amdgcn_exp2f(-1.4426950408889634f * x)); }

template <class Epi, class Sched, bool ALIGN_EPI>
__device__ __forceinline__ void gemm_phase(const int tid, PG8_LAS unsigned char* lds, const int K, const Sched& S, const Epi& E) {
    const int wid = __builtin_amdgcn_readfirstlane(tid >> 6), lane = tid & 63, wr = wid >> 2, wc = wid & 3, fr = lane & 15, fq = lane >> 4;
    const int nt = K / BK;
    int sR[2], sC[2]; unsigned voffB[2];
#pragma unroll
    for (int i = 0; i < 2; ++i) { stage_rc(tid * 16 + i * 8192, sR[i], sC[i]); const int Rb = (sR[i] & ~31) + perm32(sR[i] & 31); voffB[i] = (unsigned)(Rb * K + sC[i]) * 2u; }
    const size_t kstep = (size_t)(BK * 2);
    const size_t hstep = (size_t)HALF * K * 2;
    const unsigned ldsw = (unsigned)wid * 1024u;
    const int aoff = lds_byte(wr * 64 + fr, fq * 8), boff = lds_byte(wc * 32 + fr, fq * 8);
#define PG8_SA(b, h) (((b) * 2 + (h)) * HTB)
#define PG8_SB(b, h) ((4 + (b) * 2 + (h)) * HTB)
#define PG8_STAGE(bufoff, gbase, v0, v1) do { \
        __builtin_amdgcn_global_load_lds((const unsigned*)((const char*)(gbase) + (v0)), (PG8_LAS unsigned*)(lds + (bufoff) + ldsw), 16, 0, 0); \
        __builtin_amdgcn_global_load_lds((const unsigned*)((const char*)(gbase) + (v1)), (PG8_LAS unsigned*)(lds + (bufoff) + ldsw + 8192), 16, 0, 0); } while (0)
#define PG8_STAGEB(bufoff, gbase) PG8_STAGE(bufoff, gbase, voffB[0], voffB[1])
#define PG8_LDA(dst, b, h) do { _Pragma("unroll") for (int m = 0; m < 4; ++m) _Pragma("unroll") for (int k = 0; k < 2; ++k) dst[m][k] = *(const PG8_LAS bf16x8*)(lds + PG8_SA(b, h) + aoff + m * 2048 + k * 1024); } while (0)
#define PG8_LDB(dst, b, h) do { _Pragma("unroll") for (int n = 0; n < 2; ++n) _Pragma("unroll") for (int k = 0; k < 2; ++k) dst[n][k] = *(const PG8_LAS bf16x8*)(lds + PG8_SB(b, h) + boff + n * 2048 + k * 1024); } while (0)
#define PG8_MMA(ai, bj, At, Bt) do { __builtin_amdgcn_s_setprio(1); _Pragma("unroll") for (int m = 0; m < 4; ++m) _Pragma("unroll") for (int n = 0; n < 2; ++n) _Pragma("unroll") for (int k = 0; k < 2; ++k) \
        acc[ai][bj][m][n] = __builtin_amdgcn_mfma_f32_16x16x32_bf16(Bt[n][k], At[m][k], acc[ai][bj][m][n], 0, 0, 0); __builtin_amdgcn_s_setprio(0); } while (0)
#define PG8_WAIT_V(n) asm volatile("s_waitcnt vmcnt(" #n ")" ::: "memory")
#define PG8_WAIT_L(n) asm volatile("s_waitcnt lgkmcnt(" #n ")" ::: "memory")
#define PG8_BAR __builtin_amdgcn_s_barrier()
#define PG8_SCHED __builtin_amdgcn_sched_barrier(0)
    Unit cur, nxt; int ui = 0;
    if (!S.next(0, cur)) return;
    f32x4 acc[2][2][4][2];
#pragma unroll
    for (int a = 0; a < 2; ++a)
#pragma unroll
        for (int b = 0; b < 2; ++b)
#pragma unroll
            for (int m = 0; m < 4; ++m)
#pragma unroll
                for (int n = 0; n < 2; ++n) acc[a][b][m][n] = (f32x4){0.f, 0.f, 0.f, 0.f};
    bf16x8 At[4][2], B0[2][2], B1[2][2];
    unsigned vA[2][2], vN[2][2];
    S.voff(cur, K, sR, sC, vA);
    const char* cA = cur.a; const char* cB = cur.b;
    PG8_STAGEB(PG8_SB(0, 0), cB); PG8_STAGEB(PG8_SB(0, 1), cB + hstep); PG8_STAGE(PG8_SA(0, 0), cA, vA[0][0], vA[0][1]); PG8_STAGE(PG8_SA(0, 1), cA, vA[1][0], vA[1][1]);
    if (wr == 1) PG8_BAR;
    PG8_WAIT_V(2); PG8_BAR;
    PG8_STAGEB(PG8_SB(1, 0), cB + kstep); PG8_STAGE(PG8_SA(1, 0), cA + kstep, vA[0][0], vA[0][1]); PG8_STAGEB(PG8_SB(1, 1), cB + hstep + kstep);
    PG8_WAIT_V(6); PG8_BAR;
    for (;;) {
        const bool has_next = S.next(ui + 1, nxt);
        const char* nA = cA; const char* nB = cB;
#pragma unroll
        for (int h = 0; h < 2; ++h) { vN[h][0] = vA[h][0]; vN[h][1] = vA[h][1]; }
        if (has_next) { nA = nxt.a; nB = nxt.b; S.voff(nxt, K, sR, sC, vN); }
        for (int t = 0; t < nt; t += 2) {
            const bool last = (t == nt - 2);
            const char* a1 = cA + (size_t)(t + 1) * kstep;
            const char* a2 = last ? nA : cA + (size_t)(t + 2) * kstep; const char* b2 = last ? nB : cB + (size_t)(t + 2) * kstep;
            const char* a3 = a2 + kstep; const char* b3 = b2 + kstep;
            const unsigned w00 = last ? vN[0][0] : vA[0][0], w01 = last ? vN[0][1] : vA[0][1], w10 = last ? vN[1][0] : vA[1][0], w11 = last ? vN[1][1] : vA[1][1];
            PG8_LDB(B0, 0, 0); PG8_LDB(B1, 0, 1); PG8_SCHED; PG8_LDA(At, 0, 0); PG8_STAGE(PG8_SA(1, 1), a1, vA[1][0], vA[1][1]);
            PG8_WAIT_V(8); PG8_WAIT_L(0); PG8_BAR; PG8_MMA(0, 0, At, B0); PG8_MMA(0, 1, At, B1); PG8_BAR; PG8_SCHED;
            PG8_LDA(At, 0, 1); PG8_STAGEB(PG8_SB(0, 0), b2); PG8_STAGEB(PG8_SB(0, 1), b2 + hstep); PG8_STAGE(PG8_SA(0, 0), a2, w00, w01);
            PG8_WAIT_V(8); PG8_WAIT_L(0); PG8_BAR; PG8_MMA(1, 0, At, B0); PG8_MMA(1, 1, At, B1); PG8_BAR; PG8_SCHED;
            PG8_LDB(B0, 1, 0); PG8_LDB(B1, 1, 1); PG8_SCHED; PG8_LDA(At, 1, 0); PG8_STAGE(PG8_SA(0, 1), a2, w10, w11);
            PG8_WAIT_V(8); PG8_WAIT_L(0); PG8_BAR; PG8_MMA(0, 0, At, B0); PG8_MMA(0, 1, At, B1); PG8_BAR; PG8_SCHED;
            PG8_LDA(At, 1, 1); PG8_STAGEB(PG8_SB(1, 0), b3); PG8_STAGEB(PG8_SB(1, 1), b3 + hstep); PG8_STAGE(PG8_SA(1, 0), a3, w00, w01);
            PG8_WAIT_V(8); PG8_WAIT_L(0); PG8_BAR; PG8_MMA(1, 0, At, B0); PG8_MMA(1, 1, At, B1); PG8_BAR; PG8_SCHED;
        }
        if constexpr (ALIGN_EPI) { if (wr == 0) PG8_BAR; }
        E(acc, cur, wr, wc, fr, fq);
        if (!has_next) break;
#pragma unroll
        for (int a = 0; a < 2; ++a)
#pragma unroll
            for (int b = 0; b < 2; ++b)
#pragma unroll
                for (int m = 0; m < 4; ++m)
#pragma unroll
                    for (int n = 0; n < 2; ++n) acc[a][b][m][n] = (f32x4){0.f, 0.f, 0.f, 0.f};
        cur = nxt; cA = nA; cB = nB; ++ui;
#pragma unroll
        for (int h = 0; h < 2; ++h) { vA[h][0] = vN[h][0]; vA[h][1] = vN[h][1]; }
        if constexpr (ALIGN_EPI) { if (wr == 1) PG8_BAR; }
    }
    PG8_WAIT_V(0);
    if constexpr (!ALIGN_EPI) { if (wr == 0) PG8_BAR; }
    PG8_BAR;
#undef PG8_SA
#undef PG8_SB
#undef PG8_STAGE
#undef PG8_STAGEB
#undef PG8_LDA
#undef PG8_LDB
#undef PG8_MMA
#undef PG8_WAIT_V
#undef PG8_WAIT_L
#undef PG8_BAR
#undef PG8_SCHED
}
}
namespace pg8 {
__device__ __forceinline__ void st8(bf16_t* p, const f32x4 v0, const f32x4 v1) { u32x4 w; w.x = cvt_pk_bf16(v0[0], v0[1]); w.y = cvt_pk_bf16(v0[2], v0[3]); w.z = cvt_pk_bf16(v1[0], v1[1]); w.w = cvt_pk_bf16(v1[2], v1[3]); *(u32x4*)p = w; }
__device__ __forceinline__ f32x4 sig4(const f32x4 v) { return (f32x4){sigmoidf_fast(v[0]), sigmoidf_fast(v[1]), sigmoidf_fast(v[2]), sigmoidf_fast(v[3])}; }
struct EpiG1 {
    bf16_t* act; size_t astride; const float __attribute__((address_space(1)))* qg; float c2;
    long kgoff;
    __device__ __forceinline__ void operator()(const f32x4 (&acc)[2][2][4][2], const Unit& u, int wr, int wc, int fr, int fq) const {
        const int row0 = u.pm * BM + wr * 64 + fr, pn = u.pn;
        if (pn < 8) {
            bf16_t* base = act + astride + pn * 128 + wc * 32 + 8 * fq;
#pragma unroll
            for (int ai = 0; ai < 2; ++ai)
#pragma unroll
                for (int m = 0; m < 4; ++m) st8(base + (size_t)(row0 + ai * HALF + m * 16) * 1024, acc[ai][0][m][0] * acc[ai][1][m][0], acc[ai][0][m][1] * acc[ai][1][m][1]);
        } else if (pn >= 12 && pn < 20) {
            const bool isq = pn < 16; const float __attribute__((address_space(1)))* g = qg + (isq ? 0 : kgoff); bf16_t* base = act + (isq ? 3 : 4) * astride + (4 * (pn & 3) + wc) * 64 + 8 * fq;
            f32x4 gv[2][2];
#pragma unroll
            for (int bj = 0; bj < 2; ++bj)
#pragma unroll
                for (int n = 0; n < 2; ++n) gv[bj][n] = *(const f32x4 __attribute__((address_space(1)))*)(g + 32 * bj + 8 * fq + 4 * n);
            const float sc = isq ? c2 : 1.0f;
#pragma unroll
            for (int ai = 0; ai < 2; ++ai)
#pragma unroll
                for (int m = 0; m < 4; ++m) {
                    float ss = 0.f;
#pragma unroll
                    for (int bj = 0; bj < 2; ++bj)
#pragma unroll
                        for (int n = 0; n < 2; ++n) { const f32x4 x = acc[ai][bj][m][n]; ss += (x[0] * x[0] + x[1] * x[1]) + (x[2] * x[2] + x[3] * x[3]); }
                    { const int ln = fq * 16 + fr; ss += shx(ss, 16, ln); ss += shx(ss, 32, ln); }
                    const float rs = __builtin_amdgcn_rsqf(ss * (1.0f / 64.0f) + 1e-6f) * sc;
                    bf16_t* rowp = base + (size_t)(row0 + ai * HALF + m * 16) * 1024;
#pragma unroll
                    for (int bj = 0; bj < 2; ++bj) st8(rowp + 32 * bj, acc[ai][bj][m][0] * gv[bj][0] * rs, acc[ai][bj][m][1] * gv[bj][1] * rs);
                }
        } else {
            const bool gate = pn >= 24;
            const int bi = pn < 12 ? 2 : pn < 24 ? 5 : pn < 28 ? 6 : 7;
            bf16_t* base = act + bi * astride + (pn & 3) * 256 + wc * 32 + 8 * fq;
#pragma unroll
            for (int ai = 0; ai < 2; ++ai)
#pragma unroll
                for (int m = 0; m < 4; ++m) { bf16_t* rowp = base + (size_t)(row0 + ai * HALF + m * 16) * 1024;
#pragma unroll
                    for (int bj = 0; bj < 2; ++bj) { f32x4 v0 = acc[ai][bj][m][0], v1 = acc[ai][bj][m][1]; if (gate) { v0 = sig4(v0); v1 = sig4(v1); } st8(rowp + bj * HALF, v0, v1); } }
        }
    }
};
struct EpiG2 {
    bf16_t* MG; const bf16_t* SGA; size_t gstride;
    __device__ __forceinline__ void operator()(const f32x4 (&acc)[2][2][4][2], const Unit& u, int wr, int wc, int fr, int fq) const {
        const int row0 = u.pm * BM + wr * 64 + fr, col0 = u.pn * BM + wc * 32 + 8 * fq; const bf16_t* G = SGA + (u.kind ? gstride : 0);
#pragma unroll
        for (int ai = 0; ai < 2; ++ai)
#pragma unroll
            for (int m = 0; m < 4; ++m) { const size_t off = (size_t)(row0 + ai * HALF + m * 16) * 1024 + col0;
#pragma unroll
                for (int bj = 0; bj < 2; ++bj) { const u32x4 g = *(const u32x4*)(G + off + bj * HALF);
                    f32x4 v0 = acc[ai][bj][m][0] * (f32x4){bf_lo(g.x), bf_hi(g.x), bf_lo(g.y), bf_hi(g.y)}, v1 = acc[ai][bj][m][1] * (f32x4){bf_lo(g.z), bf_hi(g.z), bf_lo(g.w), bf_hi(g.w)};
                    if (u.kind) { const u32x4 t = *(const u32x4*)(MG + off + bj * HALF); v0 += (f32x4){bf_lo(t.x), bf_hi(t.x), bf_lo(t.y), bf_hi(t.y)}; v1 += (f32x4){bf_lo(t.z), bf_hi(t.z), bf_lo(t.w), bf_hi(t.w)}; }
                    st8(MG + off + bj * HALF, v0, v1); }
                asm volatile("" ::: "memory"); }
    }
};
struct EpiG3 {
    float* H;
    __device__ __forceinline__ void operator()(const f32x4 (&acc)[2][2][4][2], const Unit& u, int wr, int wc, int fr, int fq) const {
        const int row0 = u.pm * BM + wr * 64 + fr, col0 = u.pn * BM + wc * 32 + 8 * fq;
#pragma unroll
        for (int ai = 0; ai < 2; ++ai)
#pragma unroll
            for (int m = 0; m < 4; ++m) { float* rowp = H + (size_t)(row0 + ai * HALF + m * 16) * 1024 + col0;
#pragma unroll
                for (int bj = 0; bj < 2; ++bj)
#pragma unroll
                    for (int n = 0; n < 2; ++n) { f32x4* p = (f32x4*)(rowp + bj * HALF + 4 * n); *p = *p + acc[ai][bj][m][n]; }
                asm volatile("" ::: "memory"); }
    }
};
struct EpiM1 {
    bf16_t* HACT;
    __device__ __forceinline__ void operator()(const f32x4 (&acc)[2][2][4][2], const Unit& u, int wr, int wc, int fr, int fq) const {
        bf16_t* base = HACT + (size_t)(u.pm * BM + wr * 64 + fr) * 512 + u.pn * 128 + wc * 32 + 8 * fq;
#pragma unroll
        for (int ai = 0; ai < 2; ++ai)
#pragma unroll
            for (int m = 0; m < 4; ++m) { const f32x4 g0 = acc[ai][0][m][0], g1 = acc[ai][0][m][1];
                st8(base + (size_t)(ai * HALF + m * 16) * 512, g0 * sig4(g0) * acc[ai][1][m][0], g1 * sig4(g1) * acc[ai][1][m][1]); }
    }
};
struct EpiM2 {
    bf16_t* Y;
    __device__ __forceinline__ void operator()(const f32x4 (&acc)[2][2][4][2], const Unit& u, int wr, int wc, int fr, int fq) const {
        bf16_t* base = Y + (size_t)(u.pm * BM + wr * 64 + fr) * 1024 + u.pn * BM + wc * 32 + 8 * fq;
#pragma unroll
        for (int ai = 0; ai < 2; ++ai)
#pragma unroll
            for (int m = 0; m < 4; ++m)
#pragma unroll
                for (int bj = 0; bj < 2; ++bj) st8(base + (size_t)(ai * HALF + m * 16) * 1024 + bj * HALF, acc[ai][bj][m][0], acc[ai][bj][m][1]);
    }
};

}
#include <hip/hip_bf16.h>
namespace attn_body {
using bf16=__hip_bfloat16;
using bf16x8=__attribute__((ext_vector_type(8)))short;
using s16x4=__attribute__((ext_vector_type(4)))short;
using f32x16=__attribute__((ext_vector_type(16)))float;
using f32x4=__attribute__((ext_vector_type(4)))float;
using u32x4=__attribute__((ext_vector_type(4)))unsigned;
constexpr int NHEAD=16,SEQ=8192,D=64,DM=NHEAD*D;
constexpr int NW=8,QBLK=32,QB=QBLK*NW,KVBLK=64,NQB=SEQ/QB;
constexpr int META_ROW=16384;
__device__ __forceinline__ int crow(int r,int hi){return (r&3)+8*(r>>2)+4*hi;}
#define SBAR() __builtin_amdgcn_sched_barrier(0)
__device__ __forceinline__ void cmask(f32x16&p0,f32x16&p1,int jb,int qrel,int hi){
  const float NEG=-INFINITY; int kb=64*jb+4*hi;
  #pragma unroll
  for(int r=0;r<16;++r){int kv=kb+(r&3)+8*(r>>2); if(kv>qrel)p0[r]=NEG; if(kv+32>qrel)p1[r]=NEG;}
}
constexpr int NSLOT=3, SLOTB=8192, MAXT=132;
constexpr int LDS_K=0, LDS_V=NSLOT*SLOTB, LDS_WS=2*NSLOT*SLOTB, LDS_OST=LDS_WS+NW*64*4, LDS_BL=LDS_OST+NW*4096, LDS_BYTES=LDS_BL+MAXT*256;
constexpr float C2=0.125f*1.4426950408889634f;
__device__ __forceinline__ void glds16(const void*gsrc,unsigned lds_dst){unsigned keep;
  asm volatile("s_mov_b32 %0, m0\n\ts_mov_b32 m0, %2\n\ts_nop 0\n\tglobal_load_lds_dwordx4 %1, off\n\ts_mov_b32 m0, %0":"=&s"(keep):"v"(gsrc),"s"(lds_dst):"memory");}
typedef float f32x2_t __attribute__((ext_vector_type(2))); typedef __bf16 bf16x2_t __attribute__((ext_vector_type(2)));
__device__ __forceinline__ unsigned cvtpk_s(float lo,float hi){f32x2_t v={lo,hi};bf16x2_t b=__builtin_convertvector(v,bf16x2_t);return __builtin_bit_cast(unsigned,b);}
#define WAIT_BAR(N) asm volatile("s_waitcnt vmcnt(" #N ") lgkmcnt(0)\n\ts_barrier":::"memory")
typedef __attribute__((address_space(3))) const char* lds_cptr;
typedef short v4i16_t __attribute__((ext_vector_type(4)));
__device__ __forceinline__ void kload8(bf16x8*kf,lds_cptr kp){
  kf[0]=*(const __attribute__((address_space(3))) bf16x8*)(kp);      kf[1]=*(const __attribute__((address_space(3))) bf16x8*)(kp+512);
  kf[2]=*(const __attribute__((address_space(3))) bf16x8*)(kp+2048); kf[3]=*(const __attribute__((address_space(3))) bf16x8*)(kp+2560);
  kf[4]=*(const __attribute__((address_space(3))) bf16x8*)(kp+4096); kf[5]=*(const __attribute__((address_space(3))) bf16x8*)(kp+4608);
  kf[6]=*(const __attribute__((address_space(3))) bf16x8*)(kp+6144); kf[7]=*(const __attribute__((address_space(3))) bf16x8*)(kp+6656);
}
__device__ __forceinline__ void kload2(bf16x8*kf,lds_cptr kp,int j){ kf[2*j]=*(const __attribute__((address_space(3))) bf16x8*)(kp+j*2048); kf[2*j+1]=*(const __attribute__((address_space(3))) bf16x8*)(kp+j*2048+512); }
__device__ __forceinline__ s16x4 vtr(lds_cptr p){ return __builtin_bit_cast(s16x4,__builtin_amdgcn_ds_read_tr16_b64_v4i16((__attribute__((address_space(3))) v4i16_t*)p)); }
__device__ __forceinline__ void binit(f32x16&p0,f32x16&p1,lds_cptr bl,float at){
  #pragma unroll
  for(int g=0;g<4;++g){ const f32x4 a=*(const __attribute__((address_space(3))) f32x4*)(bl+32*g), b=*(const __attribute__((address_space(3))) f32x4*)(bl+128+32*g);
    #pragma unroll
    for(int i=0;i<4;++i){p0[4*g+i]=a[i]+at;p1[4*g+i]=b[i]+at;} }
}
__device__ __forceinline__ void pv(f32x16*o,int vb,bf16x8 pa0,bf16x8 pa1,bf16x8 pa2,bf16x8 pa3){
  #pragma unroll
  for(int d0=0;d0<2;++d0){s16x4 lo[4],hi[4];
    #pragma unroll
    for(int ks=0;ks<4;++ks){
      asm volatile("ds_read_b64_tr_b16 %0,%1 offset:%c2":"=&v"(lo[ks]):"v"(vb),"i"(d0*4096+ks*1024):"memory");
      asm volatile("ds_read_b64_tr_b16 %0,%1 offset:%c2":"=&v"(hi[ks]):"v"(vb),"i"(d0*4096+ks*1024+512):"memory");}
    asm volatile("s_waitcnt lgkmcnt(0)":::"memory");SBAR();
    #define PK(k) (bf16x8){lo[k][0],lo[k][1],lo[k][2],lo[k][3],hi[k][0],hi[k][1],hi[k][2],hi[k][3]}
    o[d0]=__builtin_amdgcn_mfma_f32_32x32x16_bf16(pa0,PK(0),o[d0],0,0,0);
    o[d0]=__builtin_amdgcn_mfma_f32_32x32x16_bf16(pa1,PK(1),o[d0],0,0,0);
    o[d0]=__builtin_amdgcn_mfma_f32_32x32x16_bf16(pa2,PK(2),o[d0],0,0,0);
    o[d0]=__builtin_amdgcn_mfma_f32_32x32x16_bf16(pa3,PK(3),o[d0],0,0,0);
    #undef PK
  }
}
#ifndef ATTN_STORE16
#define ATTN_STORE16(p,v) (*(u32x4*)(p)=(v))
#endif
__device__ __forceinline__ void attn_unit(const int tid,int b,int h,int qb,int ts,int PRE,const bf16*Q,const bf16*__restrict__ K,const bf16*__restrict__ V,bf16*O,const float*__restrict__ cb,const float*__restrict__ cbm,float m0,char*shm){
  const int lane=tid&63,r32=lane&31,hi=lane>>5; const int wid=__builtin_amdgcn_readfirstlane(tid>>6);
  const long rowbase=(long)b*SEQ; const int q0=qb*QB;
  const bf16*Qw=Q+(rowbase+q0+wid*QBLK)*DM+h*D;
  const bf16*Kh=K+rowbase*DM+h*D,*Vh=V+rowbase*DM+h*D;
  const unsigned lds0=(unsigned)(uintptr_t)shm;
  float*wsf=(float*)(shm+LDS_WS)+wid*64;
  const int NT=(q0+QB)/KVBLK-ts+PRE;
  { float*BLf=(float*)(shm+LDS_BL);
    for(int i=tid;i<NT*64;i+=NW*64){ const int ti=i>>6,j=i&63; float v;
      if(ti<PRE-1)v=-INFINITY; else if(ti==PRE-1)v=(j<16)?-cbm[j]:-INFINITY; else v=-cb[(ti-PRE+ts)*64+j];
      BLf[i]=v; } }
  const float at=cb[q0+wid*QBLK+r32]-m0;
  const long koff=(long)lane*DM+wid*8, voff=(long)(16*(wid&3)+(lane>>2))*DM+(wid>>2)*32+(lane&3)*8;
  const bf16*ksrc=Kh+koff+(long)(ts-PRE)*KVBLK*DM;
  const bf16*vsrc=Vh+voff+(long)(ts-PRE)*KVBLK*DM;
  const long dmeta=((long)META_ROW-rowbase)*DM-(long)(ts-PRE)*KVBLK*DM;
  const unsigned kdst=lds0+LDS_K+wid*1024, vdst=lds0+LDS_V+wid*1024;
  #define DMA_K(t,slot) glds16(ksrc+(((t)<PRE)?dmeta:(long)(t)*KVBLK*DM),(unsigned)__builtin_amdgcn_readfirstlane(kdst+(slot)))
  #define DMA_V(t,slot) glds16(vsrc+(((t)<PRE)?dmeta:(long)(t)*KVBLK*DM),(unsigned)__builtin_amdgcn_readfirstlane(vdst+(slot)))
  const int vb0=(int)(lds0+LDS_V)+((lane>>4)&1)*32+(lane&3)*8+(4*hi+((lane&15)>>2))*64;
  bf16x8 kf[8];
  const lds_cptr shm3=(lds_cptr)shm; const lds_cptr kp0=shm3+LDS_K+hi*1024+r32*16; const lds_cptr vp0=shm3+LDS_V+((lane>>4)&1)*32+(lane&3)*8+(4*hi+((lane&15)>>2))*64;
  lds_cptr blp=shm3+LDS_BL+16*hi;
  DMA_K(0,0);DMA_V(0,0);DMA_K(1,SLOTB);
  bf16x8 qr[4];
  #pragma unroll
  for(int d0=0;d0<4;++d0)qr[d0]=*reinterpret_cast<const bf16x8*>(&Qw[(long)r32*DM+d0*16+hi*8]);
  float l_reg=0.f;f32x16 o[2];o[0]=f32x16{};o[1]=f32x16{};
  const int qrel=wid*QBLK+r32;
  #define CMASK(P0,P1,t) do{int jb_=(t)-(NT-4); if(jb_>=0)cmask(P0,P1,jb_,qrel,hi);}while(0)
  f32x16 pA0,pA1,pB0,pB1;
  int sl_prev=0,sl_cur=0,sl_next=SLOTB;
  #define ROT() do{sl_prev=sl_cur;sl_cur=sl_next;sl_next=(sl_next==(NSLOT-1)*SLOTB)?0:sl_next+SLOTB;}while(0)
  DMA_K(2,2*SLOTB);
  WAIT_BAR(3);
  binit(pA0,pA1,blp,at); blp+=256;
  { const lds_cptr kb=kp0;
    #pragma unroll
    for(int d0=0;d0<4;++d0){
      const bf16x8 b0=*(const __attribute__((address_space(3))) bf16x8*)(kb+d0*2048);
      const bf16x8 b1=*(const __attribute__((address_space(3))) bf16x8*)(kb+d0*2048+512);
      pA0=__builtin_amdgcn_mfma_f32_32x32x16_bf16(b0,qr[d0],pA0,0,0,0);pA1=__builtin_amdgcn_mfma_f32_32x32x16_bf16(b1,qr[d0],pA1,0,0,0);} }
  CMASK(pA0,pA1,0);
  _Pragma("unroll") for(int r=0;r<16;++r){pA0[r]=__builtin_amdgcn_exp2f(pA0[r]);pA1[r]=__builtin_amdgcn_exp2f(pA1[r]);}
  binit(pB0,pB1,blp,at); blp+=256;
  WAIT_BAR(0);
  DMA_K(3,0);DMA_V(1,SLOTB);
  ROT();
  kload8(kf,kp0+sl_cur);
  WAIT_BAR(2);
  s16x4 vlo[8],vhi[8]; u32x4 pw0,pw1,pw2,pw3;
  #define PKW(P,B) cvtpk_s(P[B],P[B+1])
  #define PAF(k) __builtin_bit_cast(bf16x8,pw##k)
  #define VFR(i) (bf16x8){vlo[i][0],vlo[i][1],vlo[i][2],vlo[i][3],vhi[i][0],vhi[i][1],vhi[i][2],vhi[i][3]}
  #define PIN(x) asm volatile("":"+v"(x))
  #define GAPA(MF,A0,A1,A2,A3,W0,W1,PW) do{ MF; sacc+=A0; sacc+=A1; sacc+=A2; sacc+=A3; PIN(sacc); W0; W1; PIN(PW); SBAR(); }while(0)
  #define EX(v) __builtin_amdgcn_exp2f(v)
  #define GAPB(MF,X,B) do{ MF; X[B]=EX(X[B]); X[B+1]=EX(X[B+1]); X[B+2]=EX(X[B+2]); X[B+3]=EX(X[B+3]); PIN(X); SBAR(); }while(0)
  #define VRD(i) do{ vlo[i]=vtr(vp_+(((i)>>2)*4096+((i)&3)*1024)); vhi[i]=vtr(vp_+(((i)>>2)*4096+((i)&3)*1024+512)); }while(0)
  #define KRD(G,j) do{ if(G){ kload2(kf,kp0+sl_next,j); SBAR(); } }while(0)
  #define BRD(G,P,g) do{ if(G){ const f32x4 t_=*(const __attribute__((address_space(3))) f32x4*)(blp+(((g)>>2)*128+((g)&3)*32)); P[4*((g)&3)]=t_[0];P[4*((g)&3)+1]=t_[1];P[4*((g)&3)+2]=t_[2];P[4*((g)&3)+3]=t_[3]; } }while(0)
  #define BAD(G,P,g) do{ if(G){ P[4*((g)&3)]+=at;P[4*((g)&3)+1]+=at;P[4*((g)&3)+2]+=at;P[4*((g)&3)+3]+=at; PIN(P); } }while(0)
  #define STEP(C0,C1,P0,P1,t,GK,GV,GL,GB) do{ SBAR(); \
    const lds_cptr vp_=vp0+sl_prev; \
    VRD(0); SBAR(); float sacc=(P0[0]+P0[1]); \
    GAPA(C0=__builtin_amdgcn_mfma_f32_32x32x16_bf16(kf[0],qr[0],C0,0,0,0), P0[2],P0[3],P0[4],P0[5],     pw0[0]=PKW(P0,0), pw0[1]=PKW(P0,2), pw0); \
    VRD(4); SBAR(); GAPA(C1=__builtin_amdgcn_mfma_f32_32x32x16_bf16(kf[1],qr[0],C1,0,0,0), P0[6],P0[7],P0[8],P0[9],     pw0[2]=PKW(P0,4), pw0[3]=PKW(P0,6), pw0); \
    VRD(1); SBAR(); GAPA(C0=__builtin_amdgcn_mfma_f32_32x32x16_bf16(kf[2],qr[1],C0,0,0,0),   P0[10],P0[11],P0[12],P0[13], pw1[0]=PKW(P0,8), pw1[1]=PKW(P0,10), pw1); \
    VRD(5); SBAR(); GAPA(C1=__builtin_amdgcn_mfma_f32_32x32x16_bf16(kf[3],qr[1],C1,0,0,0),   P0[14],P0[15],P1[0],P1[1],   pw1[2]=PKW(P0,12),pw1[3]=PKW(P0,14), pw1); \
    VRD(2); SBAR(); GAPA(C0=__builtin_amdgcn_mfma_f32_32x32x16_bf16(kf[4],qr[2],C0,0,0,0),   P1[2],P1[3],P1[4],P1[5],     pw2[0]=PKW(P1,0), pw2[1]=PKW(P1,2), pw2); \
    VRD(6); SBAR(); GAPA(C1=__builtin_amdgcn_mfma_f32_32x32x16_bf16(kf[5],qr[2],C1,0,0,0),   P1[6],P1[7],P1[8],P1[9],     pw2[2]=PKW(P1,4), pw2[3]=PKW(P1,6), pw2); \
    VRD(3); SBAR(); GAPA(C0=__builtin_amdgcn_mfma_f32_32x32x16_bf16(kf[6],qr[3],C0,0,0,0),   P1[10],P1[11],P1[12],P1[13], pw3[0]=PKW(P1,8), pw3[1]=PKW(P1,10), pw3); \
    VRD(7); SBAR(); GAPA(C1=__builtin_amdgcn_mfma_f32_32x32x16_bf16(kf[7],qr[3],C1,0,0,0),   P1[14],P1[15],0.f,0.f,       pw3[2]=PKW(P1,12),pw3[3]=PKW(P1,14), pw3); \
    l_reg+=sacc; \
    if(GK){DMA_K((t)+3,sl_cur);} if(GV){DMA_V((t)+1,sl_next);} \
    CMASK(C0,C1,t); \
    SBAR(); \
    BRD(GB,P0,0); GAPB(o[0]=__builtin_amdgcn_mfma_f32_32x32x16_bf16(PAF(0),VFR(0),o[0],0,0,0), C0,0); \
    BRD(GB,P0,1); BAD(GB,P0,0); GAPB(o[1]=__builtin_amdgcn_mfma_f32_32x32x16_bf16(PAF(0),VFR(4),o[1],0,0,0), C0,4); \
    BRD(GB,P0,2); BAD(GB,P0,1); KRD(GL,0); GAPB(o[0]=__builtin_amdgcn_mfma_f32_32x32x16_bf16(PAF(1),VFR(1),o[0],0,0,0), C0,8); \
    BRD(GB,P0,3); BAD(GB,P0,2); KRD(GL,1); GAPB(o[1]=__builtin_amdgcn_mfma_f32_32x32x16_bf16(PAF(1),VFR(5),o[1],0,0,0), C0,12); \
    BRD(GB,P1,4); BAD(GB,P0,3); KRD(GL,2); GAPB(o[0]=__builtin_amdgcn_mfma_f32_32x32x16_bf16(PAF(2),VFR(2),o[0],0,0,0), C1,0); \
    BRD(GB,P1,5); BAD(GB,P1,4); KRD(GL,3); GAPB(o[1]=__builtin_amdgcn_mfma_f32_32x32x16_bf16(PAF(2),VFR(6),o[1],0,0,0), C1,4); \
    BRD(GB,P1,6); BAD(GB,P1,5); GAPB(o[0]=__builtin_amdgcn_mfma_f32_32x32x16_bf16(PAF(3),VFR(3),o[0],0,0,0), C1,8); \
    BRD(GB,P1,7); BAD(GB,P1,6); GAPB(o[1]=__builtin_amdgcn_mfma_f32_32x32x16_bf16(PAF(3),VFR(7),o[1],0,0,0), C1,12); \
    BAD(GB,P1,7); if(GB){blp+=256;} \
    }while(0)
  int t=1;
  #undef CMASK
  #define CMASK(P0,P1,t) do{}while(0)
  for(;t+5<NT;t+=2){
    STEP(pB0,pB1,pA0,pA1,t,true,true,true,true);     WAIT_BAR(2); ROT();
    STEP(pA0,pA1,pB0,pB1,t+1,true,true,true,true);   WAIT_BAR(2); ROT();
  }
  #undef CMASK
  #define CMASK(P0,P1,t) do{int jb_=(t)-(NT-4); if(jb_>=0)cmask(P0,P1,jb_,qrel,hi);}while(0)
  #define ENDW(tt) do{ if((tt)+3<NT){WAIT_BAR(2);} else if((tt)+2<NT){WAIT_BAR(1);} else {WAIT_BAR(0);} }while(0)
  for(;t+1<NT;t+=2){
    STEP(pB0,pB1,pA0,pA1,t,(t+3<NT),(t+1<NT),(t+1<NT),(t+1<NT));       ENDW(t);   ROT();
    STEP(pA0,pA1,pB0,pB1,t+1,(t+4<NT),(t+2<NT),(t+2<NT),(t+2<NT));     ENDW(t+1); ROT();
  }
  STEP(pB0,pB1,pA0,pA1,NT-1,false,false,false,false);
  { float sacc=pB0[0]+pB0[1]; _Pragma("unroll") for(int r=2;r<16;++r)sacc+=pB0[r]; _Pragma("unroll") for(int r=0;r<16;++r)sacc+=pB1[r]; l_reg+=sacc;
    pw0=(u32x4){PKW(pB0,0),PKW(pB0,2),PKW(pB0,4),PKW(pB0,6)};pw1=(u32x4){PKW(pB0,8),PKW(pB0,10),PKW(pB0,12),PKW(pB0,14)};pw2=(u32x4){PKW(pB1,0),PKW(pB1,2),PKW(pB1,4),PKW(pB1,6)};pw3=(u32x4){PKW(pB1,8),PKW(pB1,10),PKW(pB1,12),PKW(pB1,14)};
    SBAR(); pv(o,vb0+sl_cur,PAF(0),PAF(1),PAF(2),PAF(3)); }
  #undef PKW
  #undef PAF
  #undef VFR
  #undef PIN
  #undef GAPA
  #undef GAPB
  #undef EX
  #undef VRD
  #undef KRD
  #undef BRD
  #undef BAD
  #undef STEP
  #undef ENDW
  {auto rr=__builtin_amdgcn_permlane32_swap(__float_as_uint(l_reg),__float_as_uint(l_reg),false,false);l_reg=__uint_as_float(rr[0])+__uint_as_float(rr[1]);}
  if(hi==0)wsf[32+r32]=l_reg;asm volatile("s_waitcnt lgkmcnt(0)":::"memory");
  float rli[16];
  #pragma unroll
  for(int r=0;r<16;++r)rli[r]=__builtin_amdgcn_rcpf(wsf[32+crow(r,hi)]);
  bf16*Ow=O+(rowbase+q0+wid*QBLK)*DM+h*D;
  { bf16*stg=(bf16*)(shm+LDS_OST)+wid*2048;
    #pragma unroll
    for(int r=0;r<16;++r){const int orow=crow(r,hi);
      #pragma unroll
      for(int d0=0;d0<2;++d0)stg[orow*64+d0*32+r32]=__float2bfloat16(o[d0][r]*rli[r]);}
    asm volatile("s_waitcnt lgkmcnt(0)":::"memory");
    #pragma unroll
    for(int i=0;i<4;++i){const int row=i*8+(lane>>3),ch=lane&7; const u32x4 v=*(const u32x4*)(stg+row*64+ch*8); ATTN_STORE16(Ow+(long)row*DM+ch*8,v);} }
  asm volatile("s_waitcnt lgkmcnt(0)\n\ts_barrier":::"memory");
  #undef DMA_K
  #undef DMA_V
  #undef CMASK
  #undef ROT
}
constexpr int ATTN_LDS_BYTES=LDS_BYTES;
#undef SBAR
#undef WAIT_BAR
}
constexpr int NWAVES = 8;
constexpr int BATCH = 2, SEQ = 8192, D = 1024, NH = 16, HD = 64, NMETA = 16, INC = 8208, NE = 32, DE = 512, DEPTH = 2;
constexpr int M = BATCH * SEQ;
constexpr int MROW = M;
constexpr int NTOK = M + NMETA;
constexpr int MP = 16640;
constexpr int SLOTS = 41216;
constexpr float EPS = 1e-6f, LOG2E = 1.4426950408889634f;
constexpr size_t MiB = 1u << 20;
constexpr size_t WS_CTL = 0, CTL_ZERO_BYTES = 1 * MiB;
constexpr size_t WS_FL = 1 * MiB;
constexpr size_t WS_CB = WS_FL + (size_t)MP * 16 * 4;
constexpr size_t WS_CBM = WS_CB + (size_t)32 * SEQ * 4;
constexpr size_t WS_PM = WS_CBM + 1024;
constexpr size_t WS_HNM = WS_PM + (size_t)16 * INC * 4;
constexpr size_t WS_YAINM = WS_HNM + 65536, WS_OM = WS_YAINM + 65536, WS_MGM = WS_OM + 65536;
constexpr size_t WS_RE = WS_MGM + 65536;
constexpr size_t WS_RP = WS_RE + (size_t)MP * 8;
constexpr size_t WS_RW = WS_RP + (size_t)MP * 8;
constexpr size_t WS_LIST = WS_RW + (size_t)MP * 8;
constexpr size_t WS_SMALL_END = WS_LIST + (size_t)NE * MP * 4;
static_assert(WS_SMALL_END <= 16 * MiB, "small buffers");
constexpr size_t WS_WD0 = 16 * MiB, WD_LAYER = 22 * MiB;
constexpr size_t WO_WC = 16 * MiB, WO_WA = 18 * MiB, WO_WM = 20 * MiB;
constexpr size_t WS_WGU = 60 * MiB, WS_WDN = 124 * MiB;
constexpr size_t WS_H = 156 * MiB;
constexpr size_t WS_ACT = 221 * MiB, ACT_STRIDE = (size_t)MP * D * 2;
constexpr size_t WS_XN = WS_ACT, WS_Z = WS_ACT + ACT_STRIDE, WS_BG = WS_ACT + 2 * ACT_STRIDE, WS_Q = WS_ACT + 3 * ACT_STRIDE, WS_K = WS_ACT + 4 * ACT_STRIDE, WS_V = WS_ACT + 5 * ACT_STRIDE,
                 WS_SGA = WS_ACT + 6 * ACT_STRIDE, WS_SGB = WS_ACT + 7 * ACT_STRIDE, WS_YAIN = WS_ACT + 8 * ACT_STRIDE, WS_END = WS_ACT + 9 * ACT_STRIDE;
constexpr size_t WS_MG = WS_Z;
constexpr size_t WS_HACT = WS_BG;
constexpr size_t WS_Y = WS_K;
static_assert(WS_HACT + (size_t)SLOTS * DE * 2 <= WS_K && WS_Y + (size_t)SLOTS * D * 2 <= WS_SGB, "MoE overlays");
constexpr int CW_TMO = 0, CW_CODE = 1, CW_BAR = 4096, CW_CNT = 16384, CW_AQ = 20480;
constexpr int RING_OFF = 0, RING_BYTES = 131072;
constexpr int LDSCTL_OFF = 162816, MISC_OFF = LDSCTL_OFF + 320;
constexpr int LDS_BYTES = 163840;
constexpr int TOFF_OFF = MISC_OFF + 128;
static_assert(TOFF_OFF + 160 <= LDSCTL_OFF + 768 && LDSCTL_OFF + 768 + 19 * 8 <= LDS_BYTES && attn_body::ATTN_LDS_BYTES <= RING_BYTES, "LDS map");

#define GAS __attribute__((address_space(1)))
#define LAS __attribute__((address_space(3)))
typedef unsigned short bf16;
typedef unsigned v4u __attribute__((ext_vector_type(4)));
typedef unsigned v2u __attribute__((ext_vector_type(2)));
typedef float f32x4 __attribute__((ext_vector_type(4)));
typedef GAS unsigned gu32;
#define RLX_AGENT __ATOMIC_RELAXED, __HIP_MEMORY_SCOPE_AGENT
#define LDS_WAIT() asm volatile("s_waitcnt lgkmcnt(0)" ::: "memory")
#define VM_WAIT() asm volatile("s_waitcnt vmcnt(0)" ::: "memory")
__device__ __forceinline__ unsigned f2bf(float f) { unsigned u = __builtin_bit_cast(unsigned, f); return (u + 0x7fffu + ((u >> 16) & 1u)) >> 16; }
__device__ __forceinline__ unsigned pk2(float lo, float hi) { return f2bf(lo) | (f2bf(hi) << 16); }
__device__ __forceinline__ float bflo(unsigned w) { return __uint_as_float(w << 16); }
__device__ __forceinline__ float bfhi(unsigned w) { return __uint_as_float(w & 0xffff0000u); }

#define XB_TMO      128
#define XB_XCNT(j)  (256  + 64 * (j))
#define XB_XSUB(j)  (1280 + 64 * (j))
#define XB_XGEN(j)  (2304 + 64 * (j))
#define XB_TOP      3328
#define XB_TOPGEN   3392
#define XCD_BAR_WORDS 3456
#define XB_SPIN_CAP (1u << 18)
__device__ __forceinline__ unsigned xb_ld(unsigned* p)              { return __hip_atomic_load(p, __ATOMIC_RELAXED, __HIP_MEMORY_SCOPE_AGENT); }
__device__ __forceinline__ unsigned xb_add(unsigned* p, unsigned v) { return __hip_atomic_fetch_add(p, v, __ATOMIC_RELAXED, __HIP_MEMORY_SCOPE_AGENT); }
__device__ __forceinline__ unsigned xb_xcc_id() { return (unsigned)__builtin_amdgcn_s_getreg((3 << 11) | 20) & 0xFu; }
#define XB_SPIN(cond, bar) do { unsigned _sp = 0; while (cond) { __builtin_amdgcn_s_sleep(1); \
    if ((++_sp & 255u) == 0u) { if (xb_ld(&(bar)[XB_TMO])) break; if (_sp > XB_SPIN_CAP) { atomicAdd(&(bar)[XB_TMO], 1u); break; } } } } while (0)
struct XcdBarrier { unsigned* bar; unsigned x; volatile LAS unsigned* st; };
__device__ __forceinline__ XcdBarrier xcd_barrier_post(unsigned* bar, volatile LAS unsigned* st) {
    XcdBarrier b; b.bar = bar; b.x = xb_xcc_id(); b.st = st;
    if (threadIdx.x == 0) (void)xb_add(&bar[XB_XCNT(b.x)], 1u);
    return b;
}
__device__ __forceinline__ void xcd_barrier_complete(unsigned* bar, unsigned x, unsigned& nloc, unsigned& nx) {
    const unsigned G = gridDim.x * gridDim.y * gridDim.z;
    unsigned sum, cnt, mine, sp = 0u;
    for (;;) {
        sum = 0u; cnt = 0u; mine = 0u;
#pragma unroll
        for (unsigned j = 0; j < 16; ++j) { const unsigned c = xb_ld(&bar[XB_XCNT(j)]); sum += c; cnt += (c > 0u) ? 1u : 0u; mine = (j == x) ? c : mine; }
        if (sum == G) break;
        __builtin_amdgcn_s_sleep(1);
        if ((++sp & 255u) == 0u) { if (xb_ld(&bar[XB_TMO])) break; if (sp > XB_SPIN_CAP) { atomicAdd(&bar[XB_TMO], 1u); break; } }
    }
    nloc = mine > 0u ? mine : 1u; nx = cnt > 0u ? cnt : 1u;
}
__device__ __forceinline__ void xcd_barrier(const XcdBarrier& b) {
    asm volatile("s_waitcnt vmcnt(0)" ::: "memory");
    __syncthreads();
    if (threadIdx.x == 0) {
        unsigned* bar = b.bar;
        __builtin_amdgcn_s_waitcnt(0);
        unsigned nloc = b.st[0], nx = b.st[1];
        if (nloc == 0u) { xcd_barrier_complete(bar, b.x, nloc, nx); b.st[0] = nloc; b.st[1] = nx; }
        const unsigned old = xb_add(&bar[XB_XSUB(b.x)], 1u);
        const unsigned gen = old / nloc;
        if (old + 1u == (gen + 1u) * nloc) {
            __builtin_amdgcn_fence(__ATOMIC_RELEASE, "agent");
            asm volatile("s_waitcnt vmcnt(0)" ::: "memory");
            const unsigned og = xb_add(&bar[XB_TOP], 1u);
            const unsigned tg = og / nx;
            if (og + 1u == (tg + 1u) * nx) xb_add(&bar[XB_TOPGEN], 1u);
            else XB_SPIN(xb_ld(&bar[XB_TOPGEN]) == tg, bar);
            __builtin_amdgcn_fence(__ATOMIC_ACQUIRE, "agent");
            xb_add(&bar[XB_XGEN(b.x)], 1u);
            asm volatile("s_waitcnt vmcnt(0)" ::: "memory");
        } else {
            XB_SPIN(xb_ld(&bar[XB_XGEN(b.x)]) == gen, bar);
            __builtin_amdgcn_fence(__ATOMIC_ACQUIRE, "agent");
            asm volatile("s_waitcnt vmcnt(0)" ::: "memory");
        }
    }
    __syncthreads();
}

struct Frame {
    LAS unsigned char* lds; volatile LAS unsigned* MISC; gu32* ctl; unsigned char* ws;
    int tid, lane, wave, vcu, G, gw, NGW;
    float* out;
};
constexpr int INP_OFF = LDSCTL_OFF + 768;
typedef const float GAS* gcf;
__device__ __forceinline__ gcf inp_ld(Frame& F, int i) { const unsigned long long p = *(volatile LAS unsigned long long*)(F.lds + INP_OFF + 8 * i);
    const unsigned lo = __builtin_amdgcn_readfirstlane((unsigned)p), hi = __builtin_amdgcn_readfirstlane((unsigned)(p >> 32)); return (gcf)(((unsigned long long)hi << 32) | lo); }
#define INP(i) inp_ld(F, i)
__device__ __forceinline__ float wave_sum_l(float v, int lane) {
#pragma unroll
    for (int o = 1; o < 64; o <<= 1) v += pg8::shx(v, o, lane);
    return v;
}
__device__ __forceinline__ float wave_max_l(float v, int lane) {
#pragma unroll
    for (int o = 1; o < 64; o <<= 1) v = fmaxf(v, pg8::shx(v, o, lane));
    return v;
}
#define wave_sum(v) wave_sum_l(v, F.lane)
#define wave_max(v) wave_max_l(v, F.lane)
__device__ __forceinline__ void tr_block(gcf src, int ld, bf16* dst, int Kd, LAS float* scr, int lane) {
    float t[32];
    gcf sp = src + (size_t)(lane >> 5) * ld + (lane & 31);
#pragma unroll
    for (int i = 0; i < 32; ++i) t[i] = sp[(size_t)(2 * i) * ld];
#pragma unroll
    for (int i = 0; i < 32; ++i) scr[(2 * i + (lane >> 5)) * 33 + (lane & 31)] = t[i];
    LDS_WAIT(); asm volatile("" ::: "memory");
    const int c = lane & 7;
#pragma unroll
    for (int j = 0; j < 4; ++j) { const int n = (lane >> 3) + 8 * j; const LAS float* s = scr + (8 * c) * 33 + n;
        v4u o; o.x = pk2(s[0 * 33], s[1 * 33]); o.y = pk2(s[2 * 33], s[3 * 33]); o.z = pk2(s[4 * 33], s[5 * 33]); o.w = pk2(s[6 * 33], s[7 * 33]);
        *(GAS v4u*)(dst + (size_t)n * Kd + 8 * c) = o; }
    LDS_WAIT(); asm volatile("" ::: "memory");
}
__device__ __forceinline__ int win_src_col(int n0) {
    const int pn = n0 >> 8, p = n0 & 255;
    if (pn < 8) return ((p >> 7) ? 2048 : 1024) + 128 * pn + (p & 127);
    if (pn < 12) return 256 * (pn - 8) + p;
    if (pn < 20) return (pn < 16 ? 3072 : 4096) + 256 * (pn & 3) + 64 * ((p >> 5) & 3) + 32 * (p >> 7);
    if (pn < 24) return 5120 + 256 * (pn & 3) + p;
    if (pn < 28) return 6160 + 256 * (pn & 3) + p;
    return 7184 + 256 * (pn & 3) + p;
}
constexpr int IT_WIN = 16 * 256, IT_SQ = 16 * 32, IT_DENSE = IT_WIN + 3 * IT_SQ;
constexpr int IT_GU = 16 * 32, IT_DN = 8 * 32, IT_EXP = IT_GU + IT_DN, IT_EXPL = NE * IT_EXP;
__device__ __forceinline__ void conv_dense_item(Frame& F, int l, int it, LAS float* scr) {
    unsigned char* wl = F.ws + WS_WD0 + (size_t)l * WD_LAYER;
    if (it < IT_WIN) { const int kb = it >> 8, nb = it & 255; tr_block(INP(3) + (size_t)l * D * INC + (size_t)(64 * kb) * INC + win_src_col(32 * nb), INC, (bf16*)wl + (size_t)(32 * nb) * D + 64 * kb, D, scr, F.lane); return; }
    it -= IT_WIN; const int w = it / IT_SQ, r = it % IT_SQ, kb = r >> 5, nb = r & 31;
    const size_t so = (size_t)l * D * D + (size_t)(64 * kb) * D + 32 * nb, dof = (size_t)(32 * nb) * D + 64 * kb;
    if (w == 0) tr_block(INP(6) + so, D, (bf16*)(wl + WO_WC) + dof, D, scr, F.lane);
    else if (w == 1) tr_block(INP(9) + so, D, (bf16*)(wl + WO_WA) + dof, D, scr, F.lane);
    else tr_block(INP(10) + so, D, (bf16*)(wl + WO_WM) + dof, D, scr, F.lane);
}
__device__ __forceinline__ void conv_expert_item(Frame& F, int l, int it, LAS float* scr) {
    const int e = it / IT_EXP; int r = it % IT_EXP;
    if (r < IT_GU) { const int kb = r >> 5, nb = r & 31, n0 = 32 * nb, ct = n0 >> 8, p = n0 & 255;
        const size_t so = ((size_t)l * NE + e) * D * DE + (size_t)(64 * kb) * DE + 128 * ct + (p & 127); bf16* dst = (bf16*)(F.ws + WS_WGU) + (size_t)e * D * D + (size_t)n0 * D + 64 * kb;
        if (p >> 7) tr_block(INP(17) + so, DE, dst, D, scr, F.lane); else tr_block(INP(16) + so, DE, dst, D, scr, F.lane);
        return; }
    r -= IT_GU; const int kb = r >> 5, nb = r & 31;
    tr_block(INP(18) + ((size_t)l * NE + e) * DE * D + (size_t)(64 * kb) * D + 32 * nb, D, (bf16*)(F.ws + WS_WDN) + (size_t)e * D * DE + (size_t)(32 * nb) * DE + 64 * kb, DE, scr, F.lane);
}
__device__ __forceinline__ void build_toff(Frame& F, int l) {
    LAS int* toff = (LAS int*)(F.lds + TOFF_OFF);
    if (F.tid < 64) {
        int t = F.lane < NE ? (((int)__hip_atomic_load(F.ctl + CW_CNT + 64 * l + F.lane, RLX_AGENT) + 255) >> 8) : 0; const int mine = t;
#pragma unroll
        for (int o = 1; o < 32; o <<= 1) { const int u = __builtin_amdgcn_ds_bpermute(((F.lane - o) & 63) << 2, t); if (F.lane >= o) t += u; }
        if (F.lane < NE) toff[F.lane] = t - mine;
        if (F.lane == NE - 1) toff[NE] = t; }
    __syncthreads();
}
namespace pg8 {
struct SchedDense {
    const char* A; const char* B; int nM, nN, G, c, K;
    __device__ __forceinline__ bool next(int i, Unit& u) const { const int L = i * G + c; if (L >= nM * nN) return false; int pm, pn; tile_of(L, nM, nN, pm, pn); u.pm = pm; u.pn = pn; u.kind = 0; u.aux = 0;
        u.a = A + (size_t)pm * BM * K * 2; u.b = B + (size_t)pn * BM * K * 2; return true; }
    __device__ __forceinline__ void voff(const Unit&, int K_, const int (&R)[2], const int (&C)[2], unsigned (&vo)[2][2]) const {
#pragma unroll
        for (int h = 0; h < 2; ++h)
#pragma unroll
            for (int i = 0; i < 2; ++i) vo[h][i] = (unsigned)((R[i] + HALF * h) * K_ + C[i]) * 2u; }
};
struct SchedPair {
    const char *A0, *B0; long dA, dB; int c, lim;
    __device__ __forceinline__ bool next(int i, Unit& u) const { if (i >= lim) return false; int pm, pn; tile_of(c, 64, 4, pm, pn); u.pm = pm; u.pn = pn; u.kind = i; u.aux = 0;
        u.a = A0 + (i ? dA : 0) + (size_t)pm * BM * 1024 * 2; u.b = B0 + (i ? dB : 0) + (size_t)pn * BM * 1024 * 2; return true; }
    __device__ __forceinline__ void voff(const Unit&, int K_, const int (&R)[2], const int (&C)[2], unsigned (&vo)[2][2]) const {
#pragma unroll
        for (int h = 0; h < 2; ++h)
#pragma unroll
            for (int i = 0; i < 2; ++i) vo[h][i] = (unsigned)((R[i] + HALF * h) * K_ + C[i]) * 2u; }
};
struct SchedMoe {
    const char* A; const char* B; const int* list; const unsigned* cnt; const PG8_LAS int* toff; int G, c, K; size_t bstride; bool gather;
    __device__ __forceinline__ bool next(int i, Unit& u) const {
        const int L = i * G + c, total = __builtin_amdgcn_readfirstlane(toff[32]); if (L >= 4 * total) return false;
        const int rt = L >> 2, ct = L & 3; int e = 0; while (__builtin_amdgcn_readfirstlane(toff[e + 1]) <= rt) ++e;
        u.pm = rt; u.pn = ct; u.kind = e; u.aux = rt - __builtin_amdgcn_readfirstlane(toff[e]);
        u.a = gather ? A : A + (size_t)rt * BM * K * 2; u.b = B + (size_t)e * bstride + (size_t)ct * BM * K * 2; return true; }
    __device__ __forceinline__ void voff(const Unit& u, int K_, const int (&R)[2], const int (&C)[2], unsigned (&vo)[2][2]) const {
        const int n = (int)cnt[u.kind];
#pragma unroll
        for (int h = 0; h < 2; ++h)
#pragma unroll
            for (int i = 0; i < 2; ++i) { int row = R[i] + HALF * h;
                if (gather) { const int r = u.aux * BM + row; row = r < n ? (list[(size_t)u.kind * 16640 + r] >> 1) : 0; }
                vo[h][i] = (unsigned)(row * K_ + C[i]) * 2u; } }
};
}

__device__ __forceinline__ int slot_of(Frame& F, int tok, int k) {
    const LAS int* toff = (const LAS int*)(F.lds + TOFF_OFF);
    const int e = ((const int*)(F.ws + WS_RE))[tok * 2 + k], p = ((const int*)(F.ws + WS_RP))[tok * 2 + k];
    return 256 * toff[e] + p;
}
struct RowRaw { f32x4 h[4]; v2u a[4], b[4]; float w0, w1; };
struct RowMeta { int s0, s1; float w0, w1; };
__device__ __forceinline__ RowMeta row_meta(Frame& F, int l, int nrows) {
    RowMeta m; m.s0 = 0; m.s1 = 0; m.w0 = 0.f; m.w1 = 0.f;
    const int r = F.gw + F.lane * F.NGW;
    if (l > 0 && r < nrows) { m.s0 = slot_of(F, r, 0); m.s1 = slot_of(F, r, 1); m.w0 = ((const float*)(F.ws + WS_RW))[r * 2]; m.w1 = ((const float*)(F.ws + WS_RW))[r * 2 + 1]; }
    return m;
}
__device__ __forceinline__ void row_issue(Frame& F, int l, int row, const RowMeta& m, int i, RowRaw& r) {
    if (l == 0) { gcf src = row >= M ? INP(1) + (size_t)(row - M) * D : INP(0) + (size_t)row * D;
#pragma unroll
        for (int j = 0; j < 4; ++j) { r.h[j] = ((const f32x4 GAS*)src)[F.lane + 64 * j]; r.a[j] = (v2u){0u, 0u}; r.b[j] = (v2u){0u, 0u}; }
        r.w0 = 0.f; r.w1 = 0.f; return; }
    const int s0 = __builtin_amdgcn_readlane(m.s0, i), s1 = __builtin_amdgcn_readlane(m.s1, i);
    r.w0 = __int_as_float(__builtin_amdgcn_readlane(__float_as_int(m.w0), i)); r.w1 = __int_as_float(__builtin_amdgcn_readlane(__float_as_int(m.w1), i));
    const float* hr = (const float*)(F.ws + WS_H) + (size_t)row * D;
    const bf16* y0 = (const bf16*)(F.ws + WS_Y) + (size_t)s0 * D; const bf16* y1 = (const bf16*)(F.ws + WS_Y) + (size_t)s1 * D;
#pragma unroll
    for (int j = 0; j < 4; ++j) { r.h[j] = ((const f32x4*)hr)[F.lane + 64 * j]; r.a[j] = ((const v2u*)y0)[F.lane + 64 * j]; r.b[j] = ((const v2u*)y1)[F.lane + 64 * j]; }
}
__device__ __forceinline__ void row_combine(const RowRaw& r, f32x4 (&v)[4]) {
#pragma unroll
    for (int j = 0; j < 4; ++j) v[j] = r.h[j] + r.w0 * (f32x4){bflo(r.a[j].x), bfhi(r.a[j].x), bflo(r.a[j].y), bfhi(r.a[j].y)} + r.w1 * (f32x4){bflo(r.b[j].x), bfhi(r.b[j].x), bflo(r.b[j].y), bfhi(r.b[j].y)};
}
__device__ __forceinline__ void phase_t1(Frame& F, int l) {
    LAS float* wf = (LAS float*)(F.lds);
    { gcf win = INP(3) + (size_t)l * D * INC + 6144;
      float t[32];
#pragma unroll
      for (int u = 0; u < 32; ++u) { const int i = F.tid + u * (NWAVES * 64); t[u] = win[(size_t)(i >> 4) * INC + (i & 15)]; }
#pragma unroll
      for (int u = 0; u < 32; ++u) wf[(F.tid & 15) * D + (F.tid >> 4) + 32 * u] = t[u]; }
    if (l > 0) build_toff(F, l - 1); else __syncthreads();
    gcf g1 = INP(2) + (size_t)l * D; gcf bfg = INP(4) + l * 16;
    float* H = (float*)(F.ws + WS_H); bf16* XN = (bf16*)(F.ws + WS_XN); float* FL = (float*)(F.ws + WS_FL); float* HNM = (float*)(F.ws + WS_HNM);
#ifndef REP_ROWS
#define REP_ROWS 0
#endif
    for (int rr_ = (l == 0 ? REP_ROWS : 0); rr_ >= 0; --rr_)
    { const RowMeta meta = row_meta(F, l, NTOK); const int nr = (NTOK - F.gw + F.NGW - 1) / F.NGW; RowRaw cur; row_issue(F, l, F.gw, meta, 0, cur);
    for (int ri = 0; ri < nr; ++ri) { const int row = F.gw + ri * F.NGW;
        RowRaw nxt = cur; if (ri + 1 < nr) row_issue(F, l, row + F.NGW, meta, ri + 1, nxt);
        f32x4 v[4]; row_combine(cur, v); cur = nxt;
        float ss = 0.f;
#pragma unroll
        for (int j = 0; j < 4; ++j) { ((f32x4*)(H + (size_t)row * D))[F.lane + 64 * j] = v[j]; ss += (v[j].x * v[j].x + v[j].y * v[j].y) + (v[j].z * v[j].z + v[j].w * v[j].w); }
        const float rstd = __builtin_amdgcn_rsqf(wave_sum(ss) * (1.f / D) + EPS);
#pragma unroll
        for (int j = 0; j < 4; ++j) { v[j] = v[j] * rstd * ((const f32x4 GAS*)g1)[F.lane + 64 * j];
            v2u o; o.x = pk2(v[j].x, v[j].y); o.y = pk2(v[j].z, v[j].w); ((v2u*)(XN + (size_t)row * D))[F.lane + 64 * j] = o;
            if (row >= M) ((f32x4*)(HNM + (size_t)(row - M) * D))[F.lane + 64 * j] = v[j]; }
        float mine = 0.f;
#pragma unroll 1
        for (int jg = 0; jg < 16; jg += 4) { float s4[4];
#pragma unroll
            for (int q = 0; q < 4; ++q) { float s = 0.f;
#pragma unroll
                for (int j = 0; j < 4; ++j) { const f32x4 w = *(const LAS f32x4*)(wf + (jg + q) * D + 4 * F.lane + 256 * j); s += (v[j].x * w.x + v[j].y * w.y) + (v[j].z * w.z + v[j].w * w.w); }
                s4[q] = s; }
#pragma unroll
            for (int o = 1; o < 64; o <<= 1) {
#pragma unroll
                for (int q = 0; q < 4; ++q) s4[q] += pg8::shx(s4[q], o, F.lane); }
#pragma unroll
            for (int q = 0; q < 4; ++q) mine = (F.lane == jg + q) ? s4[q] : mine; }
        if (F.lane < 16) { const float f = mine + bfg[F.lane]; FL[(size_t)row * 16 + F.lane] = fminf(f, 0.f) * LOG2E - __builtin_amdgcn_logf(1.0f + __builtin_amdgcn_exp2f(-fabsf(f) * LOG2E)); }
    } }
    LAS float* scr = (LAS float*)(F.lds + 65536 + F.wave * 8448);
#ifndef REP_CONV
#define REP_CONV 0
#endif
    for (int rc = 0; rc <= REP_CONV; ++rc) {
    if (l == 0) {
        for (int it = F.gw; it < 2 * IT_DENSE; it += F.NGW) conv_dense_item(F, it / IT_DENSE, it % IT_DENSE, scr);
    }
    for (int it = F.gw; it < IT_EXPL; it += F.NGW) conv_expert_item(F, l, it, scr);
    }
}
__device__ __forceinline__ LAS float* meta_slice(Frame& F, const float* A, gcf W, int ld, int col0, int slot) {
    LAS float* Al = (LAS float*)F.lds; LAS float* red = (LAS float*)(F.lds + 65536); LAS float* out = (LAS float*)(F.lds + 98304 + 4096 * slot);
    __syncthreads();
    { float t[32];
#pragma unroll
      for (int u = 0; u < 32; ++u) t[u] = A[F.tid + u * (NWAVES * 64)];
#pragma unroll
      for (int u = 0; u < 32; ++u) Al[(F.tid + 512 * (u & 1)) * 16 + (u >> 1)] = t[u]; }
    __syncthreads();
    float acc[16];
#pragma unroll
    for (int r = 0; r < 16; ++r) acc[r] = 0.f;
    gcf wp = W + col0 + F.lane; const int k0 = F.wave * 128;
#pragma unroll 1
    for (int kb = k0; kb < k0 + 128; kb += 32) { float w[32];
#pragma unroll
        for (int u = 0; u < 32; ++u) w[u] = wp[(size_t)(kb + u) * ld];
#pragma unroll
        for (int u = 0; u < 32; ++u) {
#pragma unroll
            for (int q = 0; q < 4; ++q) { const f32x4 a = *(const LAS f32x4*)(Al + (kb + u) * 16 + 4 * q); acc[4 * q] += a.x * w[u]; acc[4 * q + 1] += a.y * w[u]; acc[4 * q + 2] += a.z * w[u]; acc[4 * q + 3] += a.w * w[u]; } } }
#pragma unroll
    for (int r = 0; r < 16; ++r) red[(F.wave * 16 + r) * 64 + F.lane] = acc[r];
    __syncthreads();
#pragma unroll
    for (int q = 0; q < 2; ++q) { const int o = F.tid * 2 + q; float s = 0.f;
#pragma unroll
        for (int g = 0; g < 8; ++g) s += red[g * 1024 + o];
        out[o] = s; }
    __syncthreads();
    return out;
}
__device__ __forceinline__ void g1_side(Frame& F, int l) {
    const int c = blockIdx.x;
    const float* FL = (const float*)(F.ws + WS_FL);
    if (c < 32) {
        const int b = c >> 4, h = c & 15; LAS float* wsum = (LAS float*)(F.lds);
        float x[16]; float run = 0.f;
#pragma unroll
        for (int i = 0; i < 16; ++i) { run += FL[((size_t)b * SEQ + F.tid * 16 + i) * 16 + h]; x[i] = run; }
        float inc = run;
#pragma unroll
        for (int o = 1; o < 64; o <<= 1) { const float t = __int_as_float(__builtin_amdgcn_ds_bpermute(((F.lane - o) & 63) << 2, __float_as_int(inc))); if (F.lane >= o) inc += t; }
        if (F.lane == 63) wsum[F.wave] = inc;
        __syncthreads();
        float base = inc - run;
        for (int w = 0; w < F.wave; ++w) base += wsum[w];
        float* CB = (float*)(F.ws + WS_CB) + (size_t)c * SEQ + F.tid * 16;
#pragma unroll
        for (int i = 0; i < 16; ++i) CB[i] = base + x[i];
        if (c < 16 && F.tid == 0) { float cm[16]; float r2 = 0.f;
#pragma unroll
            for (int j = 0; j < 16; ++j) { r2 += FL[(size_t)(MROW + j) * 16 + c]; cm[j] = r2; }
#pragma unroll
            for (int j = 0; j < 16; ++j) ((float*)(F.ws + WS_CBM))[c * 16 + j] = cm[j] - r2; }
        __syncthreads();
    }
    if (c < 128) {
        const int col0 = c < 96 ? 64 * c : 6160 + 64 * (c - 96);
        LAS float* out = meta_slice(F, (const float*)(F.ws + WS_HNM), INP(3) + (size_t)l * D * INC, INC, col0, 0);
        float* PM = (float*)(F.ws + WS_PM);
#pragma unroll
        for (int rr = 0; rr < 2; ++rr) { const int r = 2 * F.wave + rr; float v = out[r * 64 + F.lane];
            if (col0 >= 3072 && col0 < 5120) { const float ss = wave_sum(v * v); const float g = (col0 < 4096 ? INP(7) : INP(8))[l * 64 + F.lane]; v = v * __builtin_amdgcn_rsqf(ss * (1.f / 64.f) + EPS) * g; }
            if (col0 >= 6160) v = pg8::sigmoidf_fast(v);
            PM[(size_t)r * INC + col0 + F.lane] = v;
            if (col0 >= 4096 && col0 < 5120) ((bf16*)(F.ws + WS_K))[(size_t)(MROW + r) * D + (col0 - 4096) + F.lane] = (bf16)f2bf(v);
            if (col0 >= 5120 && col0 < 6144) ((bf16*)(F.ws + WS_V))[(size_t)(MROW + r) * D + (col0 - 5120) + F.lane] = (bf16)f2bf(v); }
        __syncthreads();
    }
}
__device__ __forceinline__ void a1_side(Frame& F, int l) {
    gcf cw = INP(5) + (size_t)l * 3 * D; const float* PM = (const float*)(F.ws + WS_PM);
    const bf16* Z = (const bf16*)(F.ws + WS_Z); const bf16* BG = (const bf16*)(F.ws + WS_BG); bf16* YAIN = (bf16*)(F.ws + WS_YAIN);
    for (int ci = F.gw; ci < M / 8; ci += F.NGW) {
        const int m0 = ci * 8, t0 = m0 & (SEQ - 1);
#pragma unroll
        for (int j = 0; j < 2; ++j) { const int d0 = 8 * F.lane + 512 * j;
            float w0[8], w1[8], w2[8], zp2[8], zp1[8];
#pragma unroll
            for (int i = 0; i < 8; ++i) { w0[i] = cw[d0 + i]; w1[i] = cw[D + d0 + i]; w2[i] = cw[2 * D + d0 + i]; }
            if (t0 == 0) {
#pragma unroll
                for (int i = 0; i < 8; ++i) { zp2[i] = PM[(size_t)14 * INC + 1024 + d0 + i] * PM[(size_t)14 * INC + 2048 + d0 + i]; zp1[i] = PM[(size_t)15 * INC + 1024 + d0 + i] * PM[(size_t)15 * INC + 2048 + d0 + i]; }
            } else { const v4u a = *(const v4u*)(Z + (size_t)(m0 - 2) * D + d0), b = *(const v4u*)(Z + (size_t)(m0 - 1) * D + d0);
                zp2[0] = bflo(a.x); zp2[1] = bfhi(a.x); zp2[2] = bflo(a.y); zp2[3] = bfhi(a.y); zp2[4] = bflo(a.z); zp2[5] = bfhi(a.z); zp2[6] = bflo(a.w); zp2[7] = bfhi(a.w);
                zp1[0] = bflo(b.x); zp1[1] = bfhi(b.x); zp1[2] = bflo(b.y); zp1[3] = bfhi(b.y); zp1[4] = bflo(b.z); zp1[5] = bfhi(b.z); zp1[6] = bflo(b.w); zp1[7] = bfhi(b.w); }
            v4u zr[8], gr[8];
#pragma unroll
            for (int r = 0; r < 8; ++r) { zr[r] = *(const v4u*)(Z + (size_t)(m0 + r) * D + d0); gr[r] = *(const v4u*)(BG + (size_t)(m0 + r) * D + d0); }
#pragma unroll
            for (int r = 0; r < 8; ++r) { const v4u zz = zr[r], gg = gr[r];
                float z[8], g[8], y[8];
                z[0] = bflo(zz.x); z[1] = bfhi(zz.x); z[2] = bflo(zz.y); z[3] = bfhi(zz.y); z[4] = bflo(zz.z); z[5] = bfhi(zz.z); z[6] = bflo(zz.w); z[7] = bfhi(zz.w);
                g[0] = bflo(gg.x); g[1] = bfhi(gg.x); g[2] = bflo(gg.y); g[3] = bfhi(gg.y); g[4] = bflo(gg.z); g[5] = bfhi(gg.z); g[6] = bflo(gg.w); g[7] = bfhi(gg.w);
#pragma unroll
                for (int i = 0; i < 8; ++i) { y[i] = g[i] * (w0[i] * zp2[i] + w1[i] * zp1[i] + w2[i] * z[i]); zp2[i] = zp1[i]; zp1[i] = z[i]; }
                v4u o; o.x = pk2(y[0], y[1]); o.y = pk2(y[2], y[3]); o.z = pk2(y[4], y[5]); o.w = pk2(y[6], y[7]);
                *(GAS v4u*)(YAIN + (size_t)(m0 + r) * D + d0) = o; }
        }
    }
}
__device__ __forceinline__ void g2_side(Frame& F, int l) {
    if (blockIdx.x >= 16) return;
    const int col0 = 64 * blockIdx.x; const float* PM = (const float*)(F.ws + WS_PM);
    LAS float* ya = meta_slice(F, (const float*)(F.ws + WS_YAINM), INP(6) + (size_t)l * D * D, D, col0, 0);
    LAS float* yb = meta_slice(F, (const float*)(F.ws + WS_OM), INP(9) + (size_t)l * D * D, D, col0, 1);
#pragma unroll
    for (int q = 0; q < 2; ++q) { const int o = F.tid * 2 + q, r = o >> 6, cc = o & 63;
        ((float*)(F.ws + WS_MGM))[(size_t)r * D + col0 + cc] = PM[(size_t)r * INC + 6160 + col0 + cc] * ya[o] + PM[(size_t)r * INC + 7184 + col0 + cc] * yb[o]; }
    __syncthreads();
}
__device__ __forceinline__ void g3_side(Frame& F, int l) {
    if (blockIdx.x >= 16) return;
    const int col0 = 64 * blockIdx.x;
    LAS float* y = meta_slice(F, (const float*)(F.ws + WS_MGM), INP(10) + (size_t)l * D * D, D, col0, 0);
#pragma unroll
    for (int q = 0; q < 2; ++q) { const int o = F.tid * 2 + q, r = o >> 6, cc = o & 63; ((float*)(F.ws + WS_H))[(size_t)(MROW + r) * D + col0 + cc] += y[o]; }
    __syncthreads();
}
__device__ __forceinline__ void phase_t2(Frame& F, int l, int bank, size_t dump) {
    LAS float* wr = (LAS float*)F.lds;
    { gcf wg = INP(12) + (size_t)l * D * 4; gcf we = INP(14) + (size_t)l * D * NE;
#pragma unroll 1
      for (int b0 = 0; b0 < 64; b0 += 16) { float t[16];
#pragma unroll
          for (int u = 0; u < 16; ++u) t[u] = we[F.tid + (b0 + u) * (NWAVES * 64)];
#pragma unroll
          for (int u = 0; u < 16; ++u) wr[((F.tid >> 5) + 16 * (b0 + u)) * 36 + 4 + (F.tid & 31)] = t[u]; }
      { float t[8];
#pragma unroll
          for (int u = 0; u < 8; ++u) t[u] = wg[F.tid + u * (NWAVES * 64)];
#pragma unroll
          for (int u = 0; u < 8; ++u) wr[((F.tid >> 2) + 128 * u) * 36 + (F.tid & 3)] = t[u]; } }
    LAS int* lcnt = (LAS int*)(F.lds + 147456); LAS int* lbase = lcnt + 32; LAS int* rec = lbase + 32; LAS float* recw = (LAS float*)(rec + 80 * 4);
    if (F.tid < 32) lcnt[F.tid] = 0;
    __syncthreads();
    gcf g2 = INP(11) + (size_t)l * D; gcf bg = INP(13) + l * 4; gcf be = INP(15) + l * NE;
    const float* H = (const float*)(F.ws + WS_H); bf16* XN = (bf16*)(F.ws + WS_XN);
    const int c = blockIdx.x, nrows = (c < 16 && F.wave == 0) ? 9 : 8;
    float xn[16];
#pragma unroll
    for (int jj = 0; jj < 16; ++jj) xn[jj] = H[(size_t)(64 * c + 8 * F.wave) * D + F.lane + 64 * jj];
    for (int i = 0; i < nrows; ++i) {
        const int sl = i < 8 ? 8 * F.wave + i : 64, row = i < 8 ? 64 * c + sl : MROW + c;
        float x[16]; float ss = 0.f;
#pragma unroll
        for (int jj = 0; jj < 16; ++jj) { x[jj] = xn[jj]; ss += x[jj] * x[jj]; }
        if (i + 1 < nrows) { const int rown = i + 1 < 8 ? 64 * c + 8 * F.wave + i + 1 : MROW + c;
#pragma unroll
            for (int jj = 0; jj < 16; ++jj) xn[jj] = H[(size_t)rown * D + F.lane + 64 * jj]; }
        const float rstd = __builtin_amdgcn_rsqf(wave_sum(ss) * (1.f / D) + EPS);
        float acc[36];
#pragma unroll
        for (int q = 0; q < 36; ++q) acc[q] = 0.f;
#pragma unroll
        for (int jj = 0; jj < 16; ++jj) { const float hn = x[jj] * rstd * g2[F.lane + 64 * jj]; XN[(size_t)row * D + F.lane + 64 * jj] = (bf16)f2bf(hn);
            const LAS float* wrow = wr + (F.lane + 64 * jj) * 36;
#pragma unroll
            for (int q = 0; q < 9; ++q) { const f32x4 w = *(const LAS f32x4*)(wrow + 4 * q); acc[4 * q] += hn * w.x; acc[4 * q + 1] += hn * w.y; acc[4 * q + 2] += hn * w.z; acc[4 * q + 3] += hn * w.w; } }
#pragma unroll
        for (int q = 0; q < 36; ++q) acc[q] = wave_sum(acc[q]);
        float gl[4]; int gi = 0;
#pragma unroll
        for (int j = 0; j < 4; ++j) gl[j] = acc[j] + bg[j];
        float gb = gl[0];
#pragma unroll
        for (int j = 1; j < 4; ++j) if (gl[j] > gb) { gb = gl[j]; gi = j; }
        float gs = 0.f;
#pragma unroll
        for (int j = 0; j < 4; ++j) gs += __builtin_amdgcn_exp2f((gl[j] - gb) * LOG2E);
        const float gw = 1.f / gs;
        float el[8];
#pragma unroll
        for (int j = 0; j < 8; ++j) el[j] = (gi == 0 ? acc[4 + j] : gi == 1 ? acc[12 + j] : gi == 2 ? acc[20 + j] : acc[28 + j]) + be[gi * 8 + j];
        int i1 = 0; float b1 = el[0];
#pragma unroll
        for (int j = 1; j < 8; ++j) if (el[j] > b1) { b1 = el[j]; i1 = j; }
        int i2 = -1; float b2 = -INFINITY;
#pragma unroll
        for (int j = 0; j < 8; ++j) if (j != i1 && (i2 < 0 || el[j] > b2)) { b2 = el[j]; i2 = j; }
        const float p2 = __builtin_amdgcn_exp2f((b2 - b1) * LOG2E), w1 = gw / (1.f + p2), w2 = gw * p2 / (1.f + p2);
        if (F.lane == 0) { const int e1 = gi * 8 + i1, e2 = gi * 8 + i2;
            rec[sl * 4 + 0] = e1; rec[sl * 4 + 1] = __hip_atomic_fetch_add(lcnt + e1, 1, __ATOMIC_RELAXED, __HIP_MEMORY_SCOPE_WORKGROUP);
            rec[sl * 4 + 2] = e2; rec[sl * 4 + 3] = __hip_atomic_fetch_add(lcnt + e2, 1, __ATOMIC_RELAXED, __HIP_MEMORY_SCOPE_WORKGROUP);
            recw[sl * 2] = w1; recw[sl * 2 + 1] = w2; }
    }
    __syncthreads();
    if (F.tid < 32) { const int n = lcnt[F.tid]; lbase[F.tid] = n ? (int)__hip_atomic_fetch_add(F.ctl + CW_CNT + 64 * bank + F.tid, (unsigned)n, RLX_AGENT) : 0; }
    __syncthreads();
    if (F.tid < 65 && (F.tid < 64 || c < 16)) { const int sl = F.tid, tok = sl < 64 ? 64 * c + sl : MROW + c;
#pragma unroll
        for (int k = 0; k < 2; ++k) { const int e = rec[sl * 4 + 2 * k], pos = lbase[e] + rec[sl * 4 + 2 * k + 1];
            ((int*)(F.ws + dump + WS_LIST))[(size_t)e * MP + pos] = 2 * tok + k; ((int*)(F.ws + dump + WS_RE))[2 * tok + k] = e; ((int*)(F.ws + dump + WS_RP))[2 * tok + k] = pos; ((float*)(F.ws + dump + WS_RW))[2 * tok + k] = recw[sl * 2 + k]; } }
}
__device__ __forceinline__ void a1_meta(Frame& F, int l) {
    if (blockIdx.x >= 16) return;
    const int h = blockIdx.x; gcf cw = INP(5) + (size_t)l * 3 * D; const float* PM = (const float*)(F.ws + WS_PM);
    float* YAINM = (float*)(F.ws + WS_YAINM); float* OM = (float*)(F.ws + WS_OM); const float* CBM = (const float*)(F.ws + WS_CBM);
#pragma unroll
    for (int q2 = 0; q2 < 2; ++q2) { const int o = F.tid * 2 + q2, r = o >> 6, d = 64 * h + (o & 63); float y = 0.f;
#pragma unroll
        for (int q = 0; q < 3; ++q) { const int rr = r - 2 + q; if (rr >= 0) y += PM[(size_t)rr * INC + 1024 + d] * PM[(size_t)rr * INC + 2048 + d] * cw[q * D + d]; }
        YAINM[(size_t)r * D + d] = PM[(size_t)r * INC + d] * y; }
    LAS float* sc = (LAS float*)F.lds;
    __syncthreads();
    if (F.tid < 256) { const int r = F.tid >> 4, s = F.tid & 15; const f32x4* q = (const f32x4*)(PM + (size_t)r * INC + 3072 + 64 * h); const f32x4* k = (const f32x4*)(PM + (size_t)s * INC + 4096 + 64 * h); float dsum = 0.f;
#pragma unroll
        for (int d = 0; d < 16; ++d) { const f32x4 a = q[d], b = k[d]; dsum += (a.x * b.x + a.y * b.y) + (a.z * b.z + a.w * b.w); }
        sc[F.tid] = (s <= r) ? dsum * attn_body::C2 + (CBM[h * 16 + r] - CBM[h * 16 + s]) : -INFINITY; }
    __syncthreads();
    if (F.tid < 16) { float mx = -INFINITY, ls = 0.f;
#pragma unroll
        for (int s = 0; s < 16; ++s) mx = fmaxf(mx, sc[F.tid * 16 + s]);
        float p[16];
#pragma unroll
        for (int s = 0; s < 16; ++s) { p[s] = __builtin_amdgcn_exp2f(sc[F.tid * 16 + s] - mx); ls += p[s]; }
        const float il = 1.f / ls;
#pragma unroll
        for (int s = 0; s < 16; ++s) sc[F.tid * 16 + s] = p[s] * il; }
    __syncthreads();
#pragma unroll
    for (int q2 = 0; q2 < 2; ++q2) { const int o = F.tid * 2 + q2, r = o >> 6, d = o & 63; float acc = 0.f;
#pragma unroll
        for (int s = 0; s < 16; ++s) acc += sc[r * 16 + s] * PM[(size_t)s * INC + 5120 + 64 * h + d];
        OM[(size_t)r * D + 64 * h + d] = acc; }
    __syncthreads();
}
__device__ __forceinline__ void phase_attn(Frame& F, int l, char* lds_generic) {
    const float mq = wave_max(fabsf(INP(7)[l * 64 + F.lane])), mk = wave_max(fabsf(INP(8)[l * 64 + F.lane]));
    const float m0 = 8.f * LOG2E * mq * mk * 1.02f + 0.25f;
    const float TH = 2.f * m0 + 53.f;
    const attn_body::bf16* Q = (const attn_body::bf16*)(F.ws + WS_Q); const attn_body::bf16* K = (const attn_body::bf16*)(F.ws + WS_K); const attn_body::bf16* V = (const attn_body::bf16*)(F.ws + WS_V);
    volatile LAS int* qslot = (volatile LAS int*)(F.lds + LDSCTL_OFF + 640);
    gu32* qhead = F.ctl + CW_AQ + 64 * l;
    if (F.tid == 0) *qslot = (int)__hip_atomic_fetch_add(qhead, 1u, RLX_AGENT);
    __syncthreads();
    int p = __builtin_amdgcn_readfirstlane(*qslot);
    while (p < 1024) {
        int pnext = 0; if (F.tid == 0) pnext = (int)__hip_atomic_fetch_add(qhead, 1u, RLX_AGENT);
        const int qb = 31 - (p >> 5), bh = p & 31; const float* cbh = (const float*)(F.ws + WS_CB) + (size_t)bh * SEQ;
        const float cbq = cbh[256 * qb]; const int nj = 4 * qb;
        const bool f0 = F.lane < nj && (cbq - cbh[64 * F.lane + 63] < -TH), f1 = F.lane + 64 < nj && (cbq - cbh[64 * (F.lane + 64) + 63] < -TH);
        int ts = __builtin_popcountll(__builtin_amdgcn_ballot_w64(f0)) + __builtin_popcountll(__builtin_amdgcn_ballot_w64(f1));
        const int has_meta = (ts == 0) ? 1 : 0; int dummy = 0;
        if ((has_meta + 4 * qb + 4 - ts) & 1) { if (ts > 0) --ts; else dummy = 1; }
        attn_body::attn_unit(F.tid, bh >> 4, bh & 15, qb, ts, has_meta + dummy, Q, K, V, (attn_body::bf16*)(F.ws + WS_XN), cbh, (const float*)(F.ws + WS_CBM) + (bh & 15) * 16, m0, lds_generic);
        if (F.tid == 0) *qslot = pnext;
        asm volatile("s_waitcnt vmcnt(0) lgkmcnt(0)\n\ts_barrier" ::: "memory");
        p = __builtin_amdgcn_readfirstlane(*qslot);
    }
}
__device__ __forceinline__ void phase_out(Frame& F) {
    build_toff(F, 1);
#ifdef PROBE_PH
    const float pscale = 1.0f + (float)(unsigned)(__hip_atomic_load((GAS unsigned long long*)(F.ctl + 32) + (PROBE_PH + 1), RLX_AGENT) - __hip_atomic_load((GAS unsigned long long*)(F.ctl + 32) + PROBE_PH, RLX_AGENT)) * (1.0f / (100.0f * PROBE_DIV));
#else
    const float pscale = 1.0f;
#endif
    { const RowMeta meta = row_meta(F, 1, M); const int nr = (M - F.gw + F.NGW - 1) / F.NGW; RowRaw cur; row_issue(F, 1, F.gw, meta, 0, cur);
    for (int ri = 0; ri < nr; ++ri) { const int row = F.gw + ri * F.NGW;
        RowRaw nxt = cur; if (ri + 1 < nr) row_issue(F, 1, row + F.NGW, meta, ri + 1, nxt);
        f32x4 v[4]; row_combine(cur, v); cur = nxt;
#pragma unroll
        for (int j = 0; j < 4; ++j) ((f32x4*)(F.out + (size_t)row * D))[F.lane + 64 * j] = v[j] * pscale; } }
}

#ifndef MK_N_LAUNCHES
#define MK_N_LAUNCHES 1
#endif
constexpr int N_PHASES = 17;
struct Args { const float* in[19]; float* out; unsigned char* ws; int ph_lo, ph_hi, li, two; };
__global__ void __launch_bounds__(NWAVES * 64, 2) fwd_kernel(Args args) {
    extern __shared__ __attribute__((aligned(16))) unsigned char lds[];
    Frame F;
    F.lds = (LAS unsigned char*)lds; F.MISC = (volatile LAS unsigned*)(F.lds + MISC_OFF);
    F.tid = threadIdx.x; F.lane = F.tid & 63; F.wave = __builtin_amdgcn_readfirstlane(F.tid >> 6);
    F.G = gridDim.x; { const int bx = blockIdx.x; F.vcu = (F.G % 8 == 0) ? (bx % 8) * (F.G / 8) + bx / 8 : bx; }
    F.gw = F.vcu * NWAVES + F.wave; F.NGW = F.G * NWAVES;
    F.ws = args.ws; F.ctl = (gu32*)(args.ws + WS_CTL); F.out = args.out;
    for (int u = F.tid; u < (LDS_BYTES - LDSCTL_OFF) / 4; u += NWAVES * 64) ((LAS unsigned*)(F.lds + LDSCTL_OFF))[u] = 0u;
    __syncthreads();
    if (F.tid == 0) {
#pragma unroll
        for (int i = 0; i < 19; ++i) *(LAS unsigned long long*)(F.lds + INP_OFF + 8 * i) = (unsigned long long)args.in[i]; }
    __syncthreads();
    XcdBarrier bar = xcd_barrier_post((unsigned*)(F.ctl + CW_BAR) + args.li * XCD_BAR_WORDS, F.MISC + 8);
#ifdef PROBE_PH
    if (blockIdx.x == 0 && F.tid == 0) __hip_atomic_store((GAS unsigned long long*)(F.ctl + 32), __builtin_amdgcn_s_memrealtime(), RLX_AGENT);
#endif
    const int lo = args.ph_lo, hi = args.ph_hi; int ph = 0; const int wave_s = F.wave;
#ifndef REP_PH
#define REP_PH (-1)
#endif
#ifndef REP_N
#define REP_N 0
#endif
#ifndef SUBMASK
#define SUBMASK 7
#endif
#ifndef PHMASK
#define PHMASK 0x1ff
#endif
#define PHB(k) if (((PHMASK >> (k)) & 1) && lo <= ph && ph < hi) { for (int rep_ = (ph == REP_PH ? REP_N : 0); rep_ >= 0; --rep_) { { int ot_; asm volatile("v_mbcnt_lo_u32_b32 %0, -1, 0\n\tv_mbcnt_hi_u32_b32 %0, -1, %0" : "=v"(ot_)); ot_ += wave_s * 64; F.tid = ot_; F.lane = ot_ & 63; F.wave = __builtin_amdgcn_readfirstlane(ot_ >> 6); F.gw = F.vcu * NWAVES + F.wave; size_t z_ = 0; asm volatile("" : "+s"(z_)); F.ws = args.ws + z_; F.ctl = (gu32*)(F.ws + WS_CTL); }
#ifdef PROBE_PH
#define PH_STAMP() do { if (blockIdx.x == 0 && F.tid == 0) __hip_atomic_store((GAS unsigned long long*)(F.ctl + 32) + (ph + 1), __builtin_amdgcn_s_memrealtime(), RLX_AGENT); } while (0)
#else
#define PH_STAMP() do {} while (0)
#endif
#define PH_END   } if (ph + 1 < hi) xcd_barrier(bar); PH_STAMP(); } ++ph;
    if (lo == 0) {
        for (int i = F.gw * 64 + F.lane; i < 2 * 64 * D / 8; i += F.NGW * 64) { const int wbuf = i / (64 * D / 8), r = i % (64 * D / 8);
            ((GAS v4u*)(F.ws + (wbuf ? WS_V : WS_K) + (size_t)MROW * D * 2))[r] = (v4u){0u, 0u, 0u, 0u}; } }
    for (int l = 0; l < DEPTH; ++l) {
        unsigned char* wl = F.ws + WS_WD0 + (size_t)l * WD_LAYER;
        PHB(0) phase_t1(F, l); PH_END
        PHB(1) if (SUBMASK & 1) g1_side(F, l); if (SUBMASK & 2)
            { pg8::SchedDense S{(const char*)(F.ws + WS_XN), (const char*)wl, 64, 32, F.G, (int)blockIdx.x, D};
              pg8::EpiG1 E{(bf16*)(F.ws + WS_ACT), ACT_STRIDE / 2, INP(7) + l * 64, attn_body::C2, (long)(INP(8) - INP(7))};
              pg8::gemm_phase<pg8::EpiG1, pg8::SchedDense, true>(F.tid, F.lds + RING_OFF, D, S, E); }
        PH_END
        PHB(2) if (SUBMASK & 1) a1_side(F, l); if (SUBMASK & 2) a1_meta(F, l); if (SUBMASK & 4) phase_attn(F, l, (char*)lds + RING_OFF); PH_END
        PHB(3) if (SUBMASK & 1) g2_side(F, l); if (SUBMASK & 2)
            { pg8::SchedPair S{(const char*)(F.ws + WS_YAIN), (const char*)(wl + WO_WC), (long)WS_XN - (long)WS_YAIN, (long)WO_WA - (long)WO_WC, (int)blockIdx.x, args.two};
              pg8::EpiG2 E{(bf16*)(F.ws + WS_MG), (const bf16*)(F.ws + WS_SGA), ACT_STRIDE / 2};
              if (blockIdx.x < 256) pg8::gemm_phase<pg8::EpiG2, pg8::SchedPair, true>(F.tid, F.lds + RING_OFF, D, S, E); }
        PH_END
        PHB(4) g3_side(F, l);
            { pg8::SchedDense S{(const char*)(F.ws + WS_MG), (const char*)(wl + WO_WM), 64, 4, F.G, (int)blockIdx.x, D};
              pg8::EpiG3 E{(float*)(F.ws + (rep_ > 0 ? WS_Y : WS_H))};
              pg8::gemm_phase<pg8::EpiG3, pg8::SchedDense, true>(F.tid, F.lds + RING_OFF, D, S, E); }
        PH_END
        PHB(5) phase_t2(F, l, l + 2 * (int)(rep_ > 0), (size_t)(rep_ > 0) << 23); PH_END
        PHB(6) build_toff(F, l);
            { pg8::SchedMoe S{(const char*)(F.ws + WS_XN), (const char*)(F.ws + WS_WGU), (const int*)(F.ws + WS_LIST), (const unsigned*)(F.ctl + CW_CNT + 64 * l), (const LAS int*)(F.lds + TOFF_OFF), F.G, F.vcu, D, (size_t)D * D * 2, true};
              pg8::EpiM1 E{(bf16*)(F.ws + WS_HACT)};
              pg8::gemm_phase<pg8::EpiM1, pg8::SchedMoe, true>(F.tid, F.lds + RING_OFF, D, S, E); }
        PH_END
        PHB(7) build_toff(F, l);
            { pg8::SchedMoe S{(const char*)(F.ws + WS_HACT), (const char*)(F.ws + WS_WDN), (const int*)(F.ws + WS_LIST), (const unsigned*)(F.ctl + CW_CNT + 64 * l), (const LAS int*)(F.lds + TOFF_OFF), F.G, F.vcu, DE, (size_t)D * DE * 2, false};
              pg8::EpiM2 E{(bf16*)(F.ws + WS_Y)};
              pg8::gemm_phase<pg8::EpiM2, pg8::SchedMoe, true>(F.tid, F.lds + RING_OFF, DE, S, E); }
        PH_END
    }
    PHB(8) phase_out(F); PH_END
#undef PHB
#undef PH_END
}

extern "C" void kernel_launch(void* const* d_in, const int* in_sizes, int n_in, void* d_out, int out_size, void* d_ws, size_t ws_size, hipStream_t stream) {
    static int grid = 0;
    if (grid == 0) {
        if (n_in != 19 || in_sizes[0] != M * D || out_size != M * D || ws_size < WS_END) { fprintf(stderr, "kernel_launch: unexpected shapes / workspace (n_in %d, in0 %d, out %d, ws %zu, need %zu); nothing launched\n", n_in, n_in > 0 ? in_sizes[0] : -1, out_size, ws_size, (size_t)WS_END); grid = -1; return; }
        int dev = 0, cus = 0, per_cu = 0;
        if (hipGetDevice(&dev) != hipSuccess || hipDeviceGetAttribute(&cus, hipDeviceAttributeMultiprocessorCount, dev) != hipSuccess) { grid = -1; return; }
        if (hipFuncSetAttribute((const void*)fwd_kernel, hipFuncAttributeMaxDynamicSharedMemorySize, LDS_BYTES) != hipSuccess) { fprintf(stderr, "kernel_launch: hipFuncSetAttribute failed\n"); grid = -1; return; }
        if (hipOccupancyMaxActiveBlocksPerMultiprocessor(&per_cu, (const void*)fwd_kernel, NWAVES * 64, LDS_BYTES) != hipSuccess || per_cu < 1) fprintf(stderr, "kernel_launch: note: occupancy query reports %d workgroups per CU\n", per_cu);
        (void)hipGetLastError();
        grid = cus;
        if (grid != 256) fprintf(stderr, "kernel_launch: note: %d CUs (tuned for 256)\n", grid);
    }
    if (grid < 0) return;
    if (hipMemsetAsync((char*)d_ws + WS_CTL, 0, CTL_ZERO_BYTES, stream) != hipSuccess) return;
    Args a{};
    for (int i = 0; i < 19; ++i) a.in[i] = (const float*)d_in[i];
    a.out = (float*)d_out; a.ws = (unsigned char*)d_ws; a.two = 2;
#if MK_N_LAUNCHES == 1
    a.ph_lo = 0; a.ph_hi = N_PHASES; a.li = 0;
    hipLaunchKernelGGL(fwd_kernel, dim3(grid), dim3(NWAVES * 64), LDS_BYTES, stream, a);
#else
    for (int p = 0; p < N_PHASES; ++p) { a.ph_lo = p; a.ph_hi = p + 1; a.li = 0; hipLaunchKernelGGL(fwd_kernel, dim3(grid), dim3(NWAVES * 64), LDS_BYTES, stream, a); }
#endif
}
```

```cpp
#include <hip/hip_runtime.h>
#include <cstdio>
#include <cstdint>
#include <cmath>
namespace pg8 {
#define PG8_LAS __attribute__((address_space(3)))
typedef unsigned short bf16_t;
typedef short bf16x8 __attribute__((ext_vector_type(8)));
typedef float f32x4 __attribute__((ext_vector_type(4)));
typedef float f32x2 __attribute__((ext_vector_type(2)));
typedef unsigned u32x4 __attribute__((ext_vector_type(4)));
__device__ __forceinline__ float shx(float v, int m, int lane) { return __int_as_float(__builtin_amdgcn_ds_bpermute((lane ^ m) << 2, __float_as_int(v))); }
__device__ __forceinline__ float row16_sum(float v) {
    v += __int_as_float(__builtin_amdgcn_update_dpp(0, __float_as_int(v), 0xB1, 0xF, 0xF, true));
    v += __int_as_float(__builtin_amdgcn_update_dpp(0, __float_as_int(v), 0x4E, 0xF, 0xF, true));
    v += __int_as_float(__builtin_amdgcn_update_dpp(0, __float_as_int(v), 0x141, 0xF, 0xF, true));
    v += __int_as_float(__builtin_amdgcn_update_dpp(0, __float_as_int(v), 0x140, 0xF, 0xF, true));
    return v;
}
constexpr int BM = 256, BK = 64, HALF = 128, HTB = HALF * BK * 2  , STAGE_BYTES = 8 * HTB, NXCD = 8, WGM = 8;

__host__ __device__ __forceinline__ int lds_byte(int r, int c) { const int st = (r >> 4) * 2 + (c >> 5), rr = r & 15, cc = c & 31, ob = rr * 64 + cc * 2; return st * 1024 + (ob ^ (((ob >> 9) & 1) << 5)); }
__host__ __device__ __forceinline__ void stage_rc(int b, int& R, int& C) { const int st = b / 1024, sb = b % 1024, swz = sb ^ (((sb >> 9) & 1) << 5); R = (st >> 1) * 16 + swz / 64; C = (st & 1) * 32 + (swz % 64) / 2; }
__host__ __device__ __forceinline__ int perm32(int rho) { const int n = rho >> 4, i = rho & 15; return 8 * (i >> 2) + 4 * n + (i & 3); }

struct Unit { const char* a; const char* b; int kind, pm, pn, aux; };

__device__ __forceinline__ void tile_of(int L, int nM, int nN, int& pm, int& pn) {
    const int nwg = nM * nN; int wgid = L; { const int q = nwg / NXCD, r = nwg % NXCD, xcd = wgid % NXCD, off = wgid / NXCD; wgid = (xcd < r ? xcd * (q + 1) : r * (q + 1) + (xcd - r) * q) + off; }
    const int nig = WGM * nN, gid = wgid / nig, fm = gid * WGM, gsz = (nM - fm) < WGM ? (nM - fm) : WGM;
    pm = fm + ((wgid % nig) % gsz); pn = (wgid % nig) / gsz;
}
__device__ __forceinline__ unsigned cvt_pk_bf16(float lo, float hi) { unsigned r; asm volatile("v_cvt_pk_bf16_f32 %0, %1, %2" : "=v"(r) : "v"(lo), "v"(hi)); return r; }
__device__ __forceinline__ float bf_lo(unsigned w) { return __uint_as_float(w << 16); }
__device__ __forceinline__ float bf_hi(unsigned w) { return __uint_as_float(w & 0xffff0000u); }
__device__ __forceinline__ float sigmoidf_fast(float x) { return __builtin_amdgcn_rcpf(1.0f + __builtin_amdgcn_exp2f(-1.4426950408889634f * x)); }

template <class Epi, class Sched, bool ALIGN_EPI>
__device__ __forceinline__ void gemm_phase(const int tid, PG8_LAS unsigned char* lds, const int K, const Sched& S, const Epi& E) {
    const int wid = __builtin_amdgcn_readfirstlane(tid >> 6), lane = tid & 63, wr = wid >> 2, wc = wid & 3, fr = lane & 15, fq = lane >> 4;
    const int nt = K / BK;
    int sR[2], sC[2]; unsigned voffB[2];
#pragma unroll
    for (int i = 0; i < 2; ++i) { stage_rc(tid * 16 + i * 8192, sR[i], sC[i]); const int Rb = (sR[i] & ~31) + perm32(sR[i] & 31); voffB[i] = (unsigned)(Rb * K + sC[i]) * 2u; }
    const size_t kstep = (size_t)(BK * 2);
    const size_t hstep = (size_t)HALF * K * 2;
    const unsigned ldsw = (unsigned)wid * 1024u;
    const int aoff = lds_byte(wr * 64 + fr, fq * 8), boff = lds_byte(wc * 32 + fr, fq * 8);
#define PG8_SA(b, h) (((b) * 2 + (h)) * HTB)
#define PG8_SB(b, h) ((4 + (b) * 2 + (h)) * HTB)
#define PG8_STAGE(bufoff, gbase, v0, v1) do { \
        __builtin_amdgcn_global_load_lds((const unsigned*)((const char*)(gbase) + (v0)), (PG8_LAS unsigned*)(lds + (bufoff) + ldsw), 16, 0, 0); \
        __builtin_amdgcn_global_load_lds((const unsigned*)((const char*)(gbase) + (v1)), (PG8_LAS unsigned*)(lds + (bufoff) + ldsw + 8192), 16, 0, 0); } while (0)
#define PG8_STAGEB(bufoff, gbase) PG8_STAGE(bufoff, gbase, voffB[0], voffB[1])
#define PG8_LDA(dst, b, h) do { _Pragma("unroll") for (int m = 0; m < 4; ++m) _Pragma("unroll") for (int k = 0; k < 2; ++k) dst[m][k] = *(const PG8_LAS bf16x8*)(lds + PG8_SA(b, h) + aoff + m * 2048 + k * 1024); } while (0)
#define PG8_LDB(dst, b, h) do { _Pragma("unroll") for (int n = 0; n < 2; ++n) _Pragma("unroll") for (int k = 0; k < 2; ++k) dst[n][k] = *(const PG8_LAS bf16x8*)(lds + PG8_SB(b, h) + boff + n * 2048 + k * 1024); } while (0)
#define PG8_MMA(ai, bj, At, Bt) do { __builtin_amdgcn_s_setprio(1); _Pragma("unroll") for (int m = 0; m < 4; ++m) _Pragma("unroll") for (int n = 0; n < 2; ++n) _Pragma("unroll") for (int k = 0; k < 2; ++k) \
        acc[ai][bj][m][n] = __builtin_amdgcn_mfma_f32_16x16x32_bf16(Bt[n][k], At[m][k], acc[ai][bj][m][n], 0, 0, 0); __builtin_amdgcn_s_setprio(0); } while (0)
#define PG8_WAIT_V(n) asm volatile("s_waitcnt vmcnt(" #n ")" ::: "memory")
#define PG8_WAIT_L(n) asm volatile("s_waitcnt lgkmcnt(" #n ")" ::: "memory")
#define PG8_BAR __builtin_amdgcn_s_barrier()
#define PG8_SCHED __builtin_amdgcn_sched_barrier(0)
    Unit cur, nxt; int ui = 0;
    if (!S.next(0, cur)) return;
    f32x4 acc[2][2][4][2];
#pragma unroll
    for (int a = 0; a < 2; ++a)
#pragma unroll
        for (int b = 0; b < 2; ++b)
#pragma unroll
            for (int m = 0; m < 4; ++m)
#pragma unroll
                for (int n = 0; n < 2; ++n) acc[a][b][m][n] = (f32x4){0.f, 0.f, 0.f, 0.f};
    bf16x8 At[4][2], B0[2][2], B1[2][2];
    unsigned vA[2][2], vN[2][2];
    S.voff(cur, K, sR, sC, vA);
    const char* cA = cur.a; const char* cB = cur.b;
    PG8_STAGEB(PG8_SB(0, 0), cB); PG8_STAGEB(PG8_SB(0, 1), cB + hstep); PG8_STAGE(PG8_SA(0, 0), cA, vA[0][0], vA[0][1]); PG8_STAGE(PG8_SA(0, 1), cA, vA[1][0], vA[1][1]);
    if (wr == 1) PG8_BAR;
    PG8_WAIT_V(2); PG8_BAR;
    PG8_STAGEB(PG8_SB(1, 0), cB + kstep); PG8_STAGE(PG8_SA(1, 0), cA + kstep, vA[0][0], vA[0][1]); PG8_STAGEB(PG8_SB(1, 1), cB + hstep + kstep);
    PG8_WAIT_V(6); PG8_BAR;
    for (;;) {
        const bool has_next = S.next(ui + 1, nxt);
        const char* nA = cA; const char* nB = cB;
#pragma unroll
        for (int h = 0; h < 2; ++h) { vN[h][0] = vA[h][0]; vN[h][1] = vA[h][1]; }
        if (has_next) { nA = nxt.a; nB = nxt.b; S.voff(nxt, K, sR, sC, vN); }
        for (int t = 0; t < nt; t += 2) {
            const bool last = (t == nt - 2);
            const char* a1 = cA + (size_t)(t + 1) * kstep;
            const char* a2 = last ? nA : cA + (size_t)(t + 2) * kstep; const char* b2 = last ? nB : cB + (size_t)(t + 2) * kstep;
            const char* a3 = a2 + kstep; const char* b3 = b2 + kstep;
            const unsigned w00 = last ? vN[0][0] : vA[0][0], w01 = last ? vN[0][1] : vA[0][1], w10 = last ? vN[1][0] : vA[1][0], w11 = last ? vN[1][1] : vA[1][1];
            PG8_LDB(B0, 0, 0); PG8_LDB(B1, 0, 1); PG8_SCHED; PG8_LDA(At, 0, 0); PG8_STAGE(PG8_SA(1, 1), a1, vA[1][0], vA[1][1]);
            PG8_WAIT_V(8); PG8_WAIT_L(0); PG8_BAR; PG8_MMA(0, 0, At, B0); PG8_MMA(0, 1, At, B1); PG8_BAR; PG8_SCHED;
            PG8_LDA(At, 0, 1); PG8_STAGEB(PG8_SB(0, 0), b2); PG8_STAGEB(PG8_SB(0, 1), b2 + hstep); PG8_STAGE(PG8_SA(0, 0), a2, w00, w01);
            PG8_WAIT_V(8); PG8_WAIT_L(0); PG8_BAR; PG8_MMA(1, 0, At, B0); PG8_MMA(1, 1, At, B1); PG8_BAR; PG8_SCHED;
            PG8_LDB(B0, 1, 0); PG8_LDB(B1, 1, 1); PG8_SCHED; PG8_LDA(At, 1, 0); PG8_STAGE(PG8_SA(0, 1), a2, w10, w11);
            PG8_WAIT_V(8); PG8_WAIT_L(0); PG8_BAR; PG8_MMA(0, 0, At, B0); PG8_MMA(0, 1, At, B1); PG8_BAR; PG8_SCHED;
            PG8_LDA(At, 1, 1); PG8_STAGEB(PG8_SB(1, 0), b3); PG8_STAGEB(PG8_SB(1, 1), b3 + hstep); PG8_STAGE(PG8_SA(1, 0), a3, w00, w01);
            PG8_WAIT_V(8); PG8_WAIT_L(0); PG8_BAR; PG8_MMA(1, 0, At, B0); PG8_MMA(1, 1, At, B1); PG8_BAR; PG8_SCHED;
        }
        if constexpr (ALIGN_EPI) { if (wr == 0) PG8_BAR; }
        E(acc, cur, wr, wc, fr, fq);
        if (!has_next) break;
#pragma unroll
        for (int a = 0; a < 2; ++a)
#pragma unroll
            for (int b = 0; b < 2; ++b)
#pragma unroll
                for (int m = 0; m < 4; ++m)
#pragma unroll
                    for (int n = 0; n < 2; ++n) acc[a][b][m][n] = (f32x4){0.f, 0.f, 0.f, 0.f};
        cur = nxt; cA = nA; cB = nB; ++ui;
#pragma unroll
        for (int h = 0; h < 2; ++h) { vA[h][0] = vN[h][0]; vA[h][1] = vN[h][1]; }
        if constexpr (ALIGN_EPI) { if (wr == 1) PG8_BAR; }
    }
    PG8_WAIT_V(0);
    if constexpr (!ALIGN_EPI) { if (wr == 0) PG8_BAR; }
    PG8_BAR;
#undef PG8_SA
#undef PG8_SB
#undef PG8_STAGE
#undef PG8_STAGEB
#undef PG8_LDA
#undef PG8_LDB
#undef PG8_MMA
#undef PG8_WAIT_V
#undef PG8_WAIT_L
#undef PG8_BAR
#undef PG8_SCHED
}
}
namespace pg8 {
__device__ __forceinline__ void st8(bf16_t* p, const f32x4 v0, const f32x4 v1) { u32x4 w; w.x = cvt_pk_bf16(v0[0], v0[1]); w.y = cvt_pk_bf16(v0[2], v0[3]); w.z = cvt_pk_bf16(v1[0], v1[1]); w.w = cvt_pk_bf16(v1[2], v1[3]); *(u32x4*)p = w; }
__device__ __forceinline__ f32x4 sig4(const f32x4 v) { return (f32x4){sigmoidf_fast(v[0]), sigmoidf_fast(v[1]), sigmoidf_fast(v[2]), sigmoidf_fast(v[3])}; }
struct EpiG1 {
    bf16_t* act; size_t astride; const float __attribute__((address_space(1)))* qg; float c2;
    long kgoff;
    __device__ __forceinline__ void operator()(const f32x4 (&acc)[2][2][4][2], const Unit& u, int wr, int wc, int fr, int fq) const {
        const int row0 = u.pm * BM + wr * 64 + fr, pn = u.pn;
        if (pn < 8) {
            bf16_t* base = act + astride + pn * 128 + wc * 32 + 8 * fq;
#pragma unroll
            for (int ai = 0; ai < 2; ++ai)
#pragma unroll
                for (int m = 0; m < 4; ++m) st8(base + (size_t)(row0 + ai * HALF + m * 16) * 1024, acc[ai][0][m][0] * acc[ai][1][m][0], acc[ai][0][m][1] * acc[ai][1][m][1]);
        } else if (pn >= 12 && pn < 20) {
            const bool isq = pn < 16; const float __attribute__((address_space(1)))* g = qg + (isq ? 0 : kgoff); bf16_t* base = act + (isq ? 3 : 4) * astride + (4 * (pn & 3) + wc) * 64 + 8 * fq;
            f32x4 gv[2][2];
#pragma unroll
            for (int bj = 0; bj < 2; ++bj)
#pragma unroll
                for (int n = 0; n < 2; ++n) gv[bj][n] = *(const f32x4 __attribute__((address_space(1)))*)(g + 32 * bj + 8 * fq + 4 * n);
            const float sc = isq ? c2 : 1.0f;
#pragma unroll
            for (int ai = 0; ai < 2; ++ai)
#pragma unroll
                for (int m = 0; m < 4; ++m) {
                    float ss = 0.f;
#pragma unroll
                    for (int bj = 0; bj < 2; ++bj)
#pragma unroll
                        for (int n = 0; n < 2; ++n) { const f32x4 x = acc[ai][bj][m][n]; ss += (x[0] * x[0] + x[1] * x[1]) + (x[2] * x[2] + x[3] * x[3]); }
                    { const int ln = fq * 16 + fr; ss += shx(ss, 16, ln); ss += shx(ss, 32, ln); }
                    const float rs = __builtin_amdgcn_rsqf(ss * (1.0f / 64.0f) + 1e-6f) * sc;
                    bf16_t* rowp = base + (size_t)(row0 + ai * HALF + m * 16) * 1024;
#pragma unroll
                    for (int bj = 0; bj < 2; ++bj) st8(rowp + 32 * bj, acc[ai][bj][m][0] * gv[bj][0] * rs, acc[ai][bj][m][1] * gv[bj][1] * rs);
                }
        } else {
            const bool gate = pn >= 24;
            const int bi = pn < 12 ? 2 : pn < 24 ? 5 : pn < 28 ? 6 : 7;
            bf16_t* base = act + bi * astride + (pn & 3) * 256 + wc * 32 + 8 * fq;
#pragma unroll
            for (int ai = 0; ai < 2; ++ai)
#pragma unroll
                for (int m = 0; m < 4; ++m) { bf16_t* rowp = base + (size_t)(row0 + ai * HALF + m * 16) * 1024;
#pragma unroll
                    for (int bj = 0; bj < 2; ++bj) { f32x4 v0 = acc[ai][bj][m][0], v1 = acc[ai][bj][m][1]; if (gate) { v0 = sig4(v0); v1 = sig4(v1); } st8(rowp + bj * HALF, v0, v1); } }
        }
    }
};
struct EpiG2 {
    bf16_t* MG; const bf16_t* SGA; size_t gstride;
    __device__ __forceinline__ void operator()(const f32x4 (&acc)[2][2][4][2], const Unit& u, int wr, int wc, int fr, int fq) const {
        const int row0 = u.pm * BM + wr * 64 + fr, col0 = u.pn * BM + wc * 32 + 8 * fq; const bf16_t* G = SGA + (u.kind ? gstride : 0);
#pragma unroll
        for (int ai = 0; ai < 2; ++ai)
#pragma unroll
            for (int m = 0; m < 4; ++m) { const size_t off = (size_t)(row0 + ai * HALF + m * 16) * 1024 + col0;
#pragma unroll
                for (int bj = 0; bj < 2; ++bj) { const u32x4 g = *(const u32x4*)(G + off + bj * HALF);
                    f32x4 v0 = acc[ai][bj][m][0] * (f32x4){bf_lo(g.x), bf_hi(g.x), bf_lo(g.y), bf_hi(g.y)}, v1 = acc[ai][bj][m][1] * (f32x4){bf_lo(g.z), bf_hi(g.z), bf_lo(g.w), bf_hi(g.w)};
                    if (u.kind) { const u32x4 t = *(const u32x4*)(MG + off + bj * HALF); v0 += (f32x4){bf_lo(t.x), bf_hi(t.x), bf_lo(t.y), bf_hi(t.y)}; v1 += (f32x4){bf_lo(t.z), bf_hi(t.z), bf_lo(t.w), bf_hi(t.w)}; }
                    st8(MG + off + bj * HALF, v0, v1); }
                asm volatile("" ::: "memory"); }
    }
};
struct EpiG3 {
    float* H;
    __device__ __forceinline__ void operator()(const f32x4 (&acc)[2][2][4][2], const Unit& u, int wr, int wc, int fr, int fq) const {
        const int row0 = u.pm * BM + wr * 64 + fr, col0 = u.pn * BM + wc * 32 + 8 * fq;
#pragma unroll
        for (int ai = 0; ai < 2; ++ai)
#pragma unroll
            for (int m = 0; m < 4; ++m) { float* rowp = H + (size_t)(row0 + ai * HALF + m * 16) * 1024 + col0;
#pragma unroll
                for (int bj = 0; bj < 2; ++bj)
#pragma unroll
                    for (int n = 0; n < 2; ++n) { f32x4* p = (f32x4*)(rowp + bj * HALF + 4 * n); *p = *p + acc[ai][bj][m][n]; }
                asm volatile("" ::: "memory"); }
    }
};
struct EpiM1 {
    bf16_t* HACT;
    __device__ __forceinline__ void operator()(const f32x4 (&acc)[2][2][4][2], const Unit& u, int wr, int wc, int fr, int fq) const {
        bf16_t* base = HACT + (size_t)(u.pm * BM + wr * 64 + fr) * 512 + u.pn * 128 + wc * 32 + 8 * fq;
#pragma unroll
        for (int ai = 0; ai < 2; ++ai)
#pragma unroll
            for (int m = 0; m < 4; ++m) { const f32x4 g0 = acc[ai][0][m][0], g1 = acc[ai][0][m][1];
                st8(base + (size_t)(ai * HALF + m * 16) * 512, g0 * sig4(g0) * acc[ai][1][m][0], g1 * sig4(g1) * acc[ai][1][m][1]); }
    }
};
struct EpiM2 {
    bf16_t* Y;
    __device__ __forceinline__ void operator()(const f32x4 (&acc)[2][2][4][2], const Unit& u, int wr, int wc, int fr, int fq) const {
        bf16_t* base = Y + (size_t)(u.pm * BM + wr * 64 + fr) * 1024 + u.pn * BM + wc * 32 + 8 * fq;
#pragma unroll
        for (int ai = 0; ai < 2; ++ai)
#pragma unroll
            for (int m = 0; m < 4; ++m)
#pragma unroll
                for (int bj = 0; bj < 2; ++bj) st8(base + (size_t)(ai * HALF + m * 16) * 1024 + bj * HALF, acc[ai][bj][m][0], acc[ai][bj][m][1]);
    }
};

}
#include <hip/hip_bf16.h>
namespace attn_body {
using bf16=__hip_bfloat16;
using bf16x8=__attribute__((ext_vector_type(8)))short;
using s16x4=__attribute__((ext_vector_type(4)))short;
using f32x16=__attribute__((ext_vector_type(16)))float;
using f32x4=__attribute__((ext_vector_type(4)))float;
using u32x4=__attribute__((ext_vector_type(4)))unsigned;
constexpr int NHEAD=16,SEQ=8192,D=64,DM=NHEAD*D;
constexpr int NW=8,QBLK=32,QB=QBLK*NW,KVBLK=64,NQB=SEQ/QB;
constexpr int META_ROW=16384;
__device__ __forceinline__ int crow(int r,int hi){return (r&3)+8*(r>>2)+4*hi;}
#define SBAR() __builtin_amdgcn_sched_barrier(0)
__device__ __forceinline__ void cmask(f32x16&p0,f32x16&p1,int jb,int qrel,int hi){
  const float NEG=-INFINITY; int kb=64*jb+4*hi;
  #pragma unroll
  for(int r=0;r<16;++r){int kv=kb+(r&3)+8*(r>>2); if(kv>qrel)p0[r]=NEG; if(kv+32>qrel)p1[r]=NEG;}
}
constexpr int NSLOT=3, SLOTB=8192, MAXT=132;
constexpr int LDS_K=0, LDS_V=NSLOT*SLOTB, LDS_WS=2*NSLOT*SLOTB, LDS_OST=LDS_WS+NW*64*4, LDS_BL=LDS_OST+NW*4096, LDS_BYTES=LDS_BL+MAXT*256;
constexpr float C2=0.125f*1.4426950408889634f;
__device__ __forceinline__ void glds16(const void*gsrc,unsigned lds_dst){unsigned keep;
  asm volatile("s_mov_b32 %0, m0\n\ts_mov_b32 m0, %2\n\ts_nop 0\n\tglobal_load_lds_dwordx4 %1, off\n\ts_mov_b32 m0, %0":"=&s"(keep):"v"(gsrc),"s"(lds_dst):"memory");}
typedef float f32x2_t __attribute__((ext_vector_type(2))); typedef __bf16 bf16x2_t __attribute__((ext_vector_type(2)));
__device__ __forceinline__ unsigned cvtpk_s(float lo,float hi){f32x2_t v={lo,hi};bf16x2_t b=__builtin_convertvector(v,bf16x2_t);return __builtin_bit_cast(unsigned,b);}
#define WAIT_BAR(N) asm volatile("s_waitcnt vmcnt(" #N ") lgkmcnt(0)\n\ts_barrier":::"memory")
typedef __attribute__((address_space(3))) const char* lds_cptr;
typedef short v4i16_t __attribute__((ext_vector_type(4)));
__device__ __forceinline__ void kload8(bf16x8*kf,lds_cptr kp){
  kf[0]=*(const __attribute__((address_space(3))) bf16x8*)(kp);      kf[1]=*(const __attribute__((address_space(3))) bf16x8*)(kp+512);
  kf[2]=*(const __attribute__((address_space(3))) bf16x8*)(kp+2048); kf[3]=*(const __attribute__((address_space(3))) bf16x8*)(kp+2560);
  kf[4]=*(const __attribute__((address_space(3))) bf16x8*)(kp+4096); kf[5]=*(const __attribute__((address_space(3))) bf16x8*)(kp+4608);
  kf[6]=*(const __attribute__((address_space(3))) bf16x8*)(kp+6144); kf[7]=*(const __attribute__((address_space(3))) bf16x8*)(kp+6656);
}
__device__ __forceinline__ void kload2(bf16x8*kf,lds_cptr kp,int j){ kf[2*j]=*(const __attribute__((address_space(3))) bf16x8*)(kp+j*2048); kf[2*j+1]=*(const __attribute__((address_space(3))) bf16x8*)(kp+j*2048+512); }
__device__ __forceinline__ s16x4 vtr(lds_cptr p){ return __builtin_bit_cast(s16x4,__builtin_amdgcn_ds_read_tr16_b64_v4i16((__attribute__((address_space(3))) v4i16_t*)p)); }
__device__ __forceinline__ void binit(f32x16&p0,f32x16&p1,lds_cptr bl,float at){
  #pragma unroll
  for(int g=0;g<4;++g){ const f32x4 a=*(const __attribute__((address_space(3))) f32x4*)(bl+32*g), b=*(const __attribute__((address_space(3))) f32x4*)(bl+128+32*g);
    #pragma unroll
    for(int i=0;i<4;++i){p0[4*g+i]=a[i]+at;p1[4*g+i]=b[i]+at;} }
}
__device__ __forceinline__ void pv(f32x16*o,int vb,bf16x8 pa0,bf16x8 pa1,bf16x8 pa2,bf16x8 pa3){
  #pragma unroll
  for(int d0=0;d0<2;++d0){s16x4 lo[4],hi[4];
    #pragma unroll
    for(int ks=0;ks<4;++ks){
      asm volatile("ds_read_b64_tr_b16 %0,%1 offset:%c2":"=&v"(lo[ks]):"v"(vb),"i"(d0*4096+ks*1024):"memory");
      asm volatile("ds_read_b64_tr_b16 %0,%1 offset:%c2":"=&v"(hi[ks]):"v"(vb),"i"(d0*4096+ks*1024+512):"memory");}
    asm volatile("s_waitcnt lgkmcnt(0)":::"memory");SBAR();
    #define PK(k) (bf16x8){lo[k][0],lo[k][1],lo[k][2],lo[k][3],hi[k][0],hi[k][1],hi[k][2],hi[k][3]}
    o[d0]=__builtin_amdgcn_mfma_f32_32x32x16_bf16(pa0,PK(0),o[d0],0,0,0);
    o[d0]=__builtin_amdgcn_mfma_f32_32x32x16_bf16(pa1,PK(1),o[d0],0,0,0);
    o[d0]=__builtin_amdgcn_mfma_f32_32x32x16_bf16(pa2,PK(2),o[d0],0,0,0);
    o[d0]=__builtin_amdgcn_mfma_f32_32x32x16_bf16(pa3,PK(3),o[d0],0,0,0);
    #undef PK
  }
}
#ifndef ATTN_STORE16
#define ATTN_STORE16(p,v) (*(u32x4*)(p)=(v))
#endif
__device__ __forceinline__ void attn_unit(const int tid,int b,int h,int qb,int ts,int PRE,const bf16*Q,const bf16*__restrict__ K,const bf16*__restrict__ V,bf16*O,const float*__restrict__ cb,const float*__restrict__ cbm,float m0,char*shm){
  const int lane=tid&63,r32=lane&31,hi=lane>>5; const int wid=__builtin_amdgcn_readfirstlane(tid>>6);
  const long rowbase=(long)b*SEQ; const int q0=qb*QB;
  const bf16*Qw=Q+(rowbase+q0+wid*QBLK)*DM+h*D;
  const bf16*Kh=K+rowbase*DM+h*D,*Vh=V+rowbase*DM+h*D;
  const unsigned lds0=(unsigned)(uintptr_t)shm;
  float*wsf=(float*)(shm+LDS_WS)+wid*64;
  const int NT=(q0+QB)/KVBLK-ts+PRE;
  { float*BLf=(float*)(shm+LDS_BL);
    for(int i=tid;i<NT*64;i+=NW*64){ const int ti=i>>6,j=i&63; float v;
      if(ti<PRE-1)v=-INFINITY; else if(ti==PRE-1)v=(j<16)?-cbm[j]:-INFINITY; else v=-cb[(ti-PRE+ts)*64+j];
      BLf[i]=v; } }
  const float at=cb[q0+wid*QBLK+r32]-m0;
  const long koff=(long)lane*DM+wid*8, voff=(long)(16*(wid&3)+(lane>>2))*DM+(wid>>2)*32+(lane&3)*8;
  const bf16*ksrc=Kh+koff+(long)(ts-PRE)*KVBLK*DM;
  const bf16*vsrc=Vh+voff+(long)(ts-PRE)*KVBLK*DM;
  const long dmeta=((long)META_ROW-rowbase)*DM-(long)(ts-PRE)*KVBLK*DM;
  const unsigned kdst=lds0+LDS_K+wid*1024, vdst=lds0+LDS_V+wid*1024;
  #define DMA_K(t,slot) glds16(ksrc+(((t)<PRE)?dmeta:(long)(t)*KVBLK*DM),(unsigned)__builtin_amdgcn_readfirstlane(kdst+(slot)))
  #define DMA_V(t,slot) glds16(vsrc+(((t)<PRE)?dmeta:(long)(t)*KVBLK*DM),(unsigned)__builtin_amdgcn_readfirstlane(vdst+(slot)))
  const int vb0=(int)(lds0+LDS_V)+((lane>>4)&1)*32+(lane&3)*8+(4*hi+((lane&15)>>2))*64;
  bf16x8 kf[8];
  const lds_cptr shm3=(lds_cptr)shm; const lds_cptr kp0=shm3+LDS_K+hi*1024+r32*16; const lds_cptr vp0=shm3+LDS_V+((lane>>4)&1)*32+(lane&3)*8+(4*hi+((lane&15)>>2))*64;
  lds_cptr blp=shm3+LDS_BL+16*hi;
  DMA_K(0,0);DMA_V(0,0);DMA_K(1,SLOTB);
  bf16x8 qr[4];
  #pragma unroll
  for(int d0=0;d0<4;++d0)qr[d0]=*reinterpret_cast<const bf16x8*>(&Qw[(long)r32*DM+d0*16+hi*8]);
  float l_reg=0.f;f32x16 o[2];o[0]=f32x16{};o[1]=f32x16{};
  const int qrel=wid*QBLK+r32;
  #define CMASK(P0,P1,t) do{int jb_=(t)-(NT-4); if(jb_>=0)cmask(P0,P1,jb_,qrel,hi);}while(0)
  f32x16 pA0,pA1,pB0,pB1;
  int sl_prev=0,sl_cur=0,sl_next=SLOTB;
  #define ROT() do{sl_prev=sl_cur;sl_cur=sl_next;sl_next=(sl_next==(NSLOT-1)*SLOTB)?0:sl_next+SLOTB;}while(0)
  DMA_K(2,2*SLOTB);
  WAIT_BAR(3);
  binit(pA0,pA1,blp,at); blp+=256;
  { const lds_cptr kb=kp0;
    #pragma unroll
    for(int d0=0;d0<4;++d0){
      const bf16x8 b0=*(const __attribute__((address_space(3))) bf16x8*)(kb+d0*2048);
      const bf16x8 b1=*(const __attribute__((address_space(3))) bf16x8*)(kb+d0*2048+512);
      pA0=__builtin_amdgcn_mfma_f32_32x32x16_bf16(b0,qr[d0],pA0,0,0,0);pA1=__builtin_amdgcn_mfma_f32_32x32x16_bf16(b1,qr[d0],pA1,0,0,0);} }
  CMASK(pA0,pA1,0);
  _Pragma("unroll") for(int r=0;r<16;++r){pA0[r]=__builtin_amdgcn_exp2f(pA0[r]);pA1[r]=__builtin_amdgcn_exp2f(pA1[r]);}
  binit(pB0,pB1,blp,at); blp+=256;
  WAIT_BAR(0);
  DMA_K(3,0);DMA_V(1,SLOTB);
  ROT();
  kload8(kf,kp0+sl_cur);
  WAIT_BAR(2);
  s16x4 vlo[8],vhi[8]; u32x4 pw0,pw1,pw2,pw3;
  #define PKW(P,B) cvtpk_s(P[B],P[B+1])
  #define PAF(k) __builtin_bit_cast(bf16x8,pw##k)
  #define VFR(i) (bf16x8){vlo[i][0],vlo[i][1],vlo[i][2],vlo[i][3],vhi[i][0],vhi[i][1],vhi[i][2],vhi[i][3]}
  #define PIN(x) asm volatile("":"+v"(x))
  #define GAPA(MF,A0,A1,A2,A3,W0,W1,PW) do{ MF; sacc+=A0; sacc+=A1; sacc+=A2; sacc+=A3; PIN(sacc); W0; W1; PIN(PW); SBAR(); }while(0)
  #define EX(v) __builtin_amdgcn_exp2f(v)
  #define GAPB(MF,X,B) do{ MF; X[B]=EX(X[B]); X[B+1]=EX(X[B+1]); X[B+2]=EX(X[B+2]); X[B+3]=EX(X[B+3]); PIN(X); SBAR(); }while(0)
  #define VRD(i) do{ vlo[i]=vtr(vp_+(((i)>>2)*4096+((i)&3)*1024)); vhi[i]=vtr(vp_+(((i)>>2)*4096+((i)&3)*1024+512)); }while(0)
  #define KRD(G,j) do{ if(G){ kload2(kf,kp0+sl_next,j); SBAR(); } }while(0)
  #define BRD(G,P,g) do{ if(G){ const f32x4 t_=*(const __attribute__((address_space(3))) f32x4*)(blp+(((g)>>2)*128+((g)&3)*32)); P[4*((g)&3)]=t_[0];P[4*((g)&3)+1]=t_[1];P[4*((g)&3)+2]=t_[2];P[4*((g)&3)+3]=t_[3]; } }while(0)
  #define BAD(G,P,g) do{ if(G){ P[4*((g)&3)]+=at;P[4*((g)&3)+1]+=at;P[4*((g)&3)+2]+=at;P[4*((g)&3)+3]+=at; PIN(P); } }while(0)
  #define STEP(C0,C1,P0,P1,t,GK,GV,GL,GB) do{ SBAR(); \
    const lds_cptr vp_=vp0+sl_prev; \
    VRD(0); SBAR(); float sacc=(P0[0]+P0[1]); \
    GAPA(C0=__builtin_amdgcn_mfma_f32_32x32x16_bf16(kf[0],qr[0],C0,0,0,0), P0[2],P0[3],P0[4],P0[5],     pw0[0]=PKW(P0,0), pw0[1]=PKW(P0,2), pw0); \
    VRD(4); SBAR(); GAPA(C1=__builtin_amdgcn_mfma_f32_32x32x16_bf16(kf[1],qr[0],C1,0,0,0), P0[6],P0[7],P0[8],P0[9],     pw0[2]=PKW(P0,4), pw0[3]=PKW(P0,6), pw0); \
    VRD(1); SBAR(); GAPA(C0=__builtin_amdgcn_mfma_f32_32x32x16_bf16(kf[2],qr[1],C0,0,0,0),   P0[10],P0[11],P0[12],P0[13], pw1[0]=PKW(P0,8), pw1[1]=PKW(P0,10), pw1); \
    VRD(5); SBAR(); GAPA(C1=__builtin_amdgcn_mfma_f32_32x32x16_bf16(kf[3],qr[1],C1,0,0,0),   P0[14],P0[15],P1[0],P1[1],   pw1[2]=PKW(P0,12),pw1[3]=PKW(P0,14), pw1); \
    VRD(2); SBAR(); GAPA(C0=__builtin_amdgcn_mfma_f32_32x32x16_bf16(kf[4],qr[2],C0,0,0,0),   P1[2],P1[3],P1[4],P1[5],     pw2[0]=PKW(P1,0), pw2[1]=PKW(P1,2), pw2); \
    VRD(6); SBAR(); GAPA(C1=__builtin_amdgcn_mfma_f32_32x32x16_bf16(kf[5],qr[2],C1,0,0,0),   P1[6],P1[7],P1[8],P1[9],     pw2[2]=PKW(P1,4), pw2[3]=PKW(P1,6), pw2); \
    VRD(3); SBAR(); GAPA(C0=__builtin_amdgcn_mfma_f32_32x32x16_bf16(kf[6],qr[3],C0,0,0,0),   P1[10],P1[11],P1[12],P1[13], pw3[0]=PKW(P1,8), pw3[1]=PKW(P1,10), pw3); \
    VRD(7); SBAR(); GAPA(C1=__builtin_amdgcn_mfma_f32_32x32x16_bf16(kf[7],qr[3],C1,0,0,0),   P1[14],P1[15],0.f,0.f,       pw3[2]=PKW(P1,12),pw3[3]=PKW(P1,14), pw3); \
    l_reg+=sacc; \
    if(GK){DMA_K((t)+3,sl_cur);} if(GV){DMA_V((t)+1,sl_next);} \
    CMASK(C0,C1,t); \
    SBAR(); \
    BRD(GB,P0,0); GAPB(o[0]=__builtin_amdgcn_mfma_f32_32x32x16_bf16(PAF(0),VFR(0),o[0],0,0,0), C0,0); \
    BRD(GB,P0,1); BAD(GB,P0,0); GAPB(o[1]=__builtin_amdgcn_mfma_f32_32x32x16_bf16(PAF(0),VFR(4),o[1],0,0,0), C0,4); \
    BRD(GB,P0,2); BAD(GB,P0,1); KRD(GL,0); GAPB(o[0]=__builtin_amdgcn_mfma_f32_32x32x16_bf16(PAF(1),VFR(1),o[0],0,0,0), C0,8); \
    BRD(GB,P0,3); BAD(GB,P0,2); KRD(GL,1); GAPB(o[1]=__builtin_amdgcn_mfma_f32_32x32x16_bf16(PAF(1),VFR(5),o[1],0,0,0), C0,12); \
    BRD(GB,P1,4); BAD(GB,P0,3); KRD(GL,2); GAPB(o[0]=__builtin_amdgcn_mfma_f32_32x32x16_bf16(PAF(2),VFR(2),o[0],0,0,0), C1,0); \
    BRD(GB,P1,5); BAD(GB,P1,4); KRD(GL,3); GAPB(o[1]=__builtin_amdgcn_mfma_f32_32x32x16_bf16(PAF(2),VFR(6),o[1],0,0,0), C1,4); \
    BRD(GB,P1,6); BAD(GB,P1,5); GAPB(o[0]=__builtin_amdgcn_mfma_f32_32x32x16_bf16(PAF(3),VFR(3),o[0],0,0,0), C1,8); \
    BRD(GB,P1,7); BAD(GB,P1,6); GAPB(o[1]=__builtin_amdgcn_mfma_f32_32x32x16_bf16(PAF(3),VFR(7),o[1],0,0,0), C1,12); \
    BAD(GB,P1,7); if(GB){blp+=256;} \
    }while(0)
  int t=1;
  #undef CMASK
  #define CMASK(P0,P1,t) do{}while(0)
  for(;t+5<NT;t+=2){
    STEP(pB0,pB1,pA0,pA1,t,true,true,true,true);     WAIT_BAR(2); ROT();
    STEP(pA0,pA1,pB0,pB1,t+1,true,true,true,true);   WAIT_BAR(2); ROT();
  }
  #undef CMASK
  #define CMASK(P0,P1,t) do{int jb_=(t)-(NT-4); if(jb_>=0)cmask(P0,P1,jb_,qrel,hi);}while(0)
  #define ENDW(tt) do{ if((tt)+3<NT){WAIT_BAR(2);} else if((tt)+2<NT){WAIT_BAR(1);} else {WAIT_BAR(0);} }while(0)
  for(;t+1<NT;t+=2){
    STEP(pB0,pB1,pA0,pA1,t,(t+3<NT),(t+1<NT),(t+1<NT),(t+1<NT));       ENDW(t);   ROT();
    STEP(pA0,pA1,pB0,pB1,t+1,(t+4<NT),(t+2<NT),(t+2<NT),(t+2<NT));     ENDW(t+1); ROT();
  }
  STEP(pB0,pB1,pA0,pA1,NT-1,false,false,false,false);
  { float sacc=pB0[0]+pB0[1]; _Pragma("unroll") for(int r=2;r<16;++r)sacc+=pB0[r]; _Pragma("unroll") for(int r=0;r<16;++r)sacc+=pB1[r]; l_reg+=sacc;
    pw0=(u32x4){PKW(pB0,0),PKW(pB0,2),PKW(pB0,4),PKW(pB0,6)};pw1=(u32x4){PKW(pB0,8),PKW(pB0,10),PKW(pB0,12),PKW(pB0,14)};pw2=(u32x4){PKW(pB1,0),PKW(pB1,2),PKW(pB1,4),PKW(pB1,6)};pw3=(u32x4){PKW(pB1,8),PKW(pB1,10),PKW(pB1,12),PKW(pB1,14)};
    SBAR(); pv(o,vb0+sl_cur,PAF(0),PAF(1),PAF(2),PAF(3)); }
  #undef PKW
  #undef PAF
  #undef VFR
  #undef PIN
  #undef GAPA
  #undef GAPB
  #undef EX
  #undef VRD
  #undef KRD
  #undef BRD
  #undef BAD
  #undef STEP
  #undef ENDW
  {auto rr=__builtin_amdgcn_permlane32_swap(__float_as_uint(l_reg),__float_as_uint(l_reg),false,false);l_reg=__uint_as_float(rr[0])+__uint_as_float(rr[1]);}
  if(hi==0)wsf[32+r32]=l_reg;asm volatile("s_waitcnt lgkmcnt(0)":::"memory");
  float rli[16];
  #pragma unroll
  for(int r=0;r<16;++r)rli[r]=__builtin_amdgcn_rcpf(wsf[32+crow(r,hi)]);
  bf16*Ow=O+(rowbase+q0+wid*QBLK)*DM+h*D;
  { bf16*stg=(bf16*)(shm+LDS_OST)+wid*2048;
    #pragma unroll
    for(int r=0;r<16;++r){const int orow=crow(r,hi);
      #pragma unroll
      for(int d0=0;d0<2;++d0)stg[orow*64+d0*32+r32]=__float2bfloat16(o[d0][r]*rli[r]);}
    asm volatile("s_waitcnt lgkmcnt(0)":::"memory");
    #pragma unroll
    for(int i=0;i<4;++i){const int row=i*8+(lane>>3),ch=lane&7; const u32x4 v=*(const u32x4*)(stg+row*64+ch*8); ATTN_STORE16(Ow+(long)row*DM+ch*8,v);} }
  asm volatile("s_waitcnt lgkmcnt(0)\n\ts_barrier":::"memory");
  #undef DMA_K
  #undef DMA_V
  #undef CMASK
  #undef ROT
}
constexpr int ATTN_LDS_BYTES=LDS_BYTES;
#undef SBAR
#undef WAIT_BAR
}
constexpr int NWAVES = 8;
constexpr int BATCH = 2, SEQ = 8192, D = 1024, NH = 16, HD = 64, NMETA = 16, INC = 8208, NE = 32, DE = 512, DEPTH = 2;
constexpr int M = BATCH * SEQ;
constexpr int MROW = M;
constexpr int NTOK = M + NMETA;
constexpr int MP = 16640;
constexpr int SLOTS = 41216;
constexpr float EPS = 1e-6f, LOG2E = 1.4426950408889634f;
constexpr size_t MiB = 1u << 20;
constexpr size_t WS_CTL = 0, CTL_ZERO_BYTES = 1 * MiB;
constexpr size_t WS_FL = 1 * MiB;
constexpr size_t WS_CB = WS_FL + (size_t)MP * 16 * 4;
constexpr size_t WS_CBM = WS_CB + (size_t)32 * SEQ * 4;
constexpr size_t WS_PM = WS_CBM + 1024;
constexpr size_t WS_HNM = WS_PM + (size_t)16 * INC * 4;
constexpr size_t WS_YAINM = WS_HNM + 65536, WS_OM = WS_YAINM + 65536, WS_MGM = WS_OM + 65536;
constexpr size_t WS_RE = WS_MGM + 65536;
constexpr size_t WS_RP = WS_RE + (size_t)MP * 8;
constexpr size_t WS_RW = WS_RP + (size_t)MP * 8;
constexpr size_t WS_LIST = WS_RW + (size_t)MP * 8;
constexpr size_t WS_SMALL_END = WS_LIST + (size_t)NE * MP * 4;
static_assert(WS_SMALL_END <= 16 * MiB, "small buffers");
constexpr size_t WS_WD0 = 16 * MiB, WD_LAYER = 22 * MiB;
constexpr size_t WO_WC = 16 * MiB, WO_WA = 18 * MiB, WO_WM = 20 * MiB;
constexpr size_t WS_WGU = 60 * MiB, WS_WDN = 124 * MiB;
constexpr size_t WS_H = 156 * MiB;
constexpr size_t WS_ACT = 221 * MiB, ACT_STRIDE = (size_t)MP * D * 2;
constexpr size_t WS_XN = WS_ACT, WS_Z = WS_ACT + ACT_STRIDE, WS_BG = WS_ACT + 2 * ACT_STRIDE, WS_Q = WS_ACT + 3 * ACT_STRIDE, WS_K = WS_ACT + 4 * ACT_STRIDE, WS_V = WS_ACT + 5 * ACT_STRIDE,
                 WS_SGA = WS_ACT + 6 * ACT_STRIDE, WS_SGB = WS_ACT + 7 * ACT_STRIDE, WS_YAIN = WS_ACT + 8 * ACT_STRIDE, WS_END = WS_ACT + 9 * ACT_STRIDE;
constexpr size_t WS_MG = WS_Z;
constexpr size_t WS_HACT = WS_BG;
constexpr size_t WS_Y = WS_K;
static_assert(WS_HACT + (size_t)SLOTS * DE * 2 <= WS_K && WS_Y + (size_t)SLOTS * D * 2 <= WS_SGB, "MoE overlays");
constexpr int CW_TMO = 0, CW_CODE = 1, CW_BAR = 4096, CW_CNT = 16384, CW_AQ = 32768;
constexpr int RING_OFF = 0, RING_BYTES = 131072;
constexpr int LDSCTL_OFF = 162816, MISC_OFF = LDSCTL_OFF + 320;
constexpr int LDS_BYTES = 163840;
constexpr int TOFF_OFF = MISC_OFF + 128;
static_assert(TOFF_OFF + 160 <= LDSCTL_OFF + 768 && LDSCTL_OFF + 768 + 19 * 8 <= LDS_BYTES && attn_body::ATTN_LDS_BYTES <= RING_BYTES, "LDS map");

#define GAS __attribute__((address_space(1)))
#define LAS __attribute__((address_space(3)))
typedef unsigned short bf16;
typedef unsigned v4u __attribute__((ext_vector_type(4)));
typedef unsigned v2u __attribute__((ext_vector_type(2)));
typedef float f32x4 __attribute__((ext_vector_type(4)));
typedef GAS unsigned gu32;
#define RLX_AGENT __ATOMIC_RELAXED, __HIP_MEMORY_SCOPE_AGENT
#define LDS_WAIT() asm volatile("s_waitcnt lgkmcnt(0)" ::: "memory")
#define VM_WAIT() asm volatile("s_waitcnt vmcnt(0)" ::: "memory")
__device__ __forceinline__ unsigned f2bf(float f) { unsigned u = __builtin_bit_cast(unsigned, f); return (u + 0x7fffu + ((u >> 16) & 1u)) >> 16; }
__device__ __forceinline__ unsigned pk2(float lo, float hi) { return f2bf(lo) | (f2bf(hi) << 16); }
__device__ __forceinline__ float bflo(unsigned w) { return __uint_as_float(w << 16); }
__device__ __forceinline__ float bfhi(unsigned w) { return __uint_as_float(w & 0xffff0000u); }

#define XB_TMO      128
#define XB_XCNT(j)  (256  + 64 * (j))
#define XB_XSUB(j)  (1280 + 64 * (j))
#define XB_XGEN(j)  (2304 + 64 * (j))
#define XB_TOP      3328
#define XB_TOPGEN   3392
#define XCD_BAR_WORDS 3456
#define XB_SPIN_CAP (1u << 18)
__device__ __forceinline__ unsigned xb_ld(unsigned* p)              { return __hip_atomic_load(p, __ATOMIC_RELAXED, __HIP_MEMORY_SCOPE_AGENT); }
__device__ __forceinline__ unsigned xb_add(unsigned* p, unsigned v) { return __hip_atomic_fetch_add(p, v, __ATOMIC_RELAXED, __HIP_MEMORY_SCOPE_AGENT); }
__device__ __forceinline__ unsigned xb_xcc_id() { return (unsigned)__builtin_amdgcn_s_getreg((3 << 11) | 20) & 0xFu; }
#define XB_SPIN(cond, bar) do { unsigned _sp = 0; while (cond) { __builtin_amdgcn_s_sleep(1); \
    if ((++_sp & 255u) == 0u) { if (xb_ld(&(bar)[XB_TMO])) break; if (_sp > XB_SPIN_CAP) { atomicAdd(&(bar)[XB_TMO], 1u); break; } } } } while (0)
struct XcdBarrier { unsigned* bar; unsigned x; volatile LAS unsigned* st; };
__device__ __forceinline__ XcdBarrier xcd_barrier_post(unsigned* bar, volatile LAS unsigned* st) {
    XcdBarrier b; b.bar = bar; b.x = xb_xcc_id(); b.st = st;
    if (threadIdx.x == 0) (void)xb_add(&bar[XB_XCNT(b.x)], 1u);
    return b;
}
__device__ __forceinline__ void xcd_barrier_complete(unsigned* bar, unsigned x, unsigned& nloc, unsigned& nx) {
    const unsigned G = gridDim.x * gridDim.y * gridDim.z;
    unsigned sum, cnt, mine, sp = 0u;
    for (;;) {
        sum = 0u; cnt = 0u; mine = 0u;
#pragma unroll
        for (unsigned j = 0; j < 16; ++j) { const unsigned c = xb_ld(&bar[XB_XCNT(j)]); sum += c; cnt += (c > 0u) ? 1u : 0u; mine = (j == x) ? c : mine; }
        if (sum == G) break;
        __builtin_amdgcn_s_sleep(1);
        if ((++sp & 255u) == 0u) { if (xb_ld(&bar[XB_TMO])) break; if (sp > XB_SPIN_CAP) { atomicAdd(&bar[XB_TMO], 1u); break; } }
    }
    nloc = mine > 0u ? mine : 1u; nx = cnt > 0u ? cnt : 1u;
}
__device__ __forceinline__ void xcd_barrier(const XcdBarrier& b) {
    asm volatile("s_waitcnt vmcnt(0)" ::: "memory");
    __syncthreads();
    if (threadIdx.x == 0) {
        unsigned* bar = b.bar;
        __builtin_amdgcn_s_waitcnt(0);
        unsigned nloc = b.st[0], nx = b.st[1];
        if (nloc == 0u) { xcd_barrier_complete(bar, b.x, nloc, nx); b.st[0] = nloc; b.st[1] = nx; }
        const unsigned old = xb_add(&bar[XB_XSUB(b.x)], 1u);
        const unsigned gen = old / nloc;
        if (old + 1u == (gen + 1u) * nloc) {
            __builtin_amdgcn_fence(__ATOMIC_RELEASE, "agent");
            asm volatile("s_waitcnt vmcnt(0)" ::: "memory");
            const unsigned og = xb_add(&bar[XB_TOP], 1u);
            const unsigned tg = og / nx;
            if (og + 1u == (tg + 1u) * nx) xb_add(&bar[XB_TOPGEN], 1u);
            else XB_SPIN(xb_ld(&bar[XB_TOPGEN]) == tg, bar);
            __builtin_amdgcn_fence(__ATOMIC_ACQUIRE, "agent");
            xb_add(&bar[XB_XGEN(b.x)], 1u);
            asm volatile("s_waitcnt vmcnt(0)" ::: "memory");
        } else {
            XB_SPIN(xb_ld(&bar[XB_XGEN(b.x)]) == gen, bar);
            __builtin_amdgcn_fence(__ATOMIC_ACQUIRE, "agent");
            asm volatile("s_waitcnt vmcnt(0)" ::: "memory");
        }
    }
    __syncthreads();
}

struct Frame {
    LAS unsigned char* lds; volatile LAS unsigned* MISC; gu32* ctl; unsigned char* ws;
    int tid, lane, wave, vcu, G, gw, NGW;
    float* out;
};
constexpr int INP_OFF = LDSCTL_OFF + 768;
typedef const float GAS* gcf;
__device__ __forceinline__ gcf inp_ld(Frame& F, int i) { const unsigned long long p = *(volatile LAS unsigned long long*)(F.lds + INP_OFF + 8 * i);
    const unsigned lo = __builtin_amdgcn_readfirstlane((unsigned)p), hi = __builtin_amdgcn_readfirstlane((unsigned)(p >> 32)); return (gcf)(((unsigned long long)hi << 32) | lo); }
#define INP(i) inp_ld(F, i)
__device__ __forceinline__ float wave_sum_l(float v, int lane) {
    v = pg8::row16_sum(v); v += pg8::shx(v, 16, lane); v += pg8::shx(v, 32, lane);
    return v;
}
__device__ __forceinline__ float wave_max_l(float v, int lane) {
#pragma unroll
    for (int o = 1; o < 64; o <<= 1) v = fmaxf(v, pg8::shx(v, o, lane));
    return v;
}
#define wave_sum(v) wave_sum_l(v, F.lane)
#define wave_max(v) wave_max_l(v, F.lane)
__device__ __forceinline__ void tr_block(gcf src, int ld, bf16* dst, int Kd, LAS float* scr, int lane) {
    float t[32];
    gcf sp = src + (size_t)(lane >> 5) * ld + (lane & 31);
#pragma unroll
    for (int i = 0; i < 32; ++i) t[i] = sp[(size_t)(2 * i) * ld];
#pragma unroll
    for (int i = 0; i < 32; ++i) scr[(2 * i + (lane >> 5)) * 33 + (lane & 31)] = t[i];
    LDS_WAIT(); asm volatile("" ::: "memory");
    const int c = lane & 7;
#pragma unroll
    for (int j = 0; j < 4; ++j) { const int n = (lane >> 3) + 8 * j; const LAS float* s = scr + (8 * c) * 33 + n;
        v4u o; o.x = pk2(s[0 * 33], s[1 * 33]); o.y = pk2(s[2 * 33], s[3 * 33]); o.z = pk2(s[4 * 33], s[5 * 33]); o.w = pk2(s[6 * 33], s[7 * 33]);
        *(GAS v4u*)(dst + (size_t)n * Kd + 8 * c) = o; }
    LDS_WAIT(); asm volatile("" ::: "memory");
}
__device__ __forceinline__ int win_src_col(int n0) {
    const int pn = n0 >> 8, p = n0 & 255;
    if (pn < 8) return ((p >> 7) ? 2048 : 1024) + 128 * pn + (p & 127);
    if (pn < 12) return 256 * (pn - 8) + p;
    if (pn < 20) return (pn < 16 ? 3072 : 4096) + 256 * (pn & 3) + 64 * ((p >> 5) & 3) + 32 * (p >> 7);
    if (pn < 24) return 5120 + 256 * (pn & 3) + p;
    if (pn < 28) return 6160 + 256 * (pn & 3) + p;
    return 7184 + 256 * (pn & 3) + p;
}
constexpr int IT_WIN = 16 * 256, IT_SQ = 16 * 32, IT_DENSE = IT_WIN + 3 * IT_SQ;
constexpr int IT_GU = 16 * 32, IT_DN = 8 * 32, IT_EXP = IT_GU + IT_DN, IT_EXPL = NE * IT_EXP;
__device__ __forceinline__ void conv_dense_item(Frame& F, int l, int it, LAS float* scr) {
    unsigned char* wl = F.ws + WS_WD0 + (size_t)l * WD_LAYER;
    if (it < IT_WIN) { const int kb = it >> 8, nb = it & 255; tr_block(INP(3) + (size_t)l * D * INC + (size_t)(64 * kb) * INC + win_src_col(32 * nb), INC, (bf16*)wl + (size_t)(32 * nb) * D + 64 * kb, D, scr, F.lane); return; }
    it -= IT_WIN; const int w = it / IT_SQ, r = it % IT_SQ, kb = r >> 5, nb = r & 31;
    const size_t so = (size_t)l * D * D + (size_t)(64 * kb) * D + 32 * nb, dof = (size_t)(32 * nb) * D + 64 * kb;
    if (w == 0) tr_block(INP(6) + so, D, (bf16*)(wl + WO_WC) + dof, D, scr, F.lane);
    else if (w == 1) tr_block(INP(9) + so, D, (bf16*)(wl + WO_WA) + dof, D, scr, F.lane);
    else tr_block(INP(10) + so, D, (bf16*)(wl + WO_WM) + dof, D, scr, F.lane);
}
__device__ __forceinline__ void conv_expert_item(Frame& F, int l, int it, LAS float* scr) {
    const int e = it / IT_EXP; int r = it % IT_EXP;
    if (r < IT_GU) { const int kb = r >> 5, nb = r & 31, n0 = 32 * nb, ct = n0 >> 8, p = n0 & 255;
        const size_t so = ((size_t)l * NE + e) * D * DE + (size_t)(64 * kb) * DE + 128 * ct + (p & 127); bf16* dst = (bf16*)(F.ws + WS_WGU) + (size_t)e * D * D + (size_t)n0 * D + 64 * kb;
        if (p >> 7) tr_block(INP(17) + so, DE, dst, D, scr, F.lane); else tr_block(INP(16) + so, DE, dst, D, scr, F.lane);
        return; }
    r -= IT_GU; const int kb = r >> 5, nb = r & 31;
    tr_block(INP(18) + ((size_t)l * NE + e) * DE * D + (size_t)(64 * kb) * D + 32 * nb, D, (bf16*)(F.ws + WS_WDN) + (size_t)e * D * DE + (size_t)(32 * nb) * DE + 64 * kb, DE, scr, F.lane);
}
__device__ __forceinline__ void build_toff(Frame& F, int l) {
    LAS int* toff = (LAS int*)(F.lds + TOFF_OFF);
    if (F.tid < 64) {
        int t = F.lane < NE ? (((int)__hip_atomic_load(F.ctl + CW_CNT + 64 * (32 * l + F.lane), RLX_AGENT) + 255) >> 8) : 0; const int mine = t;
#pragma unroll
        for (int o = 1; o < 32; o <<= 1) { const int u = __builtin_amdgcn_ds_bpermute(((F.lane - o) & 63) << 2, t); if (F.lane >= o) t += u; }
        if (F.lane < NE) toff[F.lane] = t - mine;
        if (F.lane == NE - 1) toff[NE] = t; }
    __syncthreads();
}
namespace pg8 {
struct SchedDense {
    const char* A; const char* B; int nM, nN, G, c, K;
    __device__ __forceinline__ bool next(int i, Unit& u) const { const int L = i * G + c; if (L >= nM * nN) return false; int pm, pn; tile_of(L, nM, nN, pm, pn); u.pm = pm; u.pn = pn; u.kind = 0; u.aux = 0;
        u.a = A + (size_t)pm * BM * K * 2; u.b = B + (size_t)pn * BM * K * 2; return true; }
    __device__ __forceinline__ void voff(const Unit&, int K_, const int (&R)[2], const int (&C)[2], unsigned (&vo)[2][2]) const {
#pragma unroll
        for (int h = 0; h < 2; ++h)
#pragma unroll
            for (int i = 0; i < 2; ++i) vo[h][i] = (unsigned)((R[i] + HALF * h) * K_ + C[i]) * 2u; }
};
struct SchedPair {
    const char *A0, *B0; long dA, dB; int c, lim;
    __device__ __forceinline__ bool next(int i, Unit& u) const { if (i >= lim) return false; int pm, pn; tile_of(c, 64, 4, pm, pn); u.pm = pm; u.pn = pn; u.kind = i; u.aux = 0;
        u.a = A0 + (i ? dA : 0) + (size_t)pm * BM * 1024 * 2; u.b = B0 + (i ? dB : 0) + (size_t)pn * BM * 1024 * 2; return true; }
    __device__ __forceinline__ void voff(const Unit&, int K_, const int (&R)[2], const int (&C)[2], unsigned (&vo)[2][2]) const {
#pragma unroll
        for (int h = 0; h < 2; ++h)
#pragma unroll
            for (int i = 0; i < 2; ++i) vo[h][i] = (unsigned)((R[i] + HALF * h) * K_ + C[i]) * 2u; }
};
struct SchedMoe {
    const char* A; const char* B; const int* list; const unsigned* cnt; const PG8_LAS int* toff; int G, c, K; size_t bstride; bool gather;
    __device__ __forceinline__ bool next(int i, Unit& u) const {
        const int L = i * G + c, total = __builtin_amdgcn_readfirstlane(toff[32]); if (L >= 4 * total) return false;
        const int rt = L >> 2, ct = L & 3; int e = 0; while (__builtin_amdgcn_readfirstlane(toff[e + 1]) <= rt) ++e;
        u.pm = rt; u.pn = ct; u.kind = e; u.aux = rt - __builtin_amdgcn_readfirstlane(toff[e]);
        u.a = gather ? A : A + (size_t)rt * BM * K * 2; u.b = B + (size_t)e * bstride + (size_t)ct * BM * K * 2; return true; }
    __device__ __forceinline__ void voff(const Unit& u, int K_, const int (&R)[2], const int (&C)[2], unsigned (&vo)[2][2]) const {
        const int n = (int)cnt[64 * u.kind];
#pragma unroll
        for (int h = 0; h < 2; ++h)
#pragma unroll
            for (int i = 0; i < 2; ++i) { int row = R[i] + HALF * h;
                if (gather) { const int r = u.aux * BM + row; row = r < n ? (list[(size_t)u.kind * 16640 + r] >> 1) : 0; }
                vo[h][i] = (unsigned)(row * K_ + C[i]) * 2u; } }
};
}

__device__ __forceinline__ int slot_of(Frame& F, int tok, int k) {
    const LAS int* toff = (const LAS int*)(F.lds + TOFF_OFF);
    const int e = ((const int*)(F.ws + WS_RE))[tok * 2 + k], p = ((const int*)(F.ws + WS_RP))[tok * 2 + k];
    return 256 * toff[e] + p;
}
struct RowRaw { f32x4 h[4]; v2u a[4], b[4]; float w0, w1; };
struct RowMeta { int s0, s1; float w0, w1; };
__device__ __forceinline__ RowMeta row_meta(Frame& F, int l, int nrows) {
    RowMeta m; m.s0 = 0; m.s1 = 0; m.w0 = 0.f; m.w1 = 0.f;
    const int r = F.gw + F.lane * F.NGW;
    if (l > 0 && r < nrows) { m.s0 = slot_of(F, r, 0); m.s1 = slot_of(F, r, 1); m.w0 = ((const float*)(F.ws + WS_RW))[r * 2]; m.w1 = ((const float*)(F.ws + WS_RW))[r * 2 + 1]; }
    return m;
}
__device__ __forceinline__ void row_issue(Frame& F, int l, int row, const RowMeta& m, int i, RowRaw& r) {
    if (l == 0) { gcf src = row >= M ? INP(1) + (size_t)(row - M) * D : INP(0) + (size_t)row * D;
#pragma unroll
        for (int j = 0; j < 4; ++j) { r.h[j] = ((const f32x4 GAS*)src)[F.lane + 64 * j]; r.a[j] = (v2u){0u, 0u}; r.b[j] = (v2u){0u, 0u}; }
        r.w0 = 0.f; r.w1 = 0.f; return; }
    const int s0 = __builtin_amdgcn_readlane(m.s0, i), s1 = __builtin_amdgcn_readlane(m.s1, i);
    r.w0 = __int_as_float(__builtin_amdgcn_readlane(__float_as_int(m.w0), i)); r.w1 = __int_as_float(__builtin_amdgcn_readlane(__float_as_int(m.w1), i));
    const float* hr = (const float*)(F.ws + WS_H) + (size_t)row * D;
    const bf16* y0 = (const bf16*)(F.ws + WS_Y) + (size_t)s0 * D; const bf16* y1 = (const bf16*)(F.ws + WS_Y) + (size_t)s1 * D;
#pragma unroll
    for (int j = 0; j < 4; ++j) { r.h[j] = ((const f32x4*)hr)[F.lane + 64 * j]; r.a[j] = ((const v2u*)y0)[F.lane + 64 * j]; r.b[j] = ((const v2u*)y1)[F.lane + 64 * j]; }
}
__device__ __forceinline__ void row_combine(const RowRaw& r, f32x4 (&v)[4]) {
#pragma unroll
    for (int j = 0; j < 4; ++j) v[j] = r.h[j] + r.w0 * (f32x4){bflo(r.a[j].x), bfhi(r.a[j].x), bflo(r.a[j].y), bfhi(r.a[j].y)} + r.w1 * (f32x4){bflo(r.b[j].x), bfhi(r.b[j].x), bflo(r.b[j].y), bfhi(r.b[j].y)};
}
__device__ __forceinline__ void phase_t1(Frame& F, int l) {
    LAS float* wf = (LAS float*)(F.lds);
    { gcf win = INP(3) + (size_t)l * D * INC + 6144;
      float t[32];
#pragma unroll
      for (int u = 0; u < 32; ++u) { const int i = F.tid + u * (NWAVES * 64); t[u] = win[(size_t)(i >> 4) * INC + (i & 15)]; }
#pragma unroll
      for (int u = 0; u < 32; ++u) wf[(F.tid & 15) * D + (F.tid >> 4) + 32 * u] = t[u]; }
    if (l > 0) build_toff(F, l - 1); else __syncthreads();
    gcf g1 = INP(2) + (size_t)l * D; gcf bfg = INP(4) + l * 16;
    float* H = (float*)(F.ws + WS_H); bf16* XN = (bf16*)(F.ws + WS_XN); float* FL = (float*)(F.ws + WS_FL); float* HNM = (float*)(F.ws + WS_HNM);
#ifndef REP_ROWS
#define REP_ROWS 0
#endif
    for (int rr_ = (l == 0 ? REP_ROWS : 0); rr_ >= 0; --rr_)
    { const RowMeta meta = row_meta(F, l, NTOK); const int nr = (NTOK - F.gw + F.NGW - 1) / F.NGW; RowRaw cur; row_issue(F, l, F.gw, meta, 0, cur);
    for (int ri = 0; ri < nr; ++ri) { const int row = F.gw + ri * F.NGW;
        RowRaw nxt = cur; if (ri + 1 < nr) row_issue(F, l, row + F.NGW, meta, ri + 1, nxt);
        f32x4 v[4]; row_combine(cur, v); cur = nxt;
        float ss = 0.f;
#pragma unroll
        for (int j = 0; j < 4; ++j) { ((f32x4*)(H + (size_t)row * D))[F.lane + 64 * j] = v[j]; ss += (v[j].x * v[j].x + v[j].y * v[j].y) + (v[j].z * v[j].z + v[j].w * v[j].w); }
        const float rstd = __builtin_amdgcn_rsqf(wave_sum(ss) * (1.f / D) + EPS);
#pragma unroll
        for (int j = 0; j < 4; ++j) { v[j] = v[j] * rstd * ((const f32x4 GAS*)g1)[F.lane + 64 * j];
            v2u o; o.x = pk2(v[j].x, v[j].y); o.y = pk2(v[j].z, v[j].w); ((v2u*)(XN + (size_t)row * D))[F.lane + 64 * j] = o;
            if (row >= M) ((f32x4*)(HNM + (size_t)(row - M) * D))[F.lane + 64 * j] = v[j]; }
        float mine = 0.f;
#pragma unroll 1
        for (int jg = 0; jg < 16; jg += 4) { float s4[4];
#pragma unroll
            for (int q = 0; q < 4; ++q) { float s = 0.f;
#pragma unroll
                for (int j = 0; j < 4; ++j) { const f32x4 w = *(const LAS f32x4*)(wf + (jg + q) * D + 4 * F.lane + 256 * j); s += (v[j].x * w.x + v[j].y * w.y) + (v[j].z * w.z + v[j].w * w.w); }
                s4[q] = s; }
#pragma unroll
            for (int q = 0; q < 4; ++q) s4[q] = pg8::row16_sum(s4[q]);
#pragma unroll
            for (int o = 16; o < 64; o <<= 1) {
#pragma unroll
                for (int q = 0; q < 4; ++q) s4[q] += pg8::shx(s4[q], o, F.lane); }
#pragma unroll
            for (int q = 0; q < 4; ++q) mine = (F.lane == jg + q) ? s4[q] : mine; }
        if (F.lane < 16) { const float f = mine + bfg[F.lane]; FL[(size_t)row * 16 + F.lane] = fminf(f, 0.f) * LOG2E - __builtin_amdgcn_logf(1.0f + __builtin_amdgcn_exp2f(-fabsf(f) * LOG2E)); }
    } }
    LAS float* scr = (LAS float*)(F.lds + 65536 + F.wave * 8448);
#ifndef REP_CONV
#define REP_CONV 0
#endif
    for (int rc = 0; rc <= REP_CONV; ++rc) {
    if (l == 0) {
        for (int it = F.gw; it < 2 * IT_DENSE; it += F.NGW) conv_dense_item(F, it / IT_DENSE, it % IT_DENSE, scr);
    }
    for (int it = F.gw; it < IT_EXPL; it += F.NGW) conv_expert_item(F, l, it, scr);
    }
}
__device__ __forceinline__ LAS float* meta_slice(Frame& F, const float* A, gcf W, int ld, int col0, int slot) {
    LAS float* Al = (LAS float*)F.lds; LAS float* red = (LAS float*)(F.lds + 65536); LAS float* out = (LAS float*)(F.lds + 98304 + 4096 * slot);
    __syncthreads();
    { float t[32];
#pragma unroll
      for (int u = 0; u < 32; ++u) t[u] = A[F.tid + u * (NWAVES * 64)];
#pragma unroll
      for (int u = 0; u < 32; ++u) Al[(F.tid + 512 * (u & 1)) * 16 + (u >> 1)] = t[u]; }
    __syncthreads();
    float acc[16];
#pragma unroll
    for (int r = 0; r < 16; ++r) acc[r] = 0.f;
    gcf wp = W + col0 + F.lane; const int k0 = F.wave * 128;
#pragma unroll 1
    for (int kb = k0; kb < k0 + 128; kb += 32) { float w[32];
#pragma unroll
        for (int u = 0; u < 32; ++u) w[u] = wp[(size_t)(kb + u) * ld];
#pragma unroll
        for (int u = 0; u < 32; ++u) {
#pragma unroll
            for (int q = 0; q < 4; ++q) { const f32x4 a = *(const LAS f32x4*)(Al + (kb + u) * 16 + 4 * q); acc[4 * q] += a.x * w[u]; acc[4 * q + 1] += a.y * w[u]; acc[4 * q + 2] += a.z * w[u]; acc[4 * q + 3] += a.w * w[u]; } } }
#pragma unroll
    for (int r = 0; r < 16; ++r) red[(F.wave * 16 + r) * 64 + F.lane] = acc[r];
    __syncthreads();
#pragma unroll
    for (int q = 0; q < 2; ++q) { const int o = F.tid * 2 + q; float s = 0.f;
#pragma unroll
        for (int g = 0; g < 8; ++g) s += red[g * 1024 + o];
        out[o] = s; }
    __syncthreads();
    return out;
}
__device__ __forceinline__ void g1_side(Frame& F, int l) {
    const int c = blockIdx.x;
    const float* FL = (const float*)(F.ws + WS_FL);
    if (c < 32) {
        const int b = c >> 4, h = c & 15; LAS float* wsum = (LAS float*)(F.lds);
        float x[16]; float run = 0.f;
#pragma unroll
        for (int i = 0; i < 16; ++i) { run += FL[((size_t)b * SEQ + F.tid * 16 + i) * 16 + h]; x[i] = run; }
        float inc = run;
#pragma unroll
        for (int o = 1; o < 64; o <<= 1) { const float t = __int_as_float(__builtin_amdgcn_ds_bpermute(((F.lane - o) & 63) << 2, __float_as_int(inc))); if (F.lane >= o) inc += t; }
        if (F.lane == 63) wsum[F.wave] = inc;
        __syncthreads();
        float base = inc - run;
        for (int w = 0; w < F.wave; ++w) base += wsum[w];
        float* CB = (float*)(F.ws + WS_CB) + (size_t)c * SEQ + F.tid * 16;
#pragma unroll
        for (int i = 0; i < 16; ++i) CB[i] = base + x[i];
        if (c < 16 && F.tid == 0) { float cm[16]; float r2 = 0.f;
#pragma unroll
            for (int j = 0; j < 16; ++j) { r2 += FL[(size_t)(MROW + j) * 16 + c]; cm[j] = r2; }
#pragma unroll
            for (int j = 0; j < 16; ++j) ((float*)(F.ws + WS_CBM))[c * 16 + j] = cm[j] - r2; }
        __syncthreads();
    }
    if (c < 128) {
        const int col0 = c < 96 ? 64 * c : 6160 + 64 * (c - 96);
        LAS float* out = meta_slice(F, (const float*)(F.ws + WS_HNM), INP(3) + (size_t)l * D * INC, INC, col0, 0);
        float* PM = (float*)(F.ws + WS_PM);
#pragma unroll
        for (int rr = 0; rr < 2; ++rr) { const int r = 2 * F.wave + rr; float v = out[r * 64 + F.lane];
            if (col0 >= 3072 && col0 < 5120) { const float ss = wave_sum(v * v); const float g = (col0 < 4096 ? INP(7) : INP(8))[l * 64 + F.lane]; v = v * __builtin_amdgcn_rsqf(ss * (1.f / 64.f) + EPS) * g; }
            if (col0 >= 6160) v = pg8::sigmoidf_fast(v);
            PM[(size_t)r * INC + col0 + F.lane] = v;
            if (col0 >= 4096 && col0 < 5120) ((bf16*)(F.ws + WS_K))[(size_t)(MROW + r) * D + (col0 - 4096) + F.lane] = (bf16)f2bf(v);
            if (col0 >= 5120 && col0 < 6144) ((bf16*)(F.ws + WS_V))[(size_t)(MROW + r) * D + (col0 - 5120) + F.lane] = (bf16)f2bf(v); }
        __syncthreads();
    }
}
__device__ __forceinline__ void a1_side(Frame& F, int l) {
    gcf cw = INP(5) + (size_t)l * 3 * D; const float* PM = (const float*)(F.ws + WS_PM);
    const bf16* Z = (const bf16*)(F.ws + WS_Z); const bf16* BG = (const bf16*)(F.ws + WS_BG); bf16* YAIN = (bf16*)(F.ws + WS_YAIN);
    for (int ci = F.gw; ci < M / 8; ci += F.NGW) {
        const int m0 = ci * 8, t0 = m0 & (SEQ - 1);
#pragma unroll
        for (int j = 0; j < 2; ++j) { const int d0 = 8 * F.lane + 512 * j;
            float w0[8], w1[8], w2[8], zp2[8], zp1[8];
#pragma unroll
            for (int i = 0; i < 8; ++i) { w0[i] = cw[d0 + i]; w1[i] = cw[D + d0 + i]; w2[i] = cw[2 * D + d0 + i]; }
            if (t0 == 0) {
#pragma unroll
                for (int i = 0; i < 8; ++i) { zp2[i] = PM[(size_t)14 * INC + 1024 + d0 + i] * PM[(size_t)14 * INC + 2048 + d0 + i]; zp1[i] = PM[(size_t)15 * INC + 1024 + d0 + i] * PM[(size_t)15 * INC + 2048 + d0 + i]; }
            } else { const v4u a = *(const v4u*)(Z + (size_t)(m0 - 2) * D + d0), b = *(const v4u*)(Z + (size_t)(m0 - 1) * D + d0);
                zp2[0] = bflo(a.x); zp2[1] = bfhi(a.x); zp2[2] = bflo(a.y); zp2[3] = bfhi(a.y); zp2[4] = bflo(a.z); zp2[5] = bfhi(a.z); zp2[6] = bflo(a.w); zp2[7] = bfhi(a.w);
                zp1[0] = bflo(b.x); zp1[1] = bfhi(b.x); zp1[2] = bflo(b.y); zp1[3] = bfhi(b.y); zp1[4] = bflo(b.z); zp1[5] = bfhi(b.z); zp1[6] = bflo(b.w); zp1[7] = bfhi(b.w); }
            v4u zr[8], gr[8];
#pragma unroll
            for (int r = 0; r < 8; ++r) { zr[r] = *(const v4u*)(Z + (size_t)(m0 + r) * D + d0); gr[r] = *(const v4u*)(BG + (size_t)(m0 + r) * D + d0); }
#pragma unroll
            for (int r = 0; r < 8; ++r) { const v4u zz = zr[r], gg = gr[r];
                float z[8], g[8], y[8];
                z[0] = bflo(zz.x); z[1] = bfhi(zz.x); z[2] = bflo(zz.y); z[3] = bfhi(zz.y); z[4] = bflo(zz.z); z[5] = bfhi(zz.z); z[6] = bflo(zz.w); z[7] = bfhi(zz.w);
                g[0] = bflo(gg.x); g[1] = bfhi(gg.x); g[2] = bflo(gg.y); g[3] = bfhi(gg.y); g[4] = bflo(gg.z); g[5] = bfhi(gg.z); g[6] = bflo(gg.w); g[7] = bfhi(gg.w);
#pragma unroll
                for (int i = 0; i < 8; ++i) { y[i] = g[i] * (w0[i] * zp2[i] + w1[i] * zp1[i] + w2[i] * z[i]); zp2[i] = zp1[i]; zp1[i] = z[i]; }
                v4u o; o.x = pk2(y[0], y[1]); o.y = pk2(y[2], y[3]); o.z = pk2(y[4], y[5]); o.w = pk2(y[6], y[7]);
                *(GAS v4u*)(YAIN + (size_t)(m0 + r) * D + d0) = o; }
        }
    }
}
__device__ __forceinline__ void g2_side(Frame& F, int l) {
    if (blockIdx.x >= 16) return;
    const int col0 = 64 * blockIdx.x; const float* PM = (const float*)(F.ws + WS_PM);
    LAS float* ya = meta_slice(F, (const float*)(F.ws + WS_YAINM), INP(6) + (size_t)l * D * D, D, col0, 0);
    LAS float* yb = meta_slice(F, (const float*)(F.ws + WS_OM), INP(9) + (size_t)l * D * D, D, col0, 1);
#pragma unroll
    for (int q = 0; q < 2; ++q) { const int o = F.tid * 2 + q, r = o >> 6, cc = o & 63;
        ((float*)(F.ws + WS_MGM))[(size_t)r * D + col0 + cc] = PM[(size_t)r * INC + 6160 + col0 + cc] * ya[o] + PM[(size_t)r * INC + 7184 + col0 + cc] * yb[o]; }
    __syncthreads();
}
__device__ __forceinline__ void g3_side(Frame& F, int l) {
    if (blockIdx.x >= 16) return;
    const int col0 = 64 * blockIdx.x;
    LAS float* y = meta_slice(F, (const float*)(F.ws + WS_MGM), INP(10) + (size_t)l * D * D, D, col0, 0);
#pragma unroll
    for (int q = 0; q < 2; ++q) { const int o = F.tid * 2 + q, r = o >> 6, cc = o & 63; ((float*)(F.ws + WS_H))[(size_t)(MROW + r) * D + col0 + cc] += y[o]; }
    __syncthreads();
}
__device__ __forceinline__ void phase_t2(Frame& F, int l, int bank, size_t dump) {
    LAS float* wr = (LAS float*)F.lds;
    { gcf wg = INP(12) + (size_t)l * D * 4; gcf we = INP(14) + (size_t)l * D * NE;
#pragma unroll 1
      for (int b0 = 0; b0 < 64; b0 += 16) { float t[16];
#pragma unroll
          for (int u = 0; u < 16; ++u) t[u] = we[F.tid + (b0 + u) * (NWAVES * 64)];
#pragma unroll
          for (int u = 0; u < 16; ++u) wr[((F.tid >> 5) + 16 * (b0 + u)) * 36 + 4 + (F.tid & 31)] = t[u]; }
      { float t[8];
#pragma unroll
          for (int u = 0; u < 8; ++u) t[u] = wg[F.tid + u * (NWAVES * 64)];
#pragma unroll
          for (int u = 0; u < 8; ++u) wr[((F.tid >> 2) + 128 * u) * 36 + (F.tid & 3)] = t[u]; } }
    LAS int* lcnt = (LAS int*)(F.lds + 147456); LAS int* lbase = lcnt + 32; LAS int* rec = lbase + 32; LAS float* recw = (LAS float*)(rec + 80 * 4);
    if (F.tid < 32) lcnt[F.tid] = 0;
    __syncthreads();
    gcf g2 = INP(11) + (size_t)l * D; gcf bg = INP(13) + l * 4; gcf be = INP(15) + l * NE;
    const float* H = (const float*)(F.ws + WS_H); bf16* XN = (bf16*)(F.ws + WS_XN);
    const int c = blockIdx.x, npair = (c < 16 && F.wave == 0) ? 5 : 4;
    float g2r[16];
#pragma unroll
    for (int jj = 0; jj < 16; ++jj) g2r[jj] = g2[F.lane + 64 * jj];
    for (int it = 0; it < npair; ++it) {
        int sl[2], row[2];
        if (it < 4) { sl[0] = 8 * F.wave + 2 * it; sl[1] = sl[0] + 1; row[0] = 64 * c + sl[0]; row[1] = row[0] + 1; } else { sl[0] = 64; sl[1] = 64; row[0] = MROW + c; row[1] = MROW + c; }
        float hn[2][16], ss[2] = {0.f, 0.f};
#pragma unroll
        for (int r = 0; r < 2; ++r)
#pragma unroll
            for (int jj = 0; jj < 16; ++jj) { hn[r][jj] = H[(size_t)row[r] * D + F.lane + 64 * jj]; ss[r] += hn[r][jj] * hn[r][jj]; }
        ss[0] = pg8::row16_sum(ss[0]); ss[1] = pg8::row16_sum(ss[1]);
#pragma unroll
        for (int o = 16; o < 64; o <<= 1) { const float t0 = pg8::shx(ss[0], o, F.lane), t1 = pg8::shx(ss[1], o, F.lane); ss[0] += t0; ss[1] += t1; }
        float acc[2][36];
#pragma unroll
        for (int r = 0; r < 2; ++r) { const float rstd = __builtin_amdgcn_rsqf(ss[r] * (1.f / D) + EPS);
#pragma unroll
            for (int jj = 0; jj < 16; ++jj) { hn[r][jj] = hn[r][jj] * rstd * g2r[jj]; XN[(size_t)row[r] * D + F.lane + 64 * jj] = (bf16)f2bf(hn[r][jj]); }
#pragma unroll
            for (int q = 0; q < 36; ++q) acc[r][q] = 0.f; }
        { f32x4 wn[9];
#pragma unroll
          for (int q = 0; q < 9; ++q) wn[q] = *(const LAS f32x4*)(wr + F.lane * 36 + 4 * q);
#pragma unroll
          for (int jj = 0; jj < 16; ++jj) { f32x4 w[9];
#pragma unroll
            for (int q = 0; q < 9; ++q) w[q] = wn[q];
            if (jj < 15) {
#pragma unroll
                for (int q = 0; q < 9; ++q) wn[q] = *(const LAS f32x4*)(wr + (F.lane + 64 * (jj + 1)) * 36 + 4 * q); }
#pragma unroll
            for (int r = 0; r < 2; ++r)
#pragma unroll
                for (int q = 0; q < 9; ++q) { acc[r][4 * q] += hn[r][jj] * w[q].x; acc[r][4 * q + 1] += hn[r][jj] * w[q].y; acc[r][4 * q + 2] += hn[r][jj] * w[q].z; acc[r][4 * q + 3] += hn[r][jj] * w[q].w; }
            asm volatile("" ::: "memory"); } }
#pragma unroll
        for (int r = 0; r < 2; ++r)
#pragma unroll
            for (int q = 0; q < 36; ++q) acc[r][q] = pg8::row16_sum(acc[r][q]);
#pragma unroll
        for (int o = 16; o < 64; o <<= 1) {
            float t[2][36];
#pragma unroll
            for (int r = 0; r < 2; ++r)
#pragma unroll
                for (int q = 0; q < 36; ++q) t[r][q] = pg8::shx(acc[r][q], o, F.lane);
#pragma unroll
            for (int r = 0; r < 2; ++r)
#pragma unroll
                for (int q = 0; q < 36; ++q) acc[r][q] += t[r][q]; }
#pragma unroll
        for (int r = 0; r < 2; ++r) {
            if (r == 1 && it == 4) break;
            float gl[4]; int gi = 0;
#pragma unroll
            for (int j = 0; j < 4; ++j) gl[j] = acc[r][j] + bg[j];
            float gb = gl[0];
#pragma unroll
            for (int j = 1; j < 4; ++j) if (gl[j] > gb) { gb = gl[j]; gi = j; }
            float gs = 0.f;
#pragma unroll
            for (int j = 0; j < 4; ++j) gs += __builtin_amdgcn_exp2f((gl[j] - gb) * LOG2E);
            const float gw = 1.f / gs;
            float el[8];
#pragma unroll
            for (int j = 0; j < 8; ++j) el[j] = (gi == 0 ? acc[r][4 + j] : gi == 1 ? acc[r][12 + j] : gi == 2 ? acc[r][20 + j] : acc[r][28 + j]) + be[gi * 8 + j];
            int i1 = 0; float b1 = el[0];
#pragma unroll
            for (int j = 1; j < 8; ++j) if (el[j] > b1) { b1 = el[j]; i1 = j; }
            int i2 = -1; float b2 = -INFINITY;
#pragma unroll
            for (int j = 0; j < 8; ++j) if (j != i1 && (i2 < 0 || el[j] > b2)) { b2 = el[j]; i2 = j; }
            const float p2 = __builtin_amdgcn_exp2f((b2 - b1) * LOG2E), w1 = gw / (1.f + p2), w2 = gw * p2 / (1.f + p2);
            if (F.lane == 0) { const int e1 = gi * 8 + i1, e2 = gi * 8 + i2, s_ = sl[r];
                rec[s_ * 4 + 0] = e1; rec[s_ * 4 + 1] = __hip_atomic_fetch_add(lcnt + e1, 1, __ATOMIC_RELAXED, __HIP_MEMORY_SCOPE_WORKGROUP);
                rec[s_ * 4 + 2] = e2; rec[s_ * 4 + 3] = __hip_atomic_fetch_add(lcnt + e2, 1, __ATOMIC_RELAXED, __HIP_MEMORY_SCOPE_WORKGROUP);
                recw[s_ * 2] = w1; recw[s_ * 2 + 1] = w2; }
        }
    }
    __syncthreads();
    if (F.tid < 32) { const int n = lcnt[F.tid]; lbase[F.tid] = n ? (int)__hip_atomic_fetch_add(F.ctl + CW_CNT + 64 * (32 * bank + F.tid), (unsigned)n, RLX_AGENT) : 0; }
    __syncthreads();
    if (F.tid < 65 && (F.tid < 64 || c < 16)) { const int sl = F.tid, tok = sl < 64 ? 64 * c + sl : MROW + c;
#pragma unroll
        for (int k = 0; k < 2; ++k) { const int e = rec[sl * 4 + 2 * k], pos = lbase[e] + rec[sl * 4 + 2 * k + 1];
            ((int*)(F.ws + dump + WS_LIST))[(size_t)e * MP + pos] = 2 * tok + k; ((int*)(F.ws + dump + WS_RE))[2 * tok + k] = e; ((int*)(F.ws + dump + WS_RP))[2 * tok + k] = pos; ((float*)(F.ws + dump + WS_RW))[2 * tok + k] = recw[sl * 2 + k]; } }
}
__device__ __forceinline__ void a1_meta(Frame& F, int l) {
    if (blockIdx.x >= 16) return;
    const int h = blockIdx.x; gcf cw = INP(5) + (size_t)l * 3 * D; const float* PM = (const float*)(F.ws + WS_PM);
    float* YAINM = (float*)(F.ws + WS_YAINM); float* OM = (float*)(F.ws + WS_OM); const float* CBM = (const float*)(F.ws + WS_CBM);
#pragma unroll
    for (int q2 = 0; q2 < 2; ++q2) { const int o = F.tid * 2 + q2, r = o >> 6, d = 64 * h + (o & 63); float y = 0.f;
#pragma unroll
        for (int q = 0; q < 3; ++q) { const int rr = r - 2 + q; if (rr >= 0) y += PM[(size_t)rr * INC + 1024 + d] * PM[(size_t)rr * INC + 2048 + d] * cw[q * D + d]; }
        YAINM[(size_t)r * D + d] = PM[(size_t)r * INC + d] * y; }
    LAS float* sc = (LAS float*)F.lds;
    __syncthreads();
    if (F.tid < 256) { const int r = F.tid >> 4, s = F.tid & 15; const f32x4* q = (const f32x4*)(PM + (size_t)r * INC + 3072 + 64 * h); const f32x4* k = (const f32x4*)(PM + (size_t)s * INC + 4096 + 64 * h); float dsum = 0.f;
#pragma unroll
        for (int d = 0; d < 16; ++d) { const f32x4 a = q[d], b = k[d]; dsum += (a.x * b.x + a.y * b.y) + (a.z * b.z + a.w * b.w); }
        sc[F.tid] = (s <= r) ? dsum * attn_body::C2 + (CBM[h * 16 + r] - CBM[h * 16 + s]) : -INFINITY; }
    __syncthreads();
    if (F.tid < 16) { float mx = -INFINITY, ls = 0.f;
#pragma unroll
        for (int s = 0; s < 16; ++s) mx = fmaxf(mx, sc[F.tid * 16 + s]);
        float p[16];
#pragma unroll
        for (int s = 0; s < 16; ++s) { p[s] = __builtin_amdgcn_exp2f(sc[F.tid * 16 + s] - mx); ls += p[s]; }
        const float il = 1.f / ls;
#pragma unroll
        for (int s = 0; s < 16; ++s) sc[F.tid * 16 + s] = p[s] * il; }
    __syncthreads();
#pragma unroll
    for (int q2 = 0; q2 < 2; ++q2) { const int o = F.tid * 2 + q2, r = o >> 6, d = o & 63; float acc = 0.f;
#pragma unroll
        for (int s = 0; s < 16; ++s) acc += sc[r * 16 + s] * PM[(size_t)s * INC + 5120 + 64 * h + d];
        OM[(size_t)r * D + 64 * h + d] = acc; }
    __syncthreads();
}
__device__ __forceinline__ void phase_attn(Frame& F, int l, char* lds_generic) {
    const float mq = wave_max(fabsf(INP(7)[l * 64 + F.lane])), mk = wave_max(fabsf(INP(8)[l * 64 + F.lane]));
    const float m0 = 8.f * LOG2E * mq * mk * 1.02f + 0.25f;
    const float TH = 2.f * m0 + 53.f;
    const attn_body::bf16* Q = (const attn_body::bf16*)(F.ws + WS_Q); const attn_body::bf16* K = (const attn_body::bf16*)(F.ws + WS_K); const attn_body::bf16* V = (const attn_body::bf16*)(F.ws + WS_V);
    volatile LAS int* qslot = (volatile LAS int*)(F.lds + LDSCTL_OFF + 640);
    gu32* qhead = F.ctl + CW_AQ + 64 * l;
    if (F.tid == 0) *qslot = (int)__hip_atomic_fetch_add(qhead, 1u, RLX_AGENT);
    __syncthreads();
    int p = __builtin_amdgcn_readfirstlane(*qslot);
    while (p < 1024) {
        int pnext = 0; if (F.tid == 0) pnext = (int)__hip_atomic_fetch_add(qhead, 1u, RLX_AGENT);
        const int qb = 31 - (p >> 5), bh = p & 31; const float* cbh = (const float*)(F.ws + WS_CB) + (size_t)bh * SEQ;
        const float cbq = cbh[256 * qb]; const int nj = 4 * qb;
        const bool f0 = F.lane < nj && (cbq - cbh[64 * F.lane + 63] < -TH), f1 = F.lane + 64 < nj && (cbq - cbh[64 * (F.lane + 64) + 63] < -TH);
        int ts = __builtin_popcountll(__builtin_amdgcn_ballot_w64(f0)) + __builtin_popcountll(__builtin_amdgcn_ballot_w64(f1));
        const int has_meta = (ts == 0) ? 1 : 0; int dummy = 0;
        if ((has_meta + 4 * qb + 4 - ts) & 1) { if (ts > 0) --ts; else dummy = 1; }
        attn_body::attn_unit(F.tid, bh >> 4, bh & 15, qb, ts, has_meta + dummy, Q, K, V, (attn_body::bf16*)(F.ws + WS_XN), cbh, (const float*)(F.ws + WS_CBM) + (bh & 15) * 16, m0, lds_generic);
        if (F.tid == 0) *qslot = pnext;
        asm volatile("s_waitcnt vmcnt(0) lgkmcnt(0)\n\ts_barrier" ::: "memory");
        p = __builtin_amdgcn_readfirstlane(*qslot);
    }
}
__device__ __forceinline__ void phase_out(Frame& F) {
    build_toff(F, 1);
#ifdef PROBE_PH
    const float pscale = 1.0f + 0.1f * rintf((float)(unsigned)(__hip_atomic_load((GAS unsigned long long*)(F.ctl + 32) + (PROBE_PH + 1), RLX_AGENT) - __hip_atomic_load((GAS unsigned long long*)(F.ctl + 32) + PROBE_PH, RLX_AGENT)) * (1.0f / (100.0f * PROBE_DIV)));
#else
    const float pscale = 1.0f;
#endif
    { const RowMeta meta = row_meta(F, 1, M); const int nr = (M - F.gw + F.NGW - 1) / F.NGW; RowRaw cur; row_issue(F, 1, F.gw, meta, 0, cur);
    for (int ri = 0; ri < nr; ++ri) { const int row = F.gw + ri * F.NGW;
        RowRaw nxt = cur; if (ri + 1 < nr) row_issue(F, 1, row + F.NGW, meta, ri + 1, nxt);
        f32x4 v[4]; row_combine(cur, v); cur = nxt;
#pragma unroll
        for (int j = 0; j < 4; ++j) ((f32x4*)(F.out + (size_t)row * D))[F.lane + 64 * j] = v[j] * pscale; } }
}

#ifndef MK_N_LAUNCHES
#define MK_N_LAUNCHES 1
#endif
constexpr int N_PHASES = 17;
struct Args { const float* in[19]; float* out; unsigned char* ws; int ph_lo, ph_hi, li, two; };
__global__ void __launch_bounds__(NWAVES * 64, 2) fwd_kernel(Args args) {
    extern __shared__ __attribute__((aligned(16))) unsigned char lds[];
    Frame F;
    F.lds = (LAS unsigned char*)lds; F.MISC = (volatile LAS unsigned*)(F.lds + MISC_OFF);
    F.tid = threadIdx.x; F.lane = F.tid & 63; F.wave = __builtin_amdgcn_readfirstlane(F.tid >> 6);
    F.G = gridDim.x; { const int bx = blockIdx.x; F.vcu = (F.G % 8 == 0) ? (bx % 8) * (F.G / 8) + bx / 8 : bx; }
    F.gw = F.vcu * NWAVES + F.wave; F.NGW = F.G * NWAVES;
    F.ws = args.ws; F.ctl = (gu32*)(args.ws + WS_CTL); F.out = args.out;
    for (int u = F.tid; u < (LDS_BYTES - LDSCTL_OFF) / 4; u += NWAVES * 64) ((LAS unsigned*)(F.lds + LDSCTL_OFF))[u] = 0u;
    __syncthreads();
    if (F.tid == 0) {
#pragma unroll
        for (int i = 0; i < 19; ++i) *(LAS unsigned long long*)(F.lds + INP_OFF + 8 * i) = (unsigned long long)args.in[i]; }
    __syncthreads();
    XcdBarrier bar = xcd_barrier_post((unsigned*)(F.ctl + CW_BAR) + args.li * XCD_BAR_WORDS, F.MISC + 8);
#ifdef PROBE_PH
    if (blockIdx.x == 0 && F.tid == 0) __hip_atomic_store((GAS unsigned long long*)(F.ctl + 32), __builtin_amdgcn_s_memrealtime(), RLX_AGENT);
#endif
    const int lo = args.ph_lo, hi = args.ph_hi; int ph = 0; const int wave_s = F.wave;
#ifndef REP_PH
#define REP_PH (-1)
#endif
#ifndef REP_N
#define REP_N 0
#endif
#ifndef SUBMASK
#define SUBMASK 7
#endif
#ifndef PHMASK
#define PHMASK 0x1ff
#endif
#define PHB(k) if (((PHMASK >> (k)) & 1) && lo <= ph && ph < hi) { for (int rep_ = (ph == REP_PH ? REP_N : 0); rep_ >= 0; --rep_) { { int ot_; asm volatile("v_mbcnt_lo_u32_b32 %0, -1, 0\n\tv_mbcnt_hi_u32_b32 %0, -1, %0" : "=v"(ot_)); ot_ += wave_s * 64; F.tid = ot_; F.lane = ot_ & 63; F.wave = __builtin_amdgcn_readfirstlane(ot_ >> 6); F.gw = F.vcu * NWAVES + F.wave; size_t z_ = 0; asm volatile("" : "+s"(z_)); F.ws = args.ws + z_; F.ctl = (gu32*)(F.ws + WS_CTL); }
#ifdef PROBE_PH
#define PH_STAMP() do { if (blockIdx.x == 0 && F.tid == 0) __hip_atomic_store((GAS unsigned long long*)(F.ctl + 32) + (ph + 1), __builtin_amdgcn_s_memrealtime(), RLX_AGENT); } while (0)
#else
#define PH_STAMP() do {} while (0)
#endif
#ifndef REP_BAR
#define REP_BAR 0
#endif
#define PH_END   } if (ph + 1 < hi) xcd_barrier(bar); if (REP_BAR > 0 && ph == 3) { for (int rb_ = 0; rb_ < REP_BAR; ++rb_) xcd_barrier(bar); } PH_STAMP(); } ++ph;
    if (lo == 0) {
        for (int i = F.gw * 64 + F.lane; i < 2 * 64 * D / 8; i += F.NGW * 64) { const int wbuf = i / (64 * D / 8), r = i % (64 * D / 8);
            ((GAS v4u*)(F.ws + (wbuf ? WS_V : WS_K) + (size_t)MROW * D * 2))[r] = (v4u){0u, 0u, 0u, 0u}; } }
    for (int l = 0; l < DEPTH; ++l) {
        unsigned char* wl = F.ws + WS_WD0 + (size_t)l * WD_LAYER;
        PHB(0) phase_t1(F, l); PH_END
        PHB(1) if (SUBMASK & 1) g1_side(F, l); if (SUBMASK & 2)
            { pg8::SchedDense S{(const char*)(F.ws + WS_XN), (const char*)wl, 64, 32, F.G, (int)blockIdx.x, D};
              pg8::EpiG1 E{(bf16*)(F.ws + WS_ACT), ACT_STRIDE / 2, INP(7) + l * 64, attn_body::C2, (long)(INP(8) - INP(7))};
              pg8::gemm_phase<pg8::EpiG1, pg8::SchedDense, true>(F.tid, F.lds + RING_OFF, D, S, E); }
        PH_END
        PHB(2) if (SUBMASK & 1) a1_side(F, l); if (SUBMASK & 2) a1_meta(F, l); if (SUBMASK & 4) phase_attn(F, l, (char*)lds + RING_OFF); PH_END
        PHB(3) if (SUBMASK & 1) g2_side(F, l); if (SUBMASK & 2)
            { pg8::SchedPair S{(const char*)(F.ws + WS_YAIN), (const char*)(wl + WO_WC), (long)WS_XN - (long)WS_YAIN, (long)WO_WA - (long)WO_WC, (int)blockIdx.x, args.two};
              pg8::EpiG2 E{(bf16*)(F.ws + WS_MG), (const bf16*)(F.ws + WS_SGA), ACT_STRIDE / 2};
              if (blockIdx.x < 256) pg8::gemm_phase<pg8::EpiG2, pg8::SchedPair, true>(F.tid, F.lds + RING_OFF, D, S, E); }
        PH_END
        PHB(4) g3_side(F, l);
            { pg8::SchedDense S{(const char*)(F.ws + WS_MG), (const char*)(wl + WO_WM), 64, 4, F.G, (int)blockIdx.x, D};
              pg8::EpiG3 E{(float*)(F.ws + (rep_ > 0 ? WS_Y : WS_H))};
              pg8::gemm_phase<pg8::EpiG3, pg8::SchedDense, true>(F.tid, F.lds + RING_OFF, D, S, E); }
        PH_END
        PHB(5) phase_t2(F, l, l + 2 * (int)(rep_ > 0), (size_t)(rep_ > 0) << 23); PH_END
        PHB(6) build_toff(F, l);
            { pg8::SchedMoe S{(const char*)(F.ws + WS_XN), (const char*)(F.ws + WS_WGU), (const int*)(F.ws + WS_LIST), (const unsigned*)(F.ctl + CW_CNT + 64 * 32 * l), (const LAS int*)(F.lds + TOFF_OFF), F.G, F.vcu, D, (size_t)D * D * 2, true};
              pg8::EpiM1 E{(bf16*)(F.ws + WS_HACT)};
              pg8::gemm_phase<pg8::EpiM1, pg8::SchedMoe, true>(F.tid, F.lds + RING_OFF, D, S, E); }
        PH_END
        PHB(7) build_toff(F, l);
            { pg8::SchedMoe S{(const char*)(F.ws + WS_HACT), (const char*)(F.ws + WS_WDN), (const int*)(F.ws + WS_LIST), (const unsigned*)(F.ctl + CW_CNT + 64 * 32 * l), (const LAS int*)(F.lds + TOFF_OFF), F.G, F.vcu, DE, (size_t)D * DE * 2, false};
              pg8::EpiM2 E{(bf16*)(F.ws + WS_Y)};
              pg8::gemm_phase<pg8::EpiM2, pg8::SchedMoe, true>(F.tid, F.lds + RING_OFF, DE, S, E); }
        PH_END
    }
    PHB(8) phase_out(F); PH_END
#undef PHB
#undef PH_END
}

extern "C" void kernel_launch(void* const* d_in, const int* in_sizes, int n_in, void* d_out, int out_size, void* d_ws, size_t ws_size, hipStream_t stream) {
    static int grid = 0;
    if (grid == 0) {
        if (n_in != 19 || in_sizes[0] != M * D || out_size != M * D || ws_size < WS_END) { fprintf(stderr, "kernel_launch: unexpected shapes / workspace (n_in %d, in0 %d, out %d, ws %zu, need %zu); nothing launched\n", n_in, n_in > 0 ? in_sizes[0] : -1, out_size, ws_size, (size_t)WS_END); grid = -1; return; }
        int dev = 0, cus = 0, per_cu = 0;
        if (hipGetDevice(&dev) != hipSuccess || hipDeviceGetAttribute(&cus, hipDeviceAttributeMultiprocessorCount, dev) != hipSuccess) { grid = -1; return; }
        if (hipFuncSetAttribute((const void*)fwd_kernel, hipFuncAttributeMaxDynamicSharedMemorySize, LDS_BYTES) != hipSuccess) { fprintf(stderr, "kernel_launch: hipFuncSetAttribute failed\n"); grid = -1; return; }
        if (hipOccupancyMaxActiveBlocksPerMultiprocessor(&per_cu, (const void*)fwd_kernel, NWAVES * 64, LDS_BYTES) != hipSuccess || per_cu < 1) fprintf(stderr, "kernel_launch: note: occupancy query reports %d workgroups per CU\n", per_cu);
        (void)hipGetLastError();
        grid = cus;
        if (grid != 256) fprintf(stderr, "kernel_launch: note: %d CUs (tuned for 256)\n", grid);
    }
    if (grid < 0) return;
    if (hipMemsetAsync((char*)d_ws + WS_CTL, 0, CTL_ZERO_BYTES, stream) != hipSuccess) return;
    Args a{};
    for (int i = 0; i < 19; ++i) a.in[i] = (const float*)d_in[i];
    a.out = (float*)d_out; a.ws = (unsigned char*)d_ws; a.two = 2;
#if MK_N_LAUNCHES == 1
    a.ph_lo = 0; a.ph_hi = N_PHASES; a.li = 0;
    hipLaunchKernelGGL(fwd_kernel, dim3(grid), dim3(NWAVES * 64), LDS_BYTES, stream, a);
#else
    for (int p = 0; p < N_PHASES; ++p) { a.ph_lo = p; a.ph_hi = p + 1; a.li = 0; hipLaunchKernelGGL(fwd_kernel, dim3(grid), dim3(NWAVES * 64), LDS_BYTES, stream, a); }
#endif
}
```

```cpp
#include <hip/hip_runtime.h>
#include <cstdio>
#include <cstdint>
#include <cmath>
namespace pg8 {
#define PG8_LAS __attribute__((address_space(3)))
typedef unsigned short bf16_t;
typedef short bf16x8 __attribute__((ext_vector_type(8)));
typedef float f32x4 __attribute__((ext_vector_type(4)));
typedef float f32x2 __attribute__((ext_vector_type(2)));
typedef unsigned u32x4 __attribute__((ext_vector_type(4)));
__device__ __forceinline__ float shx(float v, int m, int lane) { return __int_as_float(__builtin_amdgcn_ds_bpermute((lane ^ m) << 2, __float_as_int(v))); }
__device__ __forceinline__ float row16_sum(float v) {
    v += __int_as_float(__builtin_amdgcn_update_dpp(0, __float_as_int(v), 0xB1, 0xF, 0xF, true));
    v += __int_as_float(__builtin_amdgcn_update_dpp(0, __float_as_int(v), 0x4E, 0xF, 0xF, true));
    v += __int_as_float(__builtin_amdgcn_update_dpp(0, __float_as_int(v), 0x141, 0xF, 0xF, true));
    v += __int_as_float(__builtin_amdgcn_update_dpp(0, __float_as_int(v), 0x140, 0xF, 0xF, true));
    return v;
}
constexpr int BM = 256, BK = 64, HALF = 128, HTB = HALF * BK * 2  , STAGE_BYTES = 8 * HTB, NXCD = 8, WGM = 8;

__host__ __device__ __forceinline__ int lds_byte(int r, int c) { const int st = (r >> 4) * 2 + (c >> 5), rr = r & 15, cc = c & 31, ob = rr * 64 + cc * 2; return st * 1024 + (ob ^ (((ob >> 9) & 1) << 5)); }
__host__ __device__ __forceinline__ void stage_rc(int b, int& R, int& C) { const int st = b / 1024, sb = b % 1024, swz = sb ^ (((sb >> 9) & 1) << 5); R = (st >> 1) * 16 + swz / 64; C = (st & 1) * 32 + (swz % 64) / 2; }
__host__ __device__ __forceinline__ int perm32(int rho) { const int n = rho >> 4, i = rho & 15; return 8 * (i >> 2) + 4 * n + (i & 3); }

struct Unit { const char* a; const char* b; int kind, pm, pn, aux; };

__device__ __forceinline__ void tile_of(int L, int nM, int nN, int& pm, int& pn) {
    const int nwg = nM * nN; int wgid = L; { const int q = nwg / NXCD, r = nwg % NXCD, xcd = wgid % NXCD, off = wgid / NXCD; wgid = (xcd < r ? xcd * (q + 1) : r * (q + 1) + (xcd - r) * q) + off; }
    const int nig = WGM * nN, gid = wgid / nig, fm = gid * WGM, gsz = (nM - fm) < WGM ? (nM - fm) : WGM;
    pm = fm + ((wgid % nig) % gsz); pn = (wgid % nig) / gsz;
}
__device__ __forceinline__ unsigned cvt_pk_bf16(float lo, float hi) { unsigned r; asm volatile("v_cvt_pk_bf16_f32 %0, %1, %2" : "=v"(r) : "v"(lo), "v"(hi)); return r; }
__device__ __forceinline__ float bf_lo(unsigned w) { return __uint_as_float(w << 16); }
__device__ __forceinline__ float bf_hi(unsigned w) { return __uint_as_float(w & 0xffff0000u); }
__device__ __forceinline__ float sigmoidf_fast(float x) { return __builtin_amdgcn_rcpf(1.0f + __builtin_amdgcn_exp2f(-1.4426950408889634f * x)); }

template <class Epi, class Sched, bool ALIGN_EPI>
__device__ __forceinline__ void gemm_phase(const int tid, PG8_LAS unsigned char* lds, const int K, const Sched& S, const Epi& E) {
    const int wid = __builtin_amdgcn_readfirstlane(tid >> 6), lane = tid & 63, wr = wid >> 2, wc = wid & 3, fr = lane & 15, fq = lane >> 4;
    const int nt = K / BK;
    int sR[2], sC[2]; unsigned voffB[2];
#pragma unroll
    for (int i = 0; i < 2; ++i) { stage_rc(tid * 16 + i * 8192, sR[i], sC[i]); const int Rb = (sR[i] & ~31) + perm32(sR[i] & 31); voffB[i] = (unsigned)(Rb * K + sC[i]) * 2u; }
    const size_t kstep = (size_t)(BK * 2);
    const size_t hstep = (size_t)HALF * K * 2;
    const unsigned ldsw = (unsigned)wid * 1024u;
    const int aoff = lds_byte(wr * 64 + fr, fq * 8), boff = lds_byte(wc * 32 + fr, fq * 8);
#define PG8_SA(b, h) (((b) * 2 + (h)) * HTB)
#define PG8_SB(b, h) ((4 + (b) * 2 + (h)) * HTB)
#define PG8_STAGE(bufoff, gbase, v0, v1) do { \
        __builtin_amdgcn_global_load_lds((const unsigned*)((const char*)(gbase) + (v0)), (PG8_LAS unsigned*)(lds + (bufoff) + ldsw), 16, 0, 0); \
        __builtin_amdgcn_global_load_lds((const unsigned*)((const char*)(gbase) + (v1)), (PG8_LAS unsigned*)(lds + (bufoff) + ldsw + 8192), 16, 0, 0); } while (0)
#define PG8_STAGEB(bufoff, gbase) PG8_STAGE(bufoff, gbase, voffB[0], voffB[1])
#define PG8_LDA(dst, b, h) do { _Pragma("unroll") for (int m = 0; m < 4; ++m) _Pragma("unroll") for (int k = 0; k < 2; ++k) dst[m][k] = *(const PG8_LAS bf16x8*)(lds + PG8_SA(b, h) + aoff + m * 2048 + k * 1024); } while (0)
#define PG8_LDB(dst, b, h) do { _Pragma("unroll") for (int n = 0; n < 2; ++n) _Pragma("unroll") for (int k = 0; k < 2; ++k) dst[n][k] = *(const PG8_LAS bf16x8*)(lds + PG8_SB(b, h) + boff + n * 2048 + k * 1024); } while (0)
#define PG8_MMA(ai, bj, At, Bt) do { __builtin_amdgcn_s_setprio(1); _Pragma("unroll") for (int m = 0; m < 4; ++m) _Pragma("unroll") for (int n = 0; n < 2; ++n) _Pragma("unroll") for (int k = 0; k < 2; ++k) \
        acc[ai][bj][m][n] = __builtin_amdgcn_mfma_f32_16x16x32_bf16(Bt[n][k], At[m][k], acc[ai][bj][m][n], 0, 0, 0); __builtin_amdgcn_s_setprio(0); } while (0)
#define PG8_WAIT_V(n) asm volatile("s_waitcnt vmcnt(" #n ")" ::: "memory")
#define PG8_WAIT_L(n) asm volatile("s_waitcnt lgkmcnt(" #n ")" ::: "memory")
#define PG8_BAR __builtin_amdgcn_s_barrier()
#define PG8_SCHED __builtin_amdgcn_sched_barrier(0)
    Unit cur, nxt; int ui = 0;
    if (!S.next(0, cur)) return;
    f32x4 acc[2][2][4][2];
#pragma unroll
    for (int a = 0; a < 2; ++a)
#pragma unroll
        for (int b = 0; b < 2; ++b)
#pragma unroll
            for (int m = 0; m < 4; ++m)
#pragma unroll
                for (int n = 0; n < 2; ++n) acc[a][b][m][n] = (f32x4){0.f, 0.f, 0.f, 0.f};
    bf16x8 At[4][2], B0[2][2], B1[2][2];
    unsigned vA[2][2], vN[2][2];
    S.voff(cur, K, sR, sC, vA);
    const char* cA = cur.a; const char* cB = cur.b;
    PG8_STAGEB(PG8_SB(0, 0), cB); PG8_STAGEB(PG8_SB(0, 1), cB + hstep); PG8_STAGE(PG8_SA(0, 0), cA, vA[0][0], vA[0][1]); PG8_STAGE(PG8_SA(0, 1), cA, vA[1][0], vA[1][1]);
    if (wr == 1) PG8_BAR;
    PG8_WAIT_V(2); PG8_BAR;
    PG8_STAGEB(PG8_SB(1, 0), cB + kstep); PG8_STAGE(PG8_SA(1, 0), cA + kstep, vA[0][0], vA[0][1]); PG8_STAGEB(PG8_SB(1, 1), cB + hstep + kstep);
    PG8_WAIT_V(6); PG8_BAR;
    for (;;) {
        const bool has_next = S.next(ui + 1, nxt);
        const char* nA = cA; const char* nB = cB;
#pragma unroll
        for (int h = 0; h < 2; ++h) { vN[h][0] = vA[h][0]; vN[h][1] = vA[h][1]; }
        if (has_next) { nA = nxt.a; nB = nxt.b; S.voff(nxt, K, sR, sC, vN); }
        for (int t = 0; t < nt; t += 2) {
            const bool last = (t == nt - 2);
            const char* a1 = cA + (size_t)(t + 1) * kstep;
            const char* a2 = last ? nA : cA + (size_t)(t + 2) * kstep; const char* b2 = last ? nB : cB + (size_t)(t + 2) * kstep;
            const char* a3 = a2 + kstep; const char* b3 = b2 + kstep;
            const unsigned w00 = last ? vN[0][0] : vA[0][0], w01 = last ? vN[0][1] : vA[0][1], w10 = last ? vN[1][0] : vA[1][0], w11 = last ? vN[1][1] : vA[1][1];
            PG8_LDB(B0, 0, 0); PG8_LDB(B1, 0, 1); PG8_SCHED; PG8_LDA(At, 0, 0); PG8_STAGE(PG8_SA(1, 1), a1, vA[1][0], vA[1][1]);
            PG8_WAIT_V(8); PG8_WAIT_L(0); PG8_BAR; PG8_MMA(0, 0, At, B0); PG8_MMA(0, 1, At, B1); PG8_BAR; PG8_SCHED;
            PG8_LDA(At, 0, 1); PG8_STAGEB(PG8_SB(0, 0), b2); PG8_STAGEB(PG8_SB(0, 1), b2 + hstep); PG8_STAGE(PG8_SA(0, 0), a2, w00, w01);
            PG8_WAIT_V(8); PG8_WAIT_L(0); PG8_BAR; PG8_MMA(1, 0, At, B0); PG8_MMA(1, 1, At, B1); PG8_BAR; PG8_SCHED;
            PG8_LDB(B0, 1, 0); PG8_LDB(B1, 1, 1); PG8_SCHED; PG8_LDA(At, 1, 0); PG8_STAGE(PG8_SA(0, 1), a2, w10, w11);
            PG8_WAIT_V(8); PG8_WAIT_L(0); PG8_BAR; PG8_MMA(0, 0, At, B0); PG8_MMA(0, 1, At, B1); PG8_BAR; PG8_SCHED;
            PG8_LDA(At, 1, 1); PG8_STAGEB(PG8_SB(1, 0), b3); PG8_STAGEB(PG8_SB(1, 1), b3 + hstep); PG8_STAGE(PG8_SA(1, 0), a3, w00, w01);
            PG8_WAIT_V(8); PG8_WAIT_L(0); PG8_BAR; PG8_MMA(1, 0, At, B0); PG8_MMA(1, 1, At, B1); PG8_BAR; PG8_SCHED;
        }
        if constexpr (ALIGN_EPI) { if (wr == 0) PG8_BAR; }
        E(acc, cur, wr, wc, fr, fq);
        if (!has_next) break;
#pragma unroll
        for (int a = 0; a < 2; ++a)
#pragma unroll
            for (int b = 0; b < 2; ++b)
#pragma unroll
                for (int m = 0; m < 4; ++m)
#pragma unroll
                    for (int n = 0; n < 2; ++n) acc[a][b][m][n] = (f32x4){0.f, 0.f, 0.f, 0.f};
        cur = nxt; cA = nA; cB = nB; ++ui;
#pragma unroll
        for (int h = 0; h < 2; ++h) { vA[h][0] = vN[h][0]; vA[h][1] = vN[h][1]; }
        if constexpr (ALIGN_EPI) { if (wr == 1) PG8_BAR; }
    }
    PG8_WAIT_V(0);
    if constexpr (!ALIGN_EPI) { if (wr == 0) PG8_BAR; }
    PG8_BAR;
#undef PG8_SA
#undef PG8_SB
#undef PG8_STAGE
#undef PG8_STAGEB
#undef PG8_LDA
#undef PG8_LDB
#undef PG8_MMA
#undef PG8_WAIT_V
#undef PG8_WAIT_L
#undef PG8_BAR
#undef PG8_SCHED
}
}
namespace pg8 {
__device__ __forceinline__ void st8(bf16_t* p, const f32x4 v0, const f32x4 v1) { u32x4 w; w.x = cvt_pk_bf16(v0[0], v0[1]); w.y = cvt_pk_bf16(v0[2], v0[3]); w.z = cvt_pk_bf16(v1[0], v1[1]); w.w = cvt_pk_bf16(v1[2], v1[3]); *(u32x4*)p = w; }
__device__ __forceinline__ f32x4 sig4(const f32x4 v) { return (f32x4){sigmoidf_fast(v[0]), sigmoidf_fast(v[1]), sigmoidf_fast(v[2]), sigmoidf_fast(v[3])}; }
struct EpiG1 {
    bf16_t* act; size_t astride; const float __attribute__((address_space(1)))* qg; float c2;
    long kgoff;
    __device__ __forceinline__ void operator()(const f32x4 (&acc)[2][2][4][2], const Unit& u, int wr, int wc, int fr, int fq) const {
        const int row0 = u.pm * BM + wr * 64 + fr, pn = u.pn;
        if (pn < 8) {
            bf16_t* base = act + astride + pn * 128 + wc * 32 + 8 * fq;
#pragma unroll
            for (int ai = 0; ai < 2; ++ai)
#pragma unroll
                for (int m = 0; m < 4; ++m) st8(base + (size_t)(row0 + ai * HALF + m * 16) * 1024, acc[ai][0][m][0] * acc[ai][1][m][0], acc[ai][0][m][1] * acc[ai][1][m][1]);
        } else if (pn >= 12 && pn < 20) {
            const bool isq = pn < 16; const float __attribute__((address_space(1)))* g = qg + (isq ? 0 : kgoff); bf16_t* base = act + (isq ? 3 : 4) * astride + (4 * (pn & 3) + wc) * 64 + 8 * fq;
            f32x4 gv[2][2];
#pragma unroll
            for (int bj = 0; bj < 2; ++bj)
#pragma unroll
                for (int n = 0; n < 2; ++n) gv[bj][n] = *(const f32x4 __attribute__((address_space(1)))*)(g + 32 * bj + 8 * fq + 4 * n);
            const float sc = isq ? c2 : 1.0f;
#pragma unroll
            for (int ai = 0; ai < 2; ++ai)
#pragma unroll
                for (int m = 0; m < 4; ++m) {
                    float ss = 0.f;
#pragma unroll
                    for (int bj = 0; bj < 2; ++bj)
#pragma unroll
                        for (int n = 0; n < 2; ++n) { const f32x4 x = acc[ai][bj][m][n]; ss += (x[0] * x[0] + x[1] * x[1]) + (x[2] * x[2] + x[3] * x[3]); }
                    { const int ln = fq * 16 + fr; ss += shx(ss, 16, ln); ss += shx(ss, 32, ln); }
                    const float rs = __builtin_amdgcn_rsqf(ss * (1.0f / 64.0f) + 1e-6f) * sc;
                    bf16_t* rowp = base + (size_t)(row0 + ai * HALF + m * 16) * 1024;
#pragma unroll
                    for (int bj = 0; bj < 2; ++bj) st8(rowp + 32 * bj, acc[ai][bj][m][0] * gv[bj][0] * rs, acc[ai][bj][m][1] * gv[bj][1] * rs);
                }
        } else {
            const bool gate = pn >= 24;
            const int bi = pn < 12 ? 2 : pn < 24 ? 5 : pn < 28 ? 6 : 7;
            bf16_t* base = act + bi * astride + (pn & 3) * 256 + wc * 32 + 8 * fq;
#pragma unroll
            for (int ai = 0; ai < 2; ++ai)
#pragma unroll
                for (int m = 0; m < 4; ++m) { bf16_t* rowp = base + (size_t)(row0 + ai * HALF + m * 16) * 1024;
#pragma unroll
                    for (int bj = 0; bj < 2; ++bj) { f32x4 v0 = acc[ai][bj][m][0], v1 = acc[ai][bj][m][1]; if (gate) { v0 = sig4(v0); v1 = sig4(v1); } st8(rowp + bj * HALF, v0, v1); } }
        }
    }
};
struct EpiG2 {
    bf16_t* MG; const bf16_t* SGA; size_t gstride;
    __device__ __forceinline__ void operator()(const f32x4 (&acc)[2][2][4][2], const Unit& u, int wr, int wc, int fr, int fq) const {
        const int row0 = u.pm * BM + wr * 64 + fr, col0 = u.pn * BM + wc * 32 + 8 * fq; const bf16_t* G = SGA + (u.kind ? gstride : 0);
#pragma unroll
        for (int ai = 0; ai < 2; ++ai)
#pragma unroll
            for (int m = 0; m < 4; ++m) { const size_t off = (size_t)(row0 + ai * HALF + m * 16) * 1024 + col0;
#pragma unroll
                for (int bj = 0; bj < 2; ++bj) { const u32x4 g = *(const u32x4*)(G + off + bj * HALF);
                    f32x4 v0 = acc[ai][bj][m][0] * (f32x4){bf_lo(g.x), bf_hi(g.x), bf_lo(g.y), bf_hi(g.y)}, v1 = acc[ai][bj][m][1] * (f32x4){bf_lo(g.z), bf_hi(g.z), bf_lo(g.w), bf_hi(g.w)};
                    if (u.kind) { const u32x4 t = *(const u32x4*)(MG + off + bj * HALF); v0 += (f32x4){bf_lo(t.x), bf_hi(t.x), bf_lo(t.y), bf_hi(t.y)}; v1 += (f32x4){bf_lo(t.z), bf_hi(t.z), bf_lo(t.w), bf_hi(t.w)}; }
                    st8(MG + off + bj * HALF, v0, v1); }
                asm volatile("" ::: "memory"); }
    }
};
struct EpiG3 {
    float* H;
    __device__ __forceinline__ void operator()(const f32x4 (&acc)[2][2][4][2], const Unit& u, int wr, int wc, int fr, int fq) const {
        const int row0 = u.pm * BM + wr * 64 + fr, col0 = u.pn * BM + wc * 32 + 8 * fq;
#pragma unroll
        for (int ai = 0; ai < 2; ++ai)
#pragma unroll
            for (int m = 0; m < 4; ++m) { float* rowp = H + (size_t)(row0 + ai * HALF + m * 16) * 1024 + col0;
#pragma unroll
                for (int bj = 0; bj < 2; ++bj)
#pragma unroll
                    for (int n = 0; n < 2; ++n) { f32x4* p = (f32x4*)(rowp + bj * HALF + 4 * n); *p = *p + acc[ai][bj][m][n]; }
                asm volatile("" ::: "memory"); }
    }
};
struct EpiM1 {
    bf16_t* HACT;
    __device__ __forceinline__ void operator()(const f32x4 (&acc)[2][2][4][2], const Unit& u, int wr, int wc, int fr, int fq) const {
        bf16_t* base = HACT + (size_t)(u.pm * BM + wr * 64 + fr) * 512 + u.pn * 128 + wc * 32 + 8 * fq;
#pragma unroll
        for (int ai = 0; ai < 2; ++ai)
#pragma unroll
            for (int m = 0; m < 4; ++m) { const f32x4 g0 = acc[ai][0][m][0], g1 = acc[ai][0][m][1];
                st8(base + (size_t)(ai * HALF + m * 16) * 512, g0 * sig4(g0) * acc[ai][1][m][0], g1 * sig4(g1) * acc[ai][1][m][1]); }
    }
};
struct EpiM2 {
    bf16_t* Y;
    __device__ __forceinline__ void operator()(const f32x4 (&acc)[2][2][4][2], const Unit& u, int wr, int wc, int fr, int fq) const {
        bf16_t* base = Y + (size_t)(u.pm * BM + wr * 64 + fr) * 1024 + u.pn * BM + wc * 32 + 8 * fq;
#pragma unroll
        for (int ai = 0; ai < 2; ++ai)
#pragma unroll
            for (int m = 0; m < 4; ++m)
#pragma unroll
                for (int bj = 0; bj < 2; ++bj) st8(base + (size_t)(ai * HALF + m * 16) * 1024 + bj * HALF, acc[ai][bj][m][0], acc[ai][bj][m][1]);
    }
};

}
#include <hip/hip_bf16.h>
namespace attn_body {
using bf16=__hip_bfloat16;
using bf16x8=__attribute__((ext_vector_type(8)))short;
using s16x4=__attribute__((ext_vector_type(4)))short;
using f32x16=__attribute__((ext_vector_type(16)))float;
using f32x4=__attribute__((ext_vector_type(4)))float;
using u32x4=__attribute__((ext_vector_type(4)))unsigned;
constexpr int NHEAD=16,SEQ=8192,D=64,DM=NHEAD*D;
constexpr int NW=8,QBLK=32,QB=QBLK*NW,KVBLK=64,NQB=SEQ/QB;
constexpr int META_ROW=16384;
__device__ __forceinline__ int crow(int r,int hi){return (r&3)+8*(r>>2)+4*hi;}
#define SBAR() __builtin_amdgcn_sched_barrier(0)
__device__ __forceinline__ void cmask(f32x16&p0,f32x16&p1,int jb,int qrel,int hi){
  const float NEG=-INFINITY; int kb=64*jb+4*hi;
  #pragma unroll
  for(int r=0;r<16;++r){int kv=kb+(r&3)+8*(r>>2); if(kv>qrel)p0[r]=NEG; if(kv+32>qrel)p1[r]=NEG;}
}
constexpr int NSLOT=3, SLOTB=8192, MAXT=132;
constexpr int LDS_K=0, LDS_V=NSLOT*SLOTB, LDS_WS=2*NSLOT*SLOTB, LDS_OST=LDS_WS+NW*64*4, LDS_BL=LDS_OST+NW*4096, LDS_BYTES=LDS_BL+MAXT*256;
constexpr float C2=0.125f*1.4426950408889634f;
__device__ __forceinline__ void glds16(const void*gsrc,unsigned lds_dst){unsigned keep;
  asm volatile("s_mov_b32 %0, m0\n\ts_mov_b32 m0, %2\n\ts_nop 0\n\tglobal_load_lds_dwordx4 %1, off\n\ts_mov_b32 m0, %0":"=&s"(keep):"v"(gsrc),"s"(lds_dst):"memory");}
typedef float f32x2_t __attribute__((ext_vector_type(2))); typedef __bf16 bf16x2_t __attribute__((ext_vector_type(2)));
__device__ __forceinline__ unsigned cvtpk_s(float lo,float hi){f32x2_t v={lo,hi};bf16x2_t b=__builtin_convertvector(v,bf16x2_t);return __builtin_bit_cast(unsigned,b);}
#define WAIT_BAR(N) asm volatile("s_waitcnt vmcnt(" #N ") lgkmcnt(0)\n\ts_barrier":::"memory")
typedef __attribute__((address_space(3))) const char* lds_cptr;
typedef short v4i16_t __attribute__((ext_vector_type(4)));
__device__ __forceinline__ void kload8(bf16x8*kf,lds_cptr kp){
  kf[0]=*(const __attribute__((address_space(3))) bf16x8*)(kp);      kf[1]=*(const __attribute__((address_space(3))) bf16x8*)(kp+512);
  kf[2]=*(const __attribute__((address_space(3))) bf16x8*)(kp+2048); kf[3]=*(const __attribute__((address_space(3))) bf16x8*)(kp+2560);
  kf[4]=*(const __attribute__((address_space(3))) bf16x8*)(kp+4096); kf[5]=*(const __attribute__((address_space(3))) bf16x8*)(kp+4608);
  kf[6]=*(const __attribute__((address_space(3))) bf16x8*)(kp+6144); kf[7]=*(const __attribute__((address_space(3))) bf16x8*)(kp+6656);
}
__device__ __forceinline__ void kload2(bf16x8*kf,lds_cptr kp,int j){ kf[2*j]=*(const __attribute__((address_space(3))) bf16x8*)(kp+j*2048); kf[2*j+1]=*(const __attribute__((address_space(3))) bf16x8*)(kp+j*2048+512); }
__device__ __forceinline__ s16x4 vtr(lds_cptr p){ return __builtin_bit_cast(s16x4,__builtin_amdgcn_ds_read_tr16_b64_v4i16((__attribute__((address_space(3))) v4i16_t*)p)); }
__device__ __forceinline__ void binit(f32x16&p0,f32x16&p1,lds_cptr bl,float at){
  #pragma unroll
  for(int g=0;g<4;++g){ const f32x4 a=*(const __attribute__((address_space(3))) f32x4*)(bl+32*g), b=*(const __attribute__((address_space(3))) f32x4*)(bl+128+32*g);
    #pragma unroll
    for(int i=0;i<4;++i){p0[4*g+i]=a[i]+at;p1[4*g+i]=b[i]+at;} }
}
__device__ __forceinline__ void pv(f32x16*o,int vb,bf16x8 pa0,bf16x8 pa1,bf16x8 pa2,bf16x8 pa3){
  #pragma unroll
  for(int d0=0;d0<2;++d0){s16x4 lo[4],hi[4];
    #pragma unroll
    for(int ks=0;ks<4;++ks){
      asm volatile("ds_read_b64_tr_b16 %0,%1 offset:%c2":"=&v"(lo[ks]):"v"(vb),"i"(d0*4096+ks*1024):"memory");
      asm volatile("ds_read_b64_tr_b16 %0,%1 offset:%c2":"=&v"(hi[ks]):"v"(vb),"i"(d0*4096+ks*1024+512):"memory");}
    asm volatile("s_waitcnt lgkmcnt(0)":::"memory");SBAR();
    #define PK(k) (bf16x8){lo[k][0],lo[k][1],lo[k][2],lo[k][3],hi[k][0],hi[k][1],hi[k][2],hi[k][3]}
    o[d0]=__builtin_amdgcn_mfma_f32_32x32x16_bf16(pa0,PK(0),o[d0],0,0,0);
    o[d0]=__builtin_amdgcn_mfma_f32_32x32x16_bf16(pa1,PK(1),o[d0],0,0,0);
    o[d0]=__builtin_amdgcn_mfma_f32_32x32x16_bf16(pa2,PK(2),o[d0],0,0,0);
    o[d0]=__builtin_amdgcn_mfma_f32_32x32x16_bf16(pa3,PK(3),o[d0],0,0,0);
    #undef PK
  }
}
#ifndef ATTN_STORE16
#define ATTN_STORE16(p,v) (*(u32x4*)(p)=(v))
#endif
__device__ __forceinline__ void attn_unit(const int tid,int b,int h,int qb,const float TH,const bf16*Q,const bf16*__restrict__ K,const bf16*__restrict__ V,bf16*O,const float*__restrict__ cb,const float*__restrict__ cbm,float m0,char*shm){
  const int lane=tid&63,r32=lane&31,hi=lane>>5; const int wid=__builtin_amdgcn_readfirstlane(tid>>6);
  const long rowbase=(long)b*SEQ; const int q0=qb*QB;
  const bf16*Qw=Q+(rowbase+q0+wid*QBLK)*DM+h*D;
  const bf16*Kh=K+rowbase*DM+h*D,*Vh=V+rowbase*DM+h*D;
  const unsigned lds0=(unsigned)(uintptr_t)shm;
  float*wsf=(float*)(shm+LDS_WS)+wid*64;
  bf16x8 qr[4];
  #pragma unroll
  for(int d0=0;d0<4;++d0)qr[d0]=*reinterpret_cast<const bf16x8*>(&Qw[(long)r32*DM+d0*16+hi*8]);
  const float at=cb[q0+wid*QBLK+r32]-m0;
  int ts,PRE;
  { const float cbq=cb[q0]; const int nj=4*qb;
    const bool f0=lane<nj&&(cbq-cb[64*lane+63]<-TH), f1=lane+64<nj&&(cbq-cb[64*(lane+64)+63]<-TH);
    ts=__builtin_popcountll(__builtin_amdgcn_ballot_w64(f0))+__builtin_popcountll(__builtin_amdgcn_ballot_w64(f1));
    const int has_meta=(ts==0)?1:0; int dummy=0;
    if((has_meta+4*qb+4-ts)&1){ if(ts>0)--ts; else dummy=1; }
    PRE=has_meta+dummy; }
  const int NT=(q0+QB)/KVBLK-ts+PRE;
  const long koff=(long)lane*DM+wid*8, voff=(long)(16*(wid&3)+(lane>>2))*DM+(wid>>2)*32+(lane&3)*8;
  const bf16*ksrc=Kh+koff+(long)(ts-PRE)*KVBLK*DM;
  const bf16*vsrc=Vh+voff+(long)(ts-PRE)*KVBLK*DM;
  const long dmeta=((long)META_ROW-rowbase)*DM-(long)(ts-PRE)*KVBLK*DM;
  const unsigned kdst=lds0+LDS_K+wid*1024, vdst=lds0+LDS_V+wid*1024;
  #define DMA_K(t,slot) glds16(ksrc+(((t)<PRE)?dmeta:(long)(t)*KVBLK*DM),(unsigned)__builtin_amdgcn_readfirstlane(kdst+(slot)))
  #define DMA_V(t,slot) glds16(vsrc+(((t)<PRE)?dmeta:(long)(t)*KVBLK*DM),(unsigned)__builtin_amdgcn_readfirstlane(vdst+(slot)))
  const int vb0=(int)(lds0+LDS_V)+((lane>>4)&1)*32+(lane&3)*8+(4*hi+((lane&15)>>2))*64;
  bf16x8 kf[8];
  const lds_cptr shm3=(lds_cptr)shm; const lds_cptr kp0=shm3+LDS_K+hi*1024+r32*16; const lds_cptr vp0=shm3+LDS_V+((lane>>4)&1)*32+(lane&3)*8+(4*hi+((lane&15)>>2))*64;
  lds_cptr blp=shm3+LDS_BL+16*hi;
  DMA_K(0,0);DMA_V(0,0);DMA_K(1,SLOTB);
  float l_reg=0.f;f32x16 o[2];o[0]=f32x16{};o[1]=f32x16{};
  const int qrel=wid*QBLK+r32;
  #define CMASK(P0,P1,t) do{int jb_=(t)-(NT-4); if(jb_>=0)cmask(P0,P1,jb_,qrel,hi);}while(0)
  f32x16 pA0,pA1,pB0,pB1;
  int sl_prev=0,sl_cur=0,sl_next=SLOTB;
  #define ROT() do{sl_prev=sl_cur;sl_cur=sl_next;sl_next=(sl_next==(NSLOT-1)*SLOTB)?0:sl_next+SLOTB;}while(0)
  DMA_K(2,2*SLOTB);
  { float*BLf=(float*)(shm+LDS_BL);
    for(int i=tid;i<NT*64;i+=NW*64){ const int ti=i>>6,j=i&63; float v;
      if(ti<PRE-1)v=-INFINITY; else if(ti==PRE-1)v=(j<16)?-cbm[j]:-INFINITY; else v=-cb[(ti-PRE+ts)*64+j];
      BLf[i]=v; } }
  WAIT_BAR(3);
  binit(pA0,pA1,blp,at); blp+=256;
  { const lds_cptr kb=kp0;
    #pragma unroll
    for(int d0=0;d0<4;++d0){
      const bf16x8 b0=*(const __attribute__((address_space(3))) bf16x8*)(kb+d0*2048);
      const bf16x8 b1=*(const __attribute__((address_space(3))) bf16x8*)(kb+d0*2048+512);
      pA0=__builtin_amdgcn_mfma_f32_32x32x16_bf16(b0,qr[d0],pA0,0,0,0);pA1=__builtin_amdgcn_mfma_f32_32x32x16_bf16(b1,qr[d0],pA1,0,0,0);} }
  CMASK(pA0,pA1,0);
  _Pragma("unroll") for(int r=0;r<16;++r){pA0[r]=__builtin_amdgcn_exp2f(pA0[r]);pA1[r]=__builtin_amdgcn_exp2f(pA1[r]);}
  binit(pB0,pB1,blp,at); blp+=256;
  WAIT_BAR(0);
  DMA_K(3,0);DMA_V(1,SLOTB);
  ROT();
  kload8(kf,kp0+sl_cur);
  WAIT_BAR(2);
  s16x4 vlo[8],vhi[8]; u32x4 pw0,pw1,pw2,pw3;
  #define PKW(P,B) cvtpk_s(P[B],P[B+1])
  #define PAF(k) __builtin_bit_cast(bf16x8,pw##k)
  #define VFR(i) (bf16x8){vlo[i][0],vlo[i][1],vlo[i][2],vlo[i][3],vhi[i][0],vhi[i][1],vhi[i][2],vhi[i][3]}
  #define PIN(x) asm volatile("":"+v"(x))
  #define GAPA(MF,A0,A1,A2,A3,W0,W1,PW) do{ MF; sacc+=A0; sacc+=A1; sacc+=A2; sacc+=A3; PIN(sacc); W0; W1; PIN(PW); SBAR(); }while(0)
  #define EX(v) __builtin_amdgcn_exp2f(v)
  #define GAPB(MF,X,B) do{ MF; X[B]=EX(X[B]); X[B+1]=EX(X[B+1]); X[B+2]=EX(X[B+2]); X[B+3]=EX(X[B+3]); PIN(X); SBAR(); }while(0)
  #define VRD(i) do{ vlo[i]=vtr(vp_+(((i)>>2)*4096+((i)&3)*1024)); vhi[i]=vtr(vp_+(((i)>>2)*4096+((i)&3)*1024+512)); }while(0)
  #define KRD(G,j) do{ if(G){ kload2(kf,kp0+sl_next,j); SBAR(); } }while(0)
  #define BRD(G,P,g) do{ if(G){ const f32x4 t_=*(const __attribute__((address_space(3))) f32x4*)(blp+(((g)>>2)*128+((g)&3)*32)); P[4*((g)&3)]=t_[0];P[4*((g)&3)+1]=t_[1];P[4*((g)&3)+2]=t_[2];P[4*((g)&3)+3]=t_[3]; } }while(0)
  #define BAD(G,P,g) do{ if(G){ P[4*((g)&3)]+=at;P[4*((g)&3)+1]+=at;P[4*((g)&3)+2]+=at;P[4*((g)&3)+3]+=at; PIN(P); } }while(0)
  #define STEP(C0,C1,P0,P1,t,GK,GV,GL,GB) do{ SBAR(); \
    const lds_cptr vp_=vp0+sl_prev; \
    VRD(0); SBAR(); float sacc=(P0[0]+P0[1]); \
    GAPA(C0=__builtin_amdgcn_mfma_f32_32x32x16_bf16(kf[0],qr[0],C0,0,0,0), P0[2],P0[3],P0[4],P0[5],     pw0[0]=PKW(P0,0), pw0[1]=PKW(P0,2), pw0); \
    VRD(4); SBAR(); GAPA(C1=__builtin_amdgcn_mfma_f32_32x32x16_bf16(kf[1],qr[0],C1,0,0,0), P0[6],P0[7],P0[8],P0[9],     pw0[2]=PKW(P0,4), pw0[3]=PKW(P0,6), pw0); \
    VRD(1); SBAR(); GAPA(C0=__builtin_amdgcn_mfma_f32_32x32x16_bf16(kf[2],qr[1],C0,0,0,0),   P0[10],P0[11],P0[12],P0[13], pw1[0]=PKW(P0,8), pw1[1]=PKW(P0,10), pw1); \
    VRD(5); SBAR(); GAPA(C1=__builtin_amdgcn_mfma_f32_32x32x16_bf16(kf[3],qr[1],C1,0,0,0),   P0[14],P0[15],P1[0],P1[1],   pw1[2]=PKW(P0,12),pw1[3]=PKW(P0,14), pw1); \
    VRD(2); SBAR(); GAPA(C0=__builtin_amdgcn_mfma_f32_32x32x16_bf16(kf[4],qr[2],C0,0,0,0),   P1[2],P1[3],P1[4],P1[5],     pw2[0]=PKW(P1,0), pw2[1]=PKW(P1,2), pw2); \
    VRD(6); SBAR(); GAPA(C1=__builtin_amdgcn_mfma_f32_32x32x16_bf16(kf[5],qr[2],C1,0,0,0),   P1[6],P1[7],P1[8],P1[9],     pw2[2]=PKW(P1,4), pw2[3]=PKW(P1,6), pw2); \
    VRD(3); SBAR(); GAPA(C0=__builtin_amdgcn_mfma_f32_32x32x16_bf16(kf[6],qr[3],C0,0,0,0),   P1[10],P1[11],P1[12],P1[13], pw3[0]=PKW(P1,8), pw3[1]=PKW(P1,10), pw3); \
    VRD(7); SBAR(); GAPA(C1=__builtin_amdgcn_mfma_f32_32x32x16_bf16(kf[7],qr[3],C1,0,0,0),   P1[14],P1[15],0.f,0.f,       pw3[2]=PKW(P1,12),pw3[3]=PKW(P1,14), pw3); \
    l_reg+=sacc; \
    if(GK){DMA_K((t)+3,sl_cur);} if(GV){DMA_V((t)+1,sl_next);} \
    CMASK(C0,C1,t); \
    SBAR(); \
    BRD(GB,P0,0); GAPB(o[0]=__builtin_amdgcn_mfma_f32_32x32x16_bf16(PAF(0),VFR(0),o[0],0,0,0), C0,0); \
    BRD(GB,P0,1); BAD(GB,P0,0); GAPB(o[1]=__builtin_amdgcn_mfma_f32_32x32x16_bf16(PAF(0),VFR(4),o[1],0,0,0), C0,4); \
    BRD(GB,P0,2); BAD(GB,P0,1); KRD(GL,0); GAPB(o[0]=__builtin_amdgcn_mfma_f32_32x32x16_bf16(PAF(1),VFR(1),o[0],0,0,0), C0,8); \
    BRD(GB,P0,3); BAD(GB,P0,2); KRD(GL,1); GAPB(o[1]=__builtin_amdgcn_mfma_f32_32x32x16_bf16(PAF(1),VFR(5),o[1],0,0,0), C0,12); \
    BRD(GB,P1,4); BAD(GB,P0,3); KRD(GL,2); GAPB(o[0]=__builtin_amdgcn_mfma_f32_32x32x16_bf16(PAF(2),VFR(2),o[0],0,0,0), C1,0); \
    BRD(GB,P1,5); BAD(GB,P1,4); KRD(GL,3); GAPB(o[1]=__builtin_amdgcn_mfma_f32_32x32x16_bf16(PAF(2),VFR(6),o[1],0,0,0), C1,4); \
    BRD(GB,P1,6); BAD(GB,P1,5); GAPB(o[0]=__builtin_amdgcn_mfma_f32_32x32x16_bf16(PAF(3),VFR(3),o[0],0,0,0), C1,8); \
    BRD(GB,P1,7); BAD(GB,P1,6); GAPB(o[1]=__builtin_amdgcn_mfma_f32_32x32x16_bf16(PAF(3),VFR(7),o[1],0,0,0), C1,12); \
    BAD(GB,P1,7); if(GB){blp+=256;} \
    }while(0)
  int t=1;
  #undef CMASK
  #define CMASK(P0,P1,t) do{}while(0)
  for(;t+5<NT;t+=2){
    STEP(pB0,pB1,pA0,pA1,t,true,true,true,true);     WAIT_BAR(2); ROT();
    STEP(pA0,pA1,pB0,pB1,t+1,true,true,true,true);   WAIT_BAR(2); ROT();
  }
  #undef CMASK
  #define CMASK(P0,P1,t) do{int jb_=(t)-(NT-4); if(jb_>=0)cmask(P0,P1,jb_,qrel,hi);}while(0)
  #define ENDW(tt) do{ if((tt)+3<NT){WAIT_BAR(2);} else if((tt)+2<NT){WAIT_BAR(1);} else {WAIT_BAR(0);} }while(0)
  for(;t+1<NT;t+=2){
    STEP(pB0,pB1,pA0,pA1,t,(t+3<NT),(t+1<NT),(t+1<NT),(t+1<NT));       ENDW(t);   ROT();
    STEP(pA0,pA1,pB0,pB1,t+1,(t+4<NT),(t+2<NT),(t+2<NT),(t+2<NT));     ENDW(t+1); ROT();
  }
  STEP(pB0,pB1,pA0,pA1,NT-1,false,false,false,false);
  { float sacc=pB0[0]+pB0[1]; _Pragma("unroll") for(int r=2;r<16;++r)sacc+=pB0[r]; _Pragma("unroll") for(int r=0;r<16;++r)sacc+=pB1[r]; l_reg+=sacc;
    pw0=(u32x4){PKW(pB0,0),PKW(pB0,2),PKW(pB0,4),PKW(pB0,6)};pw1=(u32x4){PKW(pB0,8),PKW(pB0,10),PKW(pB0,12),PKW(pB0,14)};pw2=(u32x4){PKW(pB1,0),PKW(pB1,2),PKW(pB1,4),PKW(pB1,6)};pw3=(u32x4){PKW(pB1,8),PKW(pB1,10),PKW(pB1,12),PKW(pB1,14)};
    SBAR(); pv(o,vb0+sl_cur,PAF(0),PAF(1),PAF(2),PAF(3)); }
  #undef PKW
  #undef PAF
  #undef VFR
  #undef PIN
  #undef GAPA
  #undef GAPB
  #undef EX
  #undef VRD
  #undef KRD
  #undef BRD
  #undef BAD
  #undef STEP
  #undef ENDW
  {auto rr=__builtin_amdgcn_permlane32_swap(__float_as_uint(l_reg),__float_as_uint(l_reg),false,false);l_reg=__uint_as_float(rr[0])+__uint_as_float(rr[1]);}
  if(hi==0)wsf[32+r32]=l_reg;asm volatile("s_waitcnt lgkmcnt(0)":::"memory");
  float rli[16];
  #pragma unroll
  for(int r=0;r<16;++r)rli[r]=__builtin_amdgcn_rcpf(wsf[32+crow(r,hi)]);
  bf16*Ow=O+(rowbase+q0+wid*QBLK)*DM+h*D;
  { bf16*stg=(bf16*)(shm+LDS_OST)+wid*2048;
    #pragma unroll
    for(int r=0;r<16;++r){const int orow=crow(r,hi);
      #pragma unroll
      for(int d0=0;d0<2;++d0)stg[orow*64+d0*32+r32]=__float2bfloat16(o[d0][r]*rli[r]);}
    asm volatile("s_waitcnt lgkmcnt(0)":::"memory");
    #pragma unroll
    for(int i=0;i<4;++i){const int row=i*8+(lane>>3),ch=lane&7; const u32x4 v=*(const u32x4*)(stg+row*64+ch*8); ATTN_STORE16(Ow+(long)row*DM+ch*8,v);} }
  asm volatile("s_waitcnt lgkmcnt(0)\n\ts_barrier":::"memory");
  #undef DMA_K
  #undef DMA_V
  #undef CMASK
  #undef ROT
}
constexpr int ATTN_LDS_BYTES=LDS_BYTES;
#undef SBAR
#undef WAIT_BAR
}
constexpr int NWAVES = 8;
constexpr int BATCH = 2, SEQ = 8192, D = 1024, NH = 16, HD = 64, NMETA = 16, INC = 8208, NE = 32, DE = 512, DEPTH = 2;
constexpr int M = BATCH * SEQ;
constexpr int MROW = M;
constexpr int NTOK = M + NMETA;
constexpr int MP = 16640;
constexpr int SLOTS = 41216;
constexpr float EPS = 1e-6f, LOG2E = 1.4426950408889634f;
constexpr size_t MiB = 1u << 20;
constexpr size_t WS_CTL = 0, CTL_ZERO_BYTES = 1 * MiB;
constexpr size_t WS_FL = 1 * MiB;
constexpr size_t WS_CB = WS_FL + (size_t)MP * 16 * 4;
constexpr size_t WS_CBM = WS_CB + (size_t)32 * SEQ * 4;
constexpr size_t WS_PM = WS_CBM + 1024;
constexpr size_t WS_HNM = WS_PM + (size_t)16 * INC * 4;
constexpr size_t WS_YAINM = WS_HNM + 65536, WS_OM = WS_YAINM + 65536, WS_MGM = WS_OM + 65536;
constexpr size_t WS_RE = WS_MGM + 65536;
constexpr size_t WS_RP = WS_RE + (size_t)MP * 8;
constexpr size_t WS_RW = WS_RP + (size_t)MP * 8;
constexpr size_t WS_LIST = WS_RW + (size_t)MP * 8;
constexpr size_t WS_SMALL_END = WS_LIST + (size_t)NE * MP * 4;
static_assert(WS_SMALL_END <= 16 * MiB, "small buffers");
constexpr size_t WS_WD0 = 16 * MiB, WD_LAYER = 22 * MiB;
constexpr size_t WO_WC = 16 * MiB, WO_WA = 18 * MiB, WO_WM = 20 * MiB;
constexpr size_t WS_WGU = 60 * MiB, WS_WDN = 124 * MiB;
constexpr size_t WS_H = 156 * MiB;
constexpr size_t WS_ACT = 221 * MiB, ACT_STRIDE = (size_t)MP * D * 2;
constexpr size_t WS_XN = WS_ACT, WS_Z = WS_ACT + ACT_STRIDE, WS_BG = WS_ACT + 2 * ACT_STRIDE, WS_Q = WS_ACT + 3 * ACT_STRIDE, WS_K = WS_ACT + 4 * ACT_STRIDE, WS_V = WS_ACT + 5 * ACT_STRIDE,
                 WS_SGA = WS_ACT + 6 * ACT_STRIDE, WS_SGB = WS_ACT + 7 * ACT_STRIDE, WS_YAIN = WS_ACT + 8 * ACT_STRIDE, WS_END = WS_ACT + 9 * ACT_STRIDE;
constexpr size_t WS_MG = WS_Z;
constexpr size_t WS_HACT = WS_BG;
constexpr size_t WS_Y = WS_K;
static_assert(WS_HACT + (size_t)SLOTS * DE * 2 <= WS_K && WS_Y + (size_t)SLOTS * D * 2 <= WS_SGB, "MoE overlays");
constexpr int CW_TMO = 0, CW_CODE = 1, CW_BAR = 4096, CW_CNT = 16384, CW_AQ = 32768;
constexpr int RING_OFF = 0, RING_BYTES = 131072;
constexpr int LDSCTL_OFF = 162816, MISC_OFF = LDSCTL_OFF + 320;
constexpr int LDS_BYTES = 163840;
constexpr int TOFF_OFF = MISC_OFF + 128;
static_assert(TOFF_OFF + 160 <= LDSCTL_OFF + 768 && LDSCTL_OFF + 768 + 19 * 8 <= LDS_BYTES && attn_body::ATTN_LDS_BYTES <= RING_BYTES, "LDS map");

#define GAS __attribute__((address_space(1)))
#define LAS __attribute__((address_space(3)))
typedef unsigned short bf16;
typedef unsigned v4u __attribute__((ext_vector_type(4)));
typedef unsigned v2u __attribute__((ext_vector_type(2)));
typedef float f32x4 __attribute__((ext_vector_type(4)));
typedef GAS unsigned gu32;
#define RLX_AGENT __ATOMIC_RELAXED, __HIP_MEMORY_SCOPE_AGENT
#define LDS_WAIT() asm volatile("s_waitcnt lgkmcnt(0)" ::: "memory")
#define VM_WAIT() asm volatile("s_waitcnt vmcnt(0)" ::: "memory")
__device__ __forceinline__ unsigned f2bf(float f) { unsigned u = __builtin_bit_cast(unsigned, f); return (u + 0x7fffu + ((u >> 16) & 1u)) >> 16; }
__device__ __forceinline__ unsigned pk2(float lo, float hi) { return f2bf(lo) | (f2bf(hi) << 16); }
__device__ __forceinline__ float bflo(unsigned w) { return __uint_as_float(w << 16); }
__device__ __forceinline__ float bfhi(unsigned w) { return __uint_as_float(w & 0xffff0000u); }

#define XB_TMO      128
#define XB_XCNT(j)  (256  + 64 * (j))
#define XB_XSUB(j)  (1280 + 64 * (j))
#define XB_XGEN(j)  (2304 + 64 * (j))
#define XB_TOP      3328
#define XB_TOPGEN   3392
#define XCD_BAR_WORDS 3456
#define XB_SPIN_CAP (1u << 18)
__device__ __forceinline__ unsigned xb_ld(unsigned* p)              { return __hip_atomic_load(p, __ATOMIC_RELAXED, __HIP_MEMORY_SCOPE_AGENT); }
__device__ __forceinline__ unsigned xb_add(unsigned* p, unsigned v) { return __hip_atomic_fetch_add(p, v, __ATOMIC_RELAXED, __HIP_MEMORY_SCOPE_AGENT); }
__device__ __forceinline__ unsigned xb_xcc_id() { return (unsigned)__builtin_amdgcn_s_getreg((3 << 11) | 20) & 0xFu; }
#define XB_SPIN(cond, bar) do { unsigned _sp = 0; while (cond) { __builtin_amdgcn_s_sleep(1); \
    if ((++_sp & 255u) == 0u) { if (xb_ld(&(bar)[XB_TMO])) break; if (_sp > XB_SPIN_CAP) { atomicAdd(&(bar)[XB_TMO], 1u); break; } } } } while (0)
struct XcdBarrier { unsigned* bar; unsigned x; volatile LAS unsigned* st; };
__device__ __forceinline__ XcdBarrier xcd_barrier_post(unsigned* bar, volatile LAS unsigned* st) {
    XcdBarrier b; b.bar = bar; b.x = xb_xcc_id(); b.st = st;
    if (threadIdx.x == 0) (void)xb_add(&bar[XB_XCNT(b.x)], 1u);
    return b;
}
__device__ __forceinline__ void xcd_barrier_complete(unsigned* bar, unsigned x, unsigned& nloc, unsigned& nx) {
    const unsigned G = gridDim.x * gridDim.y * gridDim.z;
    unsigned sum, cnt, mine, sp = 0u;
    for (;;) {
        sum = 0u; cnt = 0u; mine = 0u;
#pragma unroll
        for (unsigned j = 0; j < 16; ++j) { const unsigned c = xb_ld(&bar[XB_XCNT(j)]); sum += c; cnt += (c > 0u) ? 1u : 0u; mine = (j == x) ? c : mine; }
        if (sum == G) break;
        __builtin_amdgcn_s_sleep(1);
        if ((++sp & 255u) == 0u) { if (xb_ld(&bar[XB_TMO])) break; if (sp > XB_SPIN_CAP) { atomicAdd(&bar[XB_TMO], 1u); break; } }
    }
    nloc = mine > 0u ? mine : 1u; nx = cnt > 0u ? cnt : 1u;
}
__device__ __forceinline__ void xcd_barrier(const XcdBarrier& b) {
    asm volatile("s_waitcnt vmcnt(0)" ::: "memory");
    __syncthreads();
    if (threadIdx.x == 0) {
        unsigned* bar = b.bar;
        __builtin_amdgcn_s_waitcnt(0);
        unsigned nloc = b.st[0], nx = b.st[1];
        if (nloc == 0u) { xcd_barrier_complete(bar, b.x, nloc, nx); b.st[0] = nloc; b.st[1] = nx; }
        const unsigned old = xb_add(&bar[XB_XSUB(b.x)], 1u);
        const unsigned gen = old / nloc;
        if (old + 1u == (gen + 1u) * nloc) {
            __builtin_amdgcn_fence(__ATOMIC_RELEASE, "agent");
            asm volatile("s_waitcnt vmcnt(0)" ::: "memory");
            const unsigned og = xb_add(&bar[XB_TOP], 1u);
            const unsigned tg = og / nx;
            if (og + 1u == (tg + 1u) * nx) xb_add(&bar[XB_TOPGEN], 1u);
            else XB_SPIN(xb_ld(&bar[XB_TOPGEN]) == tg, bar);
            __builtin_amdgcn_fence(__ATOMIC_ACQUIRE, "agent");
            xb_add(&bar[XB_XGEN(b.x)], 1u);
            asm volatile("s_waitcnt vmcnt(0)" ::: "memory");
        } else {
            XB_SPIN(xb_ld(&bar[XB_XGEN(b.x)]) == gen, bar);
            __builtin_amdgcn_fence(__ATOMIC_ACQUIRE, "agent");
            asm volatile("s_waitcnt vmcnt(0)" ::: "memory");
        }
    }
    __syncthreads();
}

struct Frame {
    LAS unsigned char* lds; volatile LAS unsigned* MISC; gu32* ctl; unsigned char* ws;
    int tid, lane, wave, vcu, G, gw, NGW;
    float* out;
};
constexpr int INP_OFF = LDSCTL_OFF + 768;
typedef const float GAS* gcf;
__device__ __forceinline__ gcf inp_ld(Frame& F, int i) { const unsigned long long p = *(volatile LAS unsigned long long*)(F.lds + INP_OFF + 8 * i);
    const unsigned lo = __builtin_amdgcn_readfirstlane((unsigned)p), hi = __builtin_amdgcn_readfirstlane((unsigned)(p >> 32)); return (gcf)(((unsigned long long)hi << 32) | lo); }
#define INP(i) inp_ld(F, i)
__device__ __forceinline__ float wave_sum_l(float v, int lane) {
    v = pg8::row16_sum(v); v += pg8::shx(v, 16, lane); v += pg8::shx(v, 32, lane);
    return v;
}
__device__ __forceinline__ float wave_max_l(float v, int lane) {
#pragma unroll
    for (int o = 1; o < 64; o <<= 1) v = fmaxf(v, pg8::shx(v, o, lane));
    return v;
}
#define wave_sum(v) wave_sum_l(v, F.lane)
#define wave_max(v) wave_max_l(v, F.lane)
__device__ __forceinline__ void tr_block(gcf src, int ld, bf16* dst, int Kd, LAS float* scr, int lane) {
    float t[32];
    gcf sp = src + (size_t)(lane >> 5) * ld + (lane & 31);
#pragma unroll
    for (int i = 0; i < 32; ++i) t[i] = sp[(size_t)(2 * i) * ld];
#pragma unroll
    for (int i = 0; i < 32; ++i) scr[(2 * i + (lane >> 5)) * 33 + (lane & 31)] = t[i];
    LDS_WAIT(); asm volatile("" ::: "memory");
    const int c = lane & 7;
#pragma unroll
    for (int j = 0; j < 4; ++j) { const int n = (lane >> 3) + 8 * j; const LAS float* s = scr + (8 * c) * 33 + n;
        v4u o; o.x = pk2(s[0 * 33], s[1 * 33]); o.y = pk2(s[2 * 33], s[3 * 33]); o.z = pk2(s[4 * 33], s[5 * 33]); o.w = pk2(s[6 * 33], s[7 * 33]);
        *(GAS v4u*)(dst + (size_t)n * Kd + 8 * c) = o; }
    LDS_WAIT(); asm volatile("" ::: "memory");
}
__device__ __forceinline__ int win_src_col(int n0) {
    const int pn = n0 >> 8, p = n0 & 255;
    if (pn < 8) return ((p >> 7) ? 2048 : 1024) + 128 * pn + (p & 127);
    if (pn < 12) return 256 * (pn - 8) + p;
    if (pn < 20) return (pn < 16 ? 3072 : 4096) + 256 * (pn & 3) + 64 * ((p >> 5) & 3) + 32 * (p >> 7);
    if (pn < 24) return 5120 + 256 * (pn & 3) + p;
    if (pn < 28) return 6160 + 256 * (pn & 3) + p;
    return 7184 + 256 * (pn & 3) + p;
}
constexpr int IT_WIN = 16 * 256, IT_SQ = 16 * 32, IT_DENSE = IT_WIN + 3 * IT_SQ;
constexpr int IT_GU = 16 * 32, IT_DN = 8 * 32, IT_EXP = IT_GU + IT_DN, IT_EXPL = NE * IT_EXP;
__device__ __forceinline__ void conv_dense_item(Frame& F, int l, int it, LAS float* scr) {
    unsigned char* wl = F.ws + WS_WD0 + (size_t)l * WD_LAYER;
    if (it < IT_WIN) { const int kb = it >> 8, nb = it & 255; tr_block(INP(3) + (size_t)l * D * INC + (size_t)(64 * kb) * INC + win_src_col(32 * nb), INC, (bf16*)wl + (size_t)(32 * nb) * D + 64 * kb, D, scr, F.lane); return; }
    it -= IT_WIN; const int w = it / IT_SQ, r = it % IT_SQ, kb = r >> 5, nb = r & 31;
    const size_t so = (size_t)l * D * D + (size_t)(64 * kb) * D + 32 * nb, dof = (size_t)(32 * nb) * D + 64 * kb;
    if (w == 0) tr_block(INP(6) + so, D, (bf16*)(wl + WO_WC) + dof, D, scr, F.lane);
    else if (w == 1) tr_block(INP(9) + so, D, (bf16*)(wl + WO_WA) + dof, D, scr, F.lane);
    else tr_block(INP(10) + so, D, (bf16*)(wl + WO_WM) + dof, D, scr, F.lane);
}
__device__ __forceinline__ void conv_expert_item(Frame& F, int l, int it, LAS float* scr) {
    const int e = it / IT_EXP; int r = it % IT_EXP;
    if (r < IT_GU) { const int kb = r >> 5, nb = r & 31, n0 = 32 * nb, ct = n0 >> 8, p = n0 & 255;
        const size_t so = ((size_t)l * NE + e) * D * DE + (size_t)(64 * kb) * DE + 128 * ct + (p & 127); bf16* dst = (bf16*)(F.ws + WS_WGU) + (size_t)e * D * D + (size_t)n0 * D + 64 * kb;
        if (p >> 7) tr_block(INP(17) + so, DE, dst, D, scr, F.lane); else tr_block(INP(16) + so, DE, dst, D, scr, F.lane);
        return; }
    r -= IT_GU; const int kb = r >> 5, nb = r & 31;
    tr_block(INP(18) + ((size_t)l * NE + e) * DE * D + (size_t)(64 * kb) * D + 32 * nb, D, (bf16*)(F.ws + WS_WDN) + (size_t)e * D * DE + (size_t)(32 * nb) * DE + 64 * kb, DE, scr, F.lane);
}
__device__ __forceinline__ void build_toff(Frame& F, int l) {
    LAS int* toff = (LAS int*)(F.lds + TOFF_OFF);
    if (F.tid < 64) {
        int t = F.lane < NE ? (((int)__hip_atomic_load(F.ctl + CW_CNT + 64 * (32 * l + F.lane), RLX_AGENT) + 255) >> 8) : 0; const int mine = t;
#pragma unroll
        for (int o = 1; o < 32; o <<= 1) { const int u = __builtin_amdgcn_ds_bpermute(((F.lane - o) & 63) << 2, t); if (F.lane >= o) t += u; }
        if (F.lane < NE) toff[F.lane] = t - mine;
        if (F.lane == NE - 1) toff[NE] = t; }
    __syncthreads();
}
namespace pg8 {
struct SchedDense {
    const char* A; const char* B; int nM, nN, G, c, K;
    __device__ __forceinline__ bool next(int i, Unit& u) const { const int L = i * G + c; if (L >= nM * nN) return false; int pm, pn; tile_of(L, nM, nN, pm, pn); u.pm = pm; u.pn = pn; u.kind = 0; u.aux = 0;
        u.a = A + (size_t)pm * BM * K * 2; u.b = B + (size_t)pn * BM * K * 2; return true; }
    __device__ __forceinline__ void voff(const Unit&, int K_, const int (&R)[2], const int (&C)[2], unsigned (&vo)[2][2]) const {
#pragma unroll
        for (int h = 0; h < 2; ++h)
#pragma unroll
            for (int i = 0; i < 2; ++i) vo[h][i] = (unsigned)((R[i] + HALF * h) * K_ + C[i]) * 2u; }
};
struct SchedPair {
    const char *A0, *B0; long dA, dB; int c, lim;
    __device__ __forceinline__ bool next(int i, Unit& u) const { if (i >= lim) return false; int pm, pn; tile_of(c, 64, 4, pm, pn); u.pm = pm; u.pn = pn; u.kind = i; u.aux = 0;
        u.a = A0 + (i ? dA : 0) + (size_t)pm * BM * 1024 * 2; u.b = B0 + (i ? dB : 0) + (size_t)pn * BM * 1024 * 2; return true; }
    __device__ __forceinline__ void voff(const Unit&, int K_, const int (&R)[2], const int (&C)[2], unsigned (&vo)[2][2]) const {
#pragma unroll
        for (int h = 0; h < 2; ++h)
#pragma unroll
            for (int i = 0; i < 2; ++i) vo[h][i] = (unsigned)((R[i] + HALF * h) * K_ + C[i]) * 2u; }
};
struct SchedMoe {
    const char* A; const char* B; const int* list; const unsigned* cnt; const PG8_LAS int* toff; int G, c, K; size_t bstride; bool gather;
    __device__ __forceinline__ bool next(int i, Unit& u) const {
        const int L = i * G + c, total = __builtin_amdgcn_readfirstlane(toff[32]); if (L >= 4 * total) return false;
        const int rt = L >> 2, ct = L & 3; int e = 0; while (__builtin_amdgcn_readfirstlane(toff[e + 1]) <= rt) ++e;
        u.pm = rt; u.pn = ct; u.kind = e; u.aux = rt - __builtin_amdgcn_readfirstlane(toff[e]);
        u.a = gather ? A : A + (size_t)rt * BM * K * 2; u.b = B + (size_t)e * bstride + (size_t)ct * BM * K * 2; return true; }
    __device__ __forceinline__ void voff(const Unit& u, int K_, const int (&R)[2], const int (&C)[2], unsigned (&vo)[2][2]) const {
        const int n = (int)cnt[64 * u.kind];
#pragma unroll
        for (int h = 0; h < 2; ++h)
#pragma unroll
            for (int i = 0; i < 2; ++i) { int row = R[i] + HALF * h;
                if (gather) { const int r = u.aux * BM + row; row = r < n ? (list[(size_t)u.kind * 16640 + r] >> 1) : 0; }
                vo[h][i] = (unsigned)(row * K_ + C[i]) * 2u; } }
};
}

__device__ __forceinline__ int slot_of(Frame& F, int tok, int k) {
    const LAS int* toff = (const LAS int*)(F.lds + TOFF_OFF);
    const int e = ((const int*)(F.ws + WS_RE))[tok * 2 + k], p = ((const int*)(F.ws + WS_RP))[tok * 2 + k];
    return 256 * toff[e] + p;
}
struct RowRaw { f32x4 h[4]; v2u a[4], b[4]; float w0, w1; };
struct RowMeta { int s0, s1; float w0, w1; };
__device__ __forceinline__ RowMeta row_meta(Frame& F, int l, int nrows) {
    RowMeta m; m.s0 = 0; m.s1 = 0; m.w0 = 0.f; m.w1 = 0.f;
    const int r = F.gw + F.lane * F.NGW;
    if (l > 0 && r < nrows) { m.s0 = slot_of(F, r, 0); m.s1 = slot_of(F, r, 1); m.w0 = ((const float*)(F.ws + WS_RW))[r * 2]; m.w1 = ((const float*)(F.ws + WS_RW))[r * 2 + 1]; }
    return m;
}
__device__ __forceinline__ void row_issue(Frame& F, int l, int row, const RowMeta& m, int i, RowRaw& r) {
    if (l == 0) { gcf src = row >= M ? INP(1) + (size_t)(row - M) * D : INP(0) + (size_t)row * D;
#pragma unroll
        for (int j = 0; j < 4; ++j) { r.h[j] = ((const f32x4 GAS*)src)[F.lane + 64 * j]; r.a[j] = (v2u){0u, 0u}; r.b[j] = (v2u){0u, 0u}; }
        r.w0 = 0.f; r.w1 = 0.f; return; }
    const int s0 = __builtin_amdgcn_readlane(m.s0, i), s1 = __builtin_amdgcn_readlane(m.s1, i);
    r.w0 = __int_as_float(__builtin_amdgcn_readlane(__float_as_int(m.w0), i)); r.w1 = __int_as_float(__builtin_amdgcn_readlane(__float_as_int(m.w1), i));
    const float* hr = (const float*)(F.ws + WS_H) + (size_t)row * D;
    const bf16* y0 = (const bf16*)(F.ws + WS_Y) + (size_t)s0 * D; const bf16* y1 = (const bf16*)(F.ws + WS_Y) + (size_t)s1 * D;
#pragma unroll
    for (int j = 0; j < 4; ++j) { r.h[j] = ((const f32x4*)hr)[F.lane + 64 * j]; r.a[j] = ((const v2u*)y0)[F.lane + 64 * j]; r.b[j] = ((const v2u*)y1)[F.lane + 64 * j]; }
}
__device__ __forceinline__ void row_combine(const RowRaw& r, f32x4 (&v)[4]) {
#pragma unroll
    for (int j = 0; j < 4; ++j) v[j] = r.h[j] + r.w0 * (f32x4){bflo(r.a[j].x), bfhi(r.a[j].x), bflo(r.a[j].y), bfhi(r.a[j].y)} + r.w1 * (f32x4){bflo(r.b[j].x), bfhi(r.b[j].x), bflo(r.b[j].y), bfhi(r.b[j].y)};
}
__device__ __forceinline__ void phase_t1(Frame& F, int l) {
    LAS float* wf = (LAS float*)(F.lds);
    { gcf win = INP(3) + (size_t)l * D * INC + 6144;
      float t[32];
#pragma unroll
      for (int u = 0; u < 32; ++u) { const int i = F.tid + u * (NWAVES * 64); t[u] = win[(size_t)(i >> 4) * INC + (i & 15)]; }
#pragma unroll
      for (int u = 0; u < 32; ++u) wf[(F.tid & 15) * D + (F.tid >> 4) + 32 * u] = t[u]; }
    if (l > 0) build_toff(F, l - 1); else __syncthreads();
    gcf g1 = INP(2) + (size_t)l * D; gcf bfg = INP(4) + l * 16;
    float* H = (float*)(F.ws + WS_H); bf16* XN = (bf16*)(F.ws + WS_XN); float* FL = (float*)(F.ws + WS_FL); float* HNM = (float*)(F.ws + WS_HNM);
#ifndef REP_ROWS
#define REP_ROWS 0
#endif
    for (int rr_ = (l == 0 ? REP_ROWS : 0); rr_ >= 0; --rr_)
    { const RowMeta meta = row_meta(F, l, NTOK); const int nr = (NTOK - F.gw + F.NGW - 1) / F.NGW; RowRaw cur; row_issue(F, l, F.gw, meta, 0, cur);
    for (int ri = 0; ri < nr; ++ri) { const int row = F.gw + ri * F.NGW;
        RowRaw nxt = cur; if (ri + 1 < nr) row_issue(F, l, row + F.NGW, meta, ri + 1, nxt);
        f32x4 v[4]; row_combine(cur, v); cur = nxt;
        float ss = 0.f;
#pragma unroll
        for (int j = 0; j < 4; ++j) { ((f32x4*)(H + (size_t)row * D))[F.lane + 64 * j] = v[j]; ss += (v[j].x * v[j].x + v[j].y * v[j].y) + (v[j].z * v[j].z + v[j].w * v[j].w); }
        const float rstd = __builtin_amdgcn_rsqf(wave_sum(ss) * (1.f / D) + EPS);
#pragma unroll
        for (int j = 0; j < 4; ++j) { v[j] = v[j] * rstd * ((const f32x4 GAS*)g1)[F.lane + 64 * j];
            v2u o; o.x = pk2(v[j].x, v[j].y); o.y = pk2(v[j].z, v[j].w); ((v2u*)(XN + (size_t)row * D))[F.lane + 64 * j] = o;
            if (row >= M) ((f32x4*)(HNM + (size_t)(row - M) * D))[F.lane + 64 * j] = v[j]; }
        float mine = 0.f;
#pragma unroll 1
        for (int jg = 0; jg < 16; jg += 4) { float s4[4];
#pragma unroll
            for (int q = 0; q < 4; ++q) { float s = 0.f;
#pragma unroll
                for (int j = 0; j < 4; ++j) { const f32x4 w = *(const LAS f32x4*)(wf + (jg + q) * D + 4 * F.lane + 256 * j); s += (v[j].x * w.x + v[j].y * w.y) + (v[j].z * w.z + v[j].w * w.w); }
                s4[q] = s; }
#pragma unroll
            for (int q = 0; q < 4; ++q) s4[q] = pg8::row16_sum(s4[q]);
#pragma unroll
            for (int o = 16; o < 64; o <<= 1) {
#pragma unroll
                for (int q = 0; q < 4; ++q) s4[q] += pg8::shx(s4[q], o, F.lane); }
#pragma unroll
            for (int q = 0; q < 4; ++q) mine = (F.lane == jg + q) ? s4[q] : mine; }
        if (F.lane < 16) { const float f = mine + bfg[F.lane]; FL[(size_t)row * 16 + F.lane] = fminf(f, 0.f) * LOG2E - __builtin_amdgcn_logf(1.0f + __builtin_amdgcn_exp2f(-fabsf(f) * LOG2E)); }
    } }
    LAS float* scr = (LAS float*)(F.lds + 65536 + F.wave * 8448);
#ifndef REP_CONV
#define REP_CONV 0
#endif
    for (int rc = 0; rc <= REP_CONV; ++rc) {
    if (l == 0) {
        for (int it = F.gw; it < 2 * IT_DENSE; it += F.NGW) conv_dense_item(F, it / IT_DENSE, it % IT_DENSE, scr);
    }
    for (int it = F.gw; it < IT_EXPL; it += F.NGW) conv_expert_item(F, l, it, scr);
    }
}
__device__ __forceinline__ LAS float* meta_slice(Frame& F, const float* A, gcf W, int ld, int col0, int slot) {
    LAS float* Al = (LAS float*)F.lds; LAS float* red = (LAS float*)(F.lds + 65536); LAS float* out = (LAS float*)(F.lds + 98304 + 4096 * slot);
    __syncthreads();
    { float t[32];
#pragma unroll
      for (int u = 0; u < 32; ++u) t[u] = A[F.tid + u * (NWAVES * 64)];
#pragma unroll
      for (int u = 0; u < 32; ++u) Al[(F.tid + 512 * (u & 1)) * 16 + (u >> 1)] = t[u]; }
    __syncthreads();
    float acc[16];
#pragma unroll
    for (int r = 0; r < 16; ++r) acc[r] = 0.f;
    gcf wp = W + col0 + F.lane; const int k0 = F.wave * 128;
#pragma unroll 1
    for (int kb = k0; kb < k0 + 128; kb += 32) { float w[32];
#pragma unroll
        for (int u = 0; u < 32; ++u) w[u] = wp[(size_t)(kb + u) * ld];
#pragma unroll
        for (int u = 0; u < 32; ++u) {
#pragma unroll
            for (int q = 0; q < 4; ++q) { const f32x4 a = *(const LAS f32x4*)(Al + (kb + u) * 16 + 4 * q); acc[4 * q] += a.x * w[u]; acc[4 * q + 1] += a.y * w[u]; acc[4 * q + 2] += a.z * w[u]; acc[4 * q + 3] += a.w * w[u]; } } }
#pragma unroll
    for (int r = 0; r < 16; ++r) red[(F.wave * 16 + r) * 64 + F.lane] = acc[r];
    __syncthreads();
#pragma unroll
    for (int q = 0; q < 2; ++q) { const int o = F.tid * 2 + q; float s = 0.f;
#pragma unroll
        for (int g = 0; g < 8; ++g) s += red[g * 1024 + o];
        out[o] = s; }
    __syncthreads();
    return out;
}
__device__ __forceinline__ void g1_side(Frame& F, int l) {
    const float* FL = (const float*)(F.ws + WS_FL);
    int c = (int)blockIdx.x - 128;
    if (c >= 0 && c < 32) {
        const int b = c >> 4, h = c & 15; LAS float* wsum = (LAS float*)(F.lds);
        float x[16]; float run = 0.f;
#pragma unroll
        for (int i = 0; i < 16; ++i) { run += FL[((size_t)b * SEQ + F.tid * 16 + i) * 16 + h]; x[i] = run; }
        float inc = run;
#pragma unroll
        for (int o = 1; o < 64; o <<= 1) { const float t = __int_as_float(__builtin_amdgcn_ds_bpermute(((F.lane - o) & 63) << 2, __float_as_int(inc))); if (F.lane >= o) inc += t; }
        if (F.lane == 63) wsum[F.wave] = inc;
        __syncthreads();
        float base = inc - run;
        for (int w = 0; w < F.wave; ++w) base += wsum[w];
        float* CB = (float*)(F.ws + WS_CB) + (size_t)c * SEQ + F.tid * 16;
#pragma unroll
        for (int i = 0; i < 16; ++i) CB[i] = base + x[i];
        if (c < 16 && F.tid == 0) { float cm[16]; float r2 = 0.f;
#pragma unroll
            for (int j = 0; j < 16; ++j) { r2 += FL[(size_t)(MROW + j) * 16 + c]; cm[j] = r2; }
#pragma unroll
            for (int j = 0; j < 16; ++j) ((float*)(F.ws + WS_CBM))[c * 16 + j] = cm[j] - r2; }
        __syncthreads();
    }
    c = (int)blockIdx.x;
    if (c < 128) {
        const int col0 = c < 96 ? 64 * c : 6160 + 64 * (c - 96);
        LAS float* out = meta_slice(F, (const float*)(F.ws + WS_HNM), INP(3) + (size_t)l * D * INC, INC, col0, 0);
        float* PM = (float*)(F.ws + WS_PM);
#pragma unroll
        for (int rr = 0; rr < 2; ++rr) { const int r = 2 * F.wave + rr; float v = out[r * 64 + F.lane];
            if (col0 >= 3072 && col0 < 5120) { const float ss = wave_sum(v * v); const float g = (col0 < 4096 ? INP(7) : INP(8))[l * 64 + F.lane]; v = v * __builtin_amdgcn_rsqf(ss * (1.f / 64.f) + EPS) * g; }
            if (col0 >= 6160) v = pg8::sigmoidf_fast(v);
            PM[(size_t)r * INC + col0 + F.lane] = v;
            if (col0 >= 4096 && col0 < 5120) ((bf16*)(F.ws + WS_K))[(size_t)(MROW + r) * D + (col0 - 4096) + F.lane] = (bf16)f2bf(v);
            if (col0 >= 5120 && col0 < 6144) ((bf16*)(F.ws + WS_V))[(size_t)(MROW + r) * D + (col0 - 5120) + F.lane] = (bf16)f2bf(v); }
        __syncthreads();
    }
}
__device__ __forceinline__ void a1_side(Frame& F, int l) {
    gcf cw = INP(5) + (size_t)l * 3 * D; const float* PM = (const float*)(F.ws + WS_PM);
    const bf16* Z = (const bf16*)(F.ws + WS_Z); const bf16* BG = (const bf16*)(F.ws + WS_BG); bf16* YAIN = (bf16*)(F.ws + WS_YAIN);
    for (int ci = F.gw; ci < M / 8; ci += F.NGW) {
        const int m0 = ci * 8, t0 = m0 & (SEQ - 1);
#pragma unroll
        for (int j = 0; j < 2; ++j) { const int d0 = 8 * F.lane + 512 * j;
            float w0[8], w1[8], w2[8], zp2[8], zp1[8];
#pragma unroll
            for (int i = 0; i < 8; ++i) { w0[i] = cw[d0 + i]; w1[i] = cw[D + d0 + i]; w2[i] = cw[2 * D + d0 + i]; }
            if (t0 == 0) {
#pragma unroll
                for (int i = 0; i < 8; ++i) { zp2[i] = PM[(size_t)14 * INC + 1024 + d0 + i] * PM[(size_t)14 * INC + 2048 + d0 + i]; zp1[i] = PM[(size_t)15 * INC + 1024 + d0 + i] * PM[(size_t)15 * INC + 2048 + d0 + i]; }
            } else { const v4u a = *(const v4u*)(Z + (size_t)(m0 - 2) * D + d0), b = *(const v4u*)(Z + (size_t)(m0 - 1) * D + d0);
                zp2[0] = bflo(a.x); zp2[1] = bfhi(a.x); zp2[2] = bflo(a.y); zp2[3] = bfhi(a.y); zp2[4] = bflo(a.z); zp2[5] = bfhi(a.z); zp2[6] = bflo(a.w); zp2[7] = bfhi(a.w);
                zp1[0] = bflo(b.x); zp1[1] = bfhi(b.x); zp1[2] = bflo(b.y); zp1[3] = bfhi(b.y); zp1[4] = bflo(b.z); zp1[5] = bfhi(b.z); zp1[6] = bflo(b.w); zp1[7] = bfhi(b.w); }
            v4u zr[8], gr[8];
#pragma unroll
            for (int r = 0; r < 8; ++r) { zr[r] = *(const v4u*)(Z + (size_t)(m0 + r) * D + d0); gr[r] = *(const v4u*)(BG + (size_t)(m0 + r) * D + d0); }
#pragma unroll
            for (int r = 0; r < 8; ++r) { const v4u zz = zr[r], gg = gr[r];
                float z[8], g[8], y[8];
                z[0] = bflo(zz.x); z[1] = bfhi(zz.x); z[2] = bflo(zz.y); z[3] = bfhi(zz.y); z[4] = bflo(zz.z); z[5] = bfhi(zz.z); z[6] = bflo(zz.w); z[7] = bfhi(zz.w);
                g[0] = bflo(gg.x); g[1] = bfhi(gg.x); g[2] = bflo(gg.y); g[3] = bfhi(gg.y); g[4] = bflo(gg.z); g[5] = bfhi(gg.z); g[6] = bflo(gg.w); g[7] = bfhi(gg.w);
#pragma unroll
                for (int i = 0; i < 8; ++i) { y[i] = g[i] * (w0[i] * zp2[i] + w1[i] * zp1[i] + w2[i] * z[i]); zp2[i] = zp1[i]; zp1[i] = z[i]; }
                v4u o; o.x = pk2(y[0], y[1]); o.y = pk2(y[2], y[3]); o.z = pk2(y[4], y[5]); o.w = pk2(y[6], y[7]);
                *(GAS v4u*)(YAIN + (size_t)(m0 + r) * D + d0) = o; }
        }
    }
}
__device__ __forceinline__ void g2_side(Frame& F, int l) {
    if (blockIdx.x >= 16) return;
    const int col0 = 64 * blockIdx.x; const float* PM = (const float*)(F.ws + WS_PM);
    LAS float* ya = meta_slice(F, (const float*)(F.ws + WS_YAINM), INP(6) + (size_t)l * D * D, D, col0, 0);
    LAS float* yb = meta_slice(F, (const float*)(F.ws + WS_OM), INP(9) + (size_t)l * D * D, D, col0, 1);
#pragma unroll
    for (int q = 0; q < 2; ++q) { const int o = F.tid * 2 + q, r = o >> 6, cc = o & 63;
        ((float*)(F.ws + WS_MGM))[(size_t)r * D + col0 + cc] = PM[(size_t)r * INC + 6160 + col0 + cc] * ya[o] + PM[(size_t)r * INC + 7184 + col0 + cc] * yb[o]; }
    __syncthreads();
}
__device__ __forceinline__ void g3_side(Frame& F, int l) {
    if (blockIdx.x >= 16) return;
    const int col0 = 64 * blockIdx.x;
    LAS float* y = meta_slice(F, (const float*)(F.ws + WS_MGM), INP(10) + (size_t)l * D * D, D, col0, 0);
#pragma unroll
    for (int q = 0; q < 2; ++q) { const int o = F.tid * 2 + q, r = o >> 6, cc = o & 63; ((float*)(F.ws + WS_H))[(size_t)(MROW + r) * D + col0 + cc] += y[o]; }
    __syncthreads();
}
__device__ __forceinline__ void phase_t2(Frame& F, int l, int bank, size_t dump) {
    LAS float* wr = (LAS float*)F.lds;
    { gcf wg = INP(12) + (size_t)l * D * 4; gcf we = INP(14) + (size_t)l * D * NE;
#pragma unroll 1
      for (int b0 = 0; b0 < 64; b0 += 16) { float t[16];
#pragma unroll
          for (int u = 0; u < 16; ++u) t[u] = we[F.tid + (b0 + u) * (NWAVES * 64)];
#pragma unroll
          for (int u = 0; u < 16; ++u) wr[((F.tid >> 5) + 16 * (b0 + u)) * 36 + 4 + (F.tid & 31)] = t[u]; }
      { float t[8];
#pragma unroll
          for (int u = 0; u < 8; ++u) t[u] = wg[F.tid + u * (NWAVES * 64)];
#pragma unroll
          for (int u = 0; u < 8; ++u) wr[((F.tid >> 2) + 128 * u) * 36 + (F.tid & 3)] = t[u]; } }
    LAS int* lcnt = (LAS int*)(F.lds + 147456); LAS int* lbase = lcnt + 32; LAS int* rec = lbase + 32; LAS float* recw = (LAS float*)(rec + 80 * 4);
    if (F.tid < 32) lcnt[F.tid] = 0;
    __syncthreads();
    gcf g2 = INP(11) + (size_t)l * D; gcf bg = INP(13) + l * 4; gcf be = INP(15) + l * NE;
    const float* H = (const float*)(F.ws + WS_H); bf16* XN = (bf16*)(F.ws + WS_XN);
    const int c = blockIdx.x, npair = (c < 16 && F.wave == 0) ? 5 : 4;
    float g2r[16];
#pragma unroll
    for (int jj = 0; jj < 16; ++jj) g2r[jj] = g2[F.lane + 64 * jj];
    for (int it = 0; it < npair; ++it) {
        int sl[2], row[2];
        if (it < 4) { sl[0] = 8 * F.wave + 2 * it; sl[1] = sl[0] + 1; row[0] = 64 * c + sl[0]; row[1] = row[0] + 1; } else { sl[0] = 64; sl[1] = 64; row[0] = MROW + c; row[1] = MROW + c; }
        float hn[2][16], ss[2] = {0.f, 0.f};
#pragma unroll
        for (int r = 0; r < 2; ++r)
#pragma unroll
            for (int jj = 0; jj < 16; ++jj) { hn[r][jj] = H[(size_t)row[r] * D + F.lane + 64 * jj]; ss[r] += hn[r][jj] * hn[r][jj]; }
        ss[0] = pg8::row16_sum(ss[0]); ss[1] = pg8::row16_sum(ss[1]);
#pragma unroll
        for (int o = 16; o < 64; o <<= 1) { const float t0 = pg8::shx(ss[0], o, F.lane), t1 = pg8::shx(ss[1], o, F.lane); ss[0] += t0; ss[1] += t1; }
        float acc[2][36];
#pragma unroll
        for (int r = 0; r < 2; ++r) { const float rstd = __builtin_amdgcn_rsqf(ss[r] * (1.f / D) + EPS);
#pragma unroll
            for (int jj = 0; jj < 16; ++jj) { hn[r][jj] = hn[r][jj] * rstd * g2r[jj]; XN[(size_t)row[r] * D + F.lane + 64 * jj] = (bf16)f2bf(hn[r][jj]); }
#pragma unroll
            for (int q = 0; q < 36; ++q) acc[r][q] = 0.f; }
        { f32x4 wn[9];
#pragma unroll
          for (int q = 0; q < 9; ++q) wn[q] = *(const LAS f32x4*)(wr + F.lane * 36 + 4 * q);
#pragma unroll
          for (int jj = 0; jj < 16; ++jj) { f32x4 w[9];
#pragma unroll
            for (int q = 0; q < 9; ++q) w[q] = wn[q];
            if (jj < 15) {
#pragma unroll
                for (int q = 0; q < 9; ++q) wn[q] = *(const LAS f32x4*)(wr + (F.lane + 64 * (jj + 1)) * 36 + 4 * q); }
#pragma unroll
            for (int r = 0; r < 2; ++r)
#pragma unroll
                for (int q = 0; q < 9; ++q) { acc[r][4 * q] += hn[r][jj] * w[q].x; acc[r][4 * q + 1] += hn[r][jj] * w[q].y; acc[r][4 * q + 2] += hn[r][jj] * w[q].z; acc[r][4 * q + 3] += hn[r][jj] * w[q].w; }
            asm volatile("" ::: "memory"); } }
#pragma unroll
        for (int r = 0; r < 2; ++r)
#pragma unroll
            for (int q = 0; q < 36; ++q) acc[r][q] = pg8::row16_sum(acc[r][q]);
#pragma unroll
        for (int o = 16; o < 64; o <<= 1) {
            float t[2][36];
#pragma unroll
            for (int r = 0; r < 2; ++r)
#pragma unroll
                for (int q = 0; q < 36; ++q) t[r][q] = pg8::shx(acc[r][q], o, F.lane);
#pragma unroll
            for (int r = 0; r < 2; ++r)
#pragma unroll
                for (int q = 0; q < 36; ++q) acc[r][q] += t[r][q]; }
#pragma unroll
        for (int r = 0; r < 2; ++r) {
            if (r == 1 && it == 4) break;
            float gl[4]; int gi = 0;
#pragma unroll
            for (int j = 0; j < 4; ++j) gl[j] = acc[r][j] + bg[j];
            float gb = gl[0];
#pragma unroll
            for (int j = 1; j < 4; ++j) if (gl[j] > gb) { gb = gl[j]; gi = j; }
            float gs = 0.f;
#pragma unroll
            for (int j = 0; j < 4; ++j) gs += __builtin_amdgcn_exp2f((gl[j] - gb) * LOG2E);
            const float gw = 1.f / gs;
            float el[8];
#pragma unroll
            for (int j = 0; j < 8; ++j) el[j] = (gi == 0 ? acc[r][4 + j] : gi == 1 ? acc[r][12 + j] : gi == 2 ? acc[r][20 + j] : acc[r][28 + j]) + be[gi * 8 + j];
            int i1 = 0; float b1 = el[0];
#pragma unroll
            for (int j = 1; j < 8; ++j) if (el[j] > b1) { b1 = el[j]; i1 = j; }
            int i2 = -1; float b2 = -INFINITY;
#pragma unroll
            for (int j = 0; j < 8; ++j) if (j != i1 && (i2 < 0 || el[j] > b2)) { b2 = el[j]; i2 = j; }
            const float p2 = __builtin_amdgcn_exp2f((b2 - b1) * LOG2E), w1 = gw / (1.f + p2), w2 = gw * p2 / (1.f + p2);
            if (F.lane == 0) { const int e1 = gi * 8 + i1, e2 = gi * 8 + i2, s_ = sl[r];
                rec[s_ * 4 + 0] = e1; rec[s_ * 4 + 1] = __hip_atomic_fetch_add(lcnt + e1, 1, __ATOMIC_RELAXED, __HIP_MEMORY_SCOPE_WORKGROUP);
                rec[s_ * 4 + 2] = e2; rec[s_ * 4 + 3] = __hip_atomic_fetch_add(lcnt + e2, 1, __ATOMIC_RELAXED, __HIP_MEMORY_SCOPE_WORKGROUP);
                recw[s_ * 2] = w1; recw[s_ * 2 + 1] = w2; }
        }
    }
    __syncthreads();
    if (F.tid < 32) { const int n = lcnt[F.tid]; lbase[F.tid] = n ? (int)__hip_atomic_fetch_add(F.ctl + CW_CNT + 64 * (32 * bank + F.tid), (unsigned)n, RLX_AGENT) : 0; }
    __syncthreads();
    if (F.tid < 65 && (F.tid < 64 || c < 16)) { const int sl = F.tid, tok = sl < 64 ? 64 * c + sl : MROW + c;
#pragma unroll
        for (int k = 0; k < 2; ++k) { const int e = rec[sl * 4 + 2 * k], pos = lbase[e] + rec[sl * 4 + 2 * k + 1];
            ((int*)(F.ws + dump + WS_LIST))[(size_t)e * MP + pos] = 2 * tok + k; ((int*)(F.ws + dump + WS_RE))[2 * tok + k] = e; ((int*)(F.ws + dump + WS_RP))[2 * tok + k] = pos; ((float*)(F.ws + dump + WS_RW))[2 * tok + k] = recw[sl * 2 + k]; } }
}
__device__ __forceinline__ void a1_meta(Frame& F, int l) {
    if (blockIdx.x >= 16) return;
    const int h = blockIdx.x; gcf cw = INP(5) + (size_t)l * 3 * D; const float* PM = (const float*)(F.ws + WS_PM);
    float* YAINM = (float*)(F.ws + WS_YAINM); float* OM = (float*)(F.ws + WS_OM); const float* CBM = (const float*)(F.ws + WS_CBM);
#pragma unroll
    for (int q2 = 0; q2 < 2; ++q2) { const int o = F.tid * 2 + q2, r = o >> 6, d = 64 * h + (o & 63); float y = 0.f;
#pragma unroll
        for (int q = 0; q < 3; ++q) { const int rr = r - 2 + q; if (rr >= 0) y += PM[(size_t)rr * INC + 1024 + d] * PM[(size_t)rr * INC + 2048 + d] * cw[q * D + d]; }
        YAINM[(size_t)r * D + d] = PM[(size_t)r * INC + d] * y; }
    LAS float* sc = (LAS float*)F.lds;
    __syncthreads();
    if (F.tid < 256) { const int r = F.tid >> 4, s = F.tid & 15; const f32x4* q = (const f32x4*)(PM + (size_t)r * INC + 3072 + 64 * h); const f32x4* k = (const f32x4*)(PM + (size_t)s * INC + 4096 + 64 * h); float dsum = 0.f;
#pragma unroll
        for (int d = 0; d < 16; ++d) { const f32x4 a = q[d], b = k[d]; dsum += (a.x * b.x + a.y * b.y) + (a.z * b.z + a.w * b.w); }
        sc[F.tid] = (s <= r) ? dsum * attn_body::C2 + (CBM[h * 16 + r] - CBM[h * 16 + s]) : -INFINITY; }
    __syncthreads();
    if (F.tid < 16) { float mx = -INFINITY, ls = 0.f;
#pragma unroll
        for (int s = 0; s < 16; ++s) mx = fmaxf(mx, sc[F.tid * 16 + s]);
        float p[16];
#pragma unroll
        for (int s = 0; s < 16; ++s) { p[s] = __builtin_amdgcn_exp2f(sc[F.tid * 16 + s] - mx); ls += p[s]; }
        const float il = 1.f / ls;
#pragma unroll
        for (int s = 0; s < 16; ++s) sc[F.tid * 16 + s] = p[s] * il; }
    __syncthreads();
#pragma unroll
    for (int q2 = 0; q2 < 2; ++q2) { const int o = F.tid * 2 + q2, r = o >> 6, d = o & 63; float acc = 0.f;
#pragma unroll
        for (int s = 0; s < 16; ++s) acc += sc[r * 16 + s] * PM[(size_t)s * INC + 5120 + 64 * h + d];
        OM[(size_t)r * D + 64 * h + d] = acc; }
    __syncthreads();
}
__device__ __forceinline__ void phase_attn(Frame& F, int l, int qbank, char* lds_generic) {
    const float mq = wave_max(fabsf(INP(7)[l * 64 + F.lane])), mk = wave_max(fabsf(INP(8)[l * 64 + F.lane]));
    const float m0 = 8.f * LOG2E * mq * mk * 1.02f + 0.25f;
    const float TH = 2.f * m0 + 40.f;
    const attn_body::bf16* Q = (const attn_body::bf16*)(F.ws + WS_Q); const attn_body::bf16* K = (const attn_body::bf16*)(F.ws + WS_K); const attn_body::bf16* V = (const attn_body::bf16*)(F.ws + WS_V);
    volatile LAS int* qslot = (volatile LAS int*)(F.lds + LDSCTL_OFF + 640);
    gu32* qhead = F.ctl + CW_AQ + 64 * qbank;
    if (F.tid == 0) *qslot = (int)__hip_atomic_fetch_add(qhead, 1u, RLX_AGENT);
    __syncthreads();
    int p = __builtin_amdgcn_readfirstlane(*qslot);
    while (p < 1024) {
        int pnext = 0; if (F.tid == 0) pnext = (int)__hip_atomic_fetch_add(qhead, 1u, RLX_AGENT);
        const int qb = 31 - (p >> 5), bh = p & 31; const float* cbh = (const float*)(F.ws + WS_CB) + (size_t)bh * SEQ;
        attn_body::attn_unit(F.tid, bh >> 4, bh & 15, qb, TH, Q, K, V, (attn_body::bf16*)(F.ws + WS_XN), cbh, (const float*)(F.ws + WS_CBM) + (bh & 15) * 16, m0, lds_generic);
        if (F.tid == 0) *qslot = pnext;
        asm volatile("s_waitcnt vmcnt(0) lgkmcnt(0)\n\ts_barrier" ::: "memory");
        p = __builtin_amdgcn_readfirstlane(*qslot);
    }
}
__device__ __forceinline__ void phase_out(Frame& F) {
    build_toff(F, 1);
#ifdef PROBE_PH
    const float pscale = 1.0f + 0.1f * rintf((float)(unsigned)(__hip_atomic_load((GAS unsigned long long*)(F.ctl + 32) + (PROBE_PH + 1), RLX_AGENT) - __hip_atomic_load((GAS unsigned long long*)(F.ctl + 32) + PROBE_PH, RLX_AGENT)) * (1.0f / (100.0f * PROBE_DIV)));
#else
    const float pscale = 1.0f;
#endif
    { const RowMeta meta = row_meta(F, 1, M); const int nr = (M - F.gw + F.NGW - 1) / F.NGW; RowRaw cur; row_issue(F, 1, F.gw, meta, 0, cur);
    for (int ri = 0; ri < nr; ++ri) { const int row = F.gw + ri * F.NGW;
        RowRaw nxt = cur; if (ri + 1 < nr) row_issue(F, 1, row + F.NGW, meta, ri + 1, nxt);
        f32x4 v[4]; row_combine(cur, v); cur = nxt;
#pragma unroll
        for (int j = 0; j < 4; ++j) ((f32x4*)(F.out + (size_t)row * D))[F.lane + 64 * j] = v[j] * pscale; } }
}

#ifndef MK_N_LAUNCHES
#define MK_N_LAUNCHES 1
#endif
constexpr int N_PHASES = 17;
struct Args { const float* in[19]; float* out; unsigned char* ws; int ph_lo, ph_hi, li, two; };
__global__ void __launch_bounds__(NWAVES * 64, 2) fwd_kernel(Args args) {
    extern __shared__ __attribute__((aligned(16))) unsigned char lds[];
    Frame F;
    F.lds = (LAS unsigned char*)lds; F.MISC = (volatile LAS unsigned*)(F.lds + MISC_OFF);
    F.tid = threadIdx.x; F.lane = F.tid & 63; F.wave = __builtin_amdgcn_readfirstlane(F.tid >> 6);
    F.G = gridDim.x; { const int bx = blockIdx.x; F.vcu = (F.G % 8 == 0) ? (bx % 8) * (F.G / 8) + bx / 8 : bx; }
    F.gw = F.vcu * NWAVES + F.wave; F.NGW = F.G * NWAVES;
    F.ws = args.ws; F.ctl = (gu32*)(args.ws + WS_CTL); F.out = args.out;
    for (int u = F.tid; u < (LDS_BYTES - LDSCTL_OFF) / 4; u += NWAVES * 64) ((LAS unsigned*)(F.lds + LDSCTL_OFF))[u] = 0u;
    __syncthreads();
    if (F.tid == 0) {
#pragma unroll
        for (int i = 0; i < 19; ++i) *(LAS unsigned long long*)(F.lds + INP_OFF + 8 * i) = (unsigned long long)args.in[i]; }
    __syncthreads();
    XcdBarrier bar = xcd_barrier_post((unsigned*)(F.ctl + CW_BAR) + args.li * XCD_BAR_WORDS, F.MISC + 8);
#ifdef PROBE_PH
    if (blockIdx.x == 0 && F.tid == 0) __hip_atomic_store((GAS unsigned long long*)(F.ctl + 32), __builtin_amdgcn_s_memrealtime(), RLX_AGENT);
#endif
    const int lo = args.ph_lo, hi = args.ph_hi; int ph = 0; const int wave_s = F.wave;
#ifndef REP_PH
#define REP_PH (-1)
#endif
#ifndef REP_N
#define REP_N 0
#endif
#ifndef SUBMASK
#define SUBMASK 7
#endif
#ifndef PHMASK
#define PHMASK 0x1ff
#endif
#define PHB(k) if (((PHMASK >> (k)) & 1) && lo <= ph && ph < hi) { for (int rep_ = (ph == REP_PH ? REP_N : 0); rep_ >= 0; --rep_) { { int ot_; asm volatile("v_mbcnt_lo_u32_b32 %0, -1, 0\n\tv_mbcnt_hi_u32_b32 %0, -1, %0" : "=v"(ot_)); ot_ += wave_s * 64; F.tid = ot_; F.lane = ot_ & 63; F.wave = __builtin_amdgcn_readfirstlane(ot_ >> 6); F.gw = F.vcu * NWAVES + F.wave; size_t z_ = 0; asm volatile("" : "+s"(z_)); F.ws = args.ws + z_; F.ctl = (gu32*)(F.ws + WS_CTL); }
#ifdef PROBE_PH
#define PH_STAMP() do { if (blockIdx.x == 0 && F.tid == 0) __hip_atomic_store((GAS unsigned long long*)(F.ctl + 32) + (ph + 1), __builtin_amdgcn_s_memrealtime(), RLX_AGENT); } while (0)
#else
#define PH_STAMP() do {} while (0)
#endif
#ifndef REP_BAR
#define REP_BAR 0
#endif
#define PH_END   } if (ph + 1 < hi) xcd_barrier(bar); if (REP_BAR > 0 && ph == 3) { for (int rb_ = 0; rb_ < REP_BAR; ++rb_) xcd_barrier(bar); } PH_STAMP(); } ++ph;
    if (lo == 0) {
        for (int i = F.gw * 64 + F.lane; i < 2 * 64 * D / 8; i += F.NGW * 64) { const int wbuf = i / (64 * D / 8), r = i % (64 * D / 8);
            ((GAS v4u*)(F.ws + (wbuf ? WS_V : WS_K) + (size_t)MROW * D * 2))[r] = (v4u){0u, 0u, 0u, 0u}; } }
    for (int l = 0; l < DEPTH; ++l) {
        unsigned char* wl = F.ws + WS_WD0 + (size_t)l * WD_LAYER;
        PHB(0) phase_t1(F, l); PH_END
        PHB(1) if (SUBMASK & 1) g1_side(F, l); if (SUBMASK & 2)
            { pg8::SchedDense S{(const char*)(F.ws + WS_XN), (const char*)wl, 64, 32, F.G, (int)blockIdx.x, D};
              pg8::EpiG1 E{(bf16*)(F.ws + WS_ACT), ACT_STRIDE / 2, INP(7) + l * 64, attn_body::C2, (long)(INP(8) - INP(7))};
              pg8::gemm_phase<pg8::EpiG1, pg8::SchedDense, true>(F.tid, F.lds + RING_OFF, D, S, E); }
        PH_END
        PHB(2) if (SUBMASK & 1) a1_side(F, l); if (SUBMASK & 2) a1_meta(F, l); if (SUBMASK & 4) phase_attn(F, l, l + 2 * rep_, (char*)lds + RING_OFF); PH_END
        PHB(3) if (SUBMASK & 1) g2_side(F, l); if (SUBMASK & 2)
            { pg8::SchedPair S{(const char*)(F.ws + WS_YAIN), (const char*)(wl + WO_WC), (long)WS_XN - (long)WS_YAIN, (long)WO_WA - (long)WO_WC, (int)blockIdx.x, args.two};
              pg8::EpiG2 E{(bf16*)(F.ws + WS_MG), (const bf16*)(F.ws + WS_SGA), ACT_STRIDE / 2};
              if (blockIdx.x < 256) pg8::gemm_phase<pg8::EpiG2, pg8::SchedPair, true>(F.tid, F.lds + RING_OFF, D, S, E); }
        PH_END
        PHB(4) g3_side(F, l);
            { pg8::SchedDense S{(const char*)(F.ws + WS_MG), (const char*)(wl + WO_WM), 64, 4, F.G, (int)blockIdx.x, D};
              pg8::EpiG3 E{(float*)(F.ws + (rep_ > 0 ? WS_Y : WS_H))};
              pg8::gemm_phase<pg8::EpiG3, pg8::SchedDense, true>(F.tid, F.lds + RING_OFF, D, S, E); }
        PH_END
        PHB(5) phase_t2(F, l, l + 2 * (int)(rep_ > 0), (size_t)(rep_ > 0) << 23); PH_END
        PHB(6) build_toff(F, l);
            { pg8::SchedMoe S{(const char*)(F.ws + WS_XN), (const char*)(F.ws + WS_WGU), (const int*)(F.ws + WS_LIST), (const unsigned*)(F.ctl + CW_CNT + 64 * 32 * l), (const LAS int*)(F.lds + TOFF_OFF), F.G, F.vcu, D, (size_t)D * D * 2, true};
              pg8::EpiM1 E{(bf16*)(F.ws + WS_HACT)};
              pg8::gemm_phase<pg8::EpiM1, pg8::SchedMoe, true>(F.tid, F.lds + RING_OFF, D, S, E); }
        PH_END
        PHB(7) build_toff(F, l);
            { pg8::SchedMoe S{(const char*)(F.ws + WS_HACT), (const char*)(F.ws + WS_WDN), (const int*)(F.ws + WS_LIST), (const unsigned*)(F.ctl + CW_CNT + 64 * 32 * l), (const LAS int*)(F.lds + TOFF_OFF), F.G, F.vcu, DE, (size_t)D * DE * 2, false};
              pg8::EpiM2 E{(bf16*)(F.ws + WS_Y)};
              pg8::gemm_phase<pg8::EpiM2, pg8::SchedMoe, true>(F.tid, F.lds + RING_OFF, DE, S, E); }
        PH_END
    }
    PHB(8) phase_out(F); PH_END
#undef PHB
#undef PH_END
}

extern "C" void kernel_launch(void* const* d_in, const int* in_sizes, int n_in, void* d_out, int out_size, void* d_ws, size_t ws_size, hipStream_t stream) {
    static int grid = 0;
    if (grid == 0) {
        if (n_in != 19 || in_sizes[0] != M * D || out_size != M * D || ws_size < WS_END) { fprintf(stderr, "kernel_launch: unexpected shapes / workspace (n_in %d, in0 %d, out %d, ws %zu, need %zu); nothing launched\n", n_in, n_in > 0 ? in_sizes[0] : -1, out_size, ws_size, (size_t)WS_END); grid = -1; return; }
        int dev = 0, cus = 0, per_cu = 0;
        if (hipGetDevice(&dev) != hipSuccess || hipDeviceGetAttribute(&cus, hipDeviceAttributeMultiprocessorCount, dev) != hipSuccess) { grid = -1; return; }
        if (hipFuncSetAttribute((const void*)fwd_kernel, hipFuncAttributeMaxDynamicSharedMemorySize, LDS_BYTES) != hipSuccess) { fprintf(stderr, "kernel_launch: hipFuncSetAttribute failed\n"); grid = -1; return; }
        if (hipOccupancyMaxActiveBlocksPerMultiprocessor(&per_cu, (const void*)fwd_kernel, NWAVES * 64, LDS_BYTES) != hipSuccess || per_cu < 1) fprintf(stderr, "kernel_launch: note: occupancy query reports %d workgroups per CU\n", per_cu);
        (void)hipGetLastError();
        grid = cus;
        if (grid != 256) fprintf(stderr, "kernel_launch: note: %d CUs (tuned for 256)\n", grid);
    }
    if (grid < 0) return;
    if (hipMemsetAsync((char*)d_ws + WS_CTL, 0, CTL_ZERO_BYTES, stream) != hipSuccess) return;
    Args a{};
    for (int i = 0; i < 19; ++i) a.in[i] = (const float*)d_in[i];
    a.out = (float*)d_out; a.ws = (unsigned char*)d_ws; a.two = 2;
#if MK_N_LAUNCHES == 1
    a.ph_lo = 0; a.ph_hi = N_PHASES; a.li = 0;
    hipLaunchKernelGGL(fwd_kernel, dim3(grid), dim3(NWAVES * 64), LDS_BYTES, stream, a);
#else
    for (int p = 0; p < N_PHASES; ++p) { a.ph_lo = p; a.ph_hi = p + 1; a.li = 0; hipLaunchKernelGGL(fwd_kernel, dim3(grid), dim3(NWAVES * 64), LDS_BYTES, stream, a); }
#endif
}
```

```cpp
#include <hip/hip_runtime.h>
#include <cstdio>
#include <cstdint>
#include <cmath>
namespace pg8 {
#define PG8_LAS __attribute__((address_space(3)))
typedef unsigned short bf16_t;
typedef short bf16x8 __attribute__((ext_vector_type(8)));
typedef float f32x4 __attribute__((ext_vector_type(4)));
typedef float f32x2 __attribute__((ext_vector_type(2)));
typedef unsigned u32x4 __attribute__((ext_vector_type(4)));
__device__ __forceinline__ float shx(float v, int m, int lane) { return __int_as_float(__builtin_amdgcn_ds_bpermute((lane ^ m) << 2, __float_as_int(v))); }
__device__ __forceinline__ float row16_sum(float v) {
    v += __int_as_float(__builtin_amdgcn_update_dpp(0, __float_as_int(v), 0xB1, 0xF, 0xF, true));
    v += __int_as_float(__builtin_amdgcn_update_dpp(0, __float_as_int(v), 0x4E, 0xF, 0xF, true));
    v += __int_as_float(__builtin_amdgcn_update_dpp(0, __float_as_int(v), 0x141, 0xF, 0xF, true));
    v += __int_as_float(__builtin_amdgcn_update_dpp(0, __float_as_int(v), 0x140, 0xF, 0xF, true));
    return v;
}
constexpr int BM = 256, BK = 64, HALF = 128, HTB = HALF * BK * 2  , STAGE_BYTES = 8 * HTB, NXCD = 8, WGM = 8;

__host__ __device__ __forceinline__ int lds_byte(int r, int c) { const int st = (r >> 4) * 2 + (c >> 5), rr = r & 15, cc = c & 31, ob = rr * 64 + cc * 2; return st * 1024 + (ob ^ (((ob >> 9) & 1) << 5)); }
__host__ __device__ __forceinline__ void stage_rc(int b, int& R, int& C) { const int st = b / 1024, sb = b % 1024, swz = sb ^ (((sb >> 9) & 1) << 5); R = (st >> 1) * 16 + swz / 64; C = (st & 1) * 32 + (swz % 64) / 2; }
__host__ __device__ __forceinline__ int perm32(int rho) { const int n = rho >> 4, i = rho & 15; return 8 * (i >> 2) + 4 * n + (i & 3); }

struct Unit { const char* a; const char* b; int kind, pm, pn, aux; };

__device__ __forceinline__ void tile_of(int L, int nM, int nN, int& pm, int& pn) {
    const int nwg = nM * nN; int wgid = L; { const int q = nwg / NXCD, r = nwg % NXCD, xcd = wgid % NXCD, off = wgid / NXCD; wgid = (xcd < r ? xcd * (q + 1) : r * (q + 1) + (xcd - r) * q) + off; }
    const int nig = WGM * nN, gid = wgid / nig, fm = gid * WGM, gsz = (nM - fm) < WGM ? (nM - fm) : WGM;
    pm = fm + ((wgid % nig) % gsz); pn = (wgid % nig) / gsz;
}
__device__ __forceinline__ unsigned cvt_pk_bf16(float lo, float hi) { unsigned r; asm volatile("v_cvt_pk_bf16_f32 %0, %1, %2" : "=v"(r) : "v"(lo), "v"(hi)); return r; }
__device__ __forceinline__ float bf_lo(unsigned w) { return __uint_as_float(w << 16); }
__device__ __forceinline__ float bf_hi(unsigned w) { return __uint_as_float(w & 0xffff0000u); }
__device__ __forceinline__ float sigmoidf_fast(float x) { return __builtin_amdgcn_rcpf(1.0f + __builtin_amdgcn_exp2f(-1.4426950408889634f * x)); }

template <class Epi, class Sched, bool ALIGN_EPI>
__device__ __forceinline__ void gemm_phase(const int tid, PG8_LAS unsigned char* lds, const int K, const Sched& S, const Epi& E) {
    const int wid = __builtin_amdgcn_readfirstlane(tid >> 6), lane = tid & 63, wr = wid >> 2, wc = wid & 3, fr = lane & 15, fq = lane >> 4;
    const int nt = K / BK;
    int sR[2], sC[2]; unsigned voffB[2];
#pragma unroll
    for (int i = 0; i < 2; ++i) { stage_rc(tid * 16 + i * 8192, sR[i], sC[i]); const int Rb = (sR[i] & ~31) + perm32(sR[i] & 31); voffB[i] = (unsigned)(Rb * K + sC[i]) * 2u; }
    const size_t kstep = (size_t)(BK * 2);
    const size_t hstep = (size_t)HALF * K * 2;
    const unsigned ldsw = (unsigned)wid * 1024u;
    const int aoff = lds_byte(wr * 64 + fr, fq * 8), boff = lds_byte(wc * 32 + fr, fq * 8);
#define PG8_SA(b, h) (((b) * 2 + (h)) * HTB)
#define PG8_SB(b, h) ((4 + (b) * 2 + (h)) * HTB)
#define PG8_STAGE(bufoff, gbase, v0, v1) do { \
        __builtin_amdgcn_global_load_lds((const unsigned*)((const char*)(gbase) + (v0)), (PG8_LAS unsigned*)(lds + (bufoff) + ldsw), 16, 0, 0); \
        __builtin_amdgcn_global_load_lds((const unsigned*)((const char*)(gbase) + (v1)), (PG8_LAS unsigned*)(lds + (bufoff) + ldsw + 8192), 16, 0, 0); } while (0)
#define PG8_STAGEB(bufoff, gbase) PG8_STAGE(bufoff, gbase, voffB[0], voffB[1])
#define PG8_LDA(dst, b, h) do { _Pragma("unroll") for (int m = 0; m < 4; ++m) _Pragma("unroll") for (int k = 0; k < 2; ++k) dst[m][k] = *(const PG8_LAS bf16x8*)(lds + PG8_SA(b, h) + aoff + m * 2048 + k * 1024); } while (0)
#define PG8_LDB(dst, b, h) do { _Pragma("unroll") for (int n = 0; n < 2; ++n) _Pragma("unroll") for (int k = 0; k < 2; ++k) dst[n][k] = *(const PG8_LAS bf16x8*)(lds + PG8_SB(b, h) + boff + n * 2048 + k * 1024); } while (0)
#define PG8_MMA(ai, bj, At, Bt) do { __builtin_amdgcn_s_setprio(1); _Pragma("unroll") for (int m = 0; m < 4; ++m) _Pragma("unroll") for (int n = 0; n < 2; ++n) _Pragma("unroll") for (int k = 0; k < 2; ++k) \
        acc[ai][bj][m][n] = __builtin_amdgcn_mfma_f32_16x16x32_bf16(Bt[n][k], At[m][k], acc[ai][bj][m][n], 0, 0, 0); __builtin_amdgcn_s_setprio(0); } while (0)
#define PG8_WAIT_V(n) asm volatile("s_waitcnt vmcnt(" #n ")" ::: "memory")
#define PG8_WAIT_L(n) asm volatile("s_waitcnt lgkmcnt(" #n ")" ::: "memory")
#define PG8_BAR __builtin_amdgcn_s_barrier()
#define PG8_SCHED __builtin_amdgcn_sched_barrier(0)
    Unit cur, nxt; int ui = 0;
    if (!S.next(0, cur)) return;
    f32x4 acc[2][2][4][2];
#pragma unroll
    for (int a = 0; a < 2; ++a)
#pragma unroll
        for (int b = 0; b < 2; ++b)
#pragma unroll
            for (int m = 0; m < 4; ++m)
#pragma unroll
                for (int n = 0; n < 2; ++n) acc[a][b][m][n] = (f32x4){0.f, 0.f, 0.f, 0.f};
    bf16x8 At[4][2], B0[2][2], B1[2][2];
    unsigned vA[2][2], vN[2][2];
    S.voff(cur, K, sR, sC, vA);
    const char* cA = cur.a; const char* cB = cur.b;
    PG8_STAGEB(PG8_SB(0, 0), cB); PG8_STAGEB(PG8_SB(0, 1), cB + hstep); PG8_STAGE(PG8_SA(0, 0), cA, vA[0][0], vA[0][1]); PG8_STAGE(PG8_SA(0, 1), cA, vA[1][0], vA[1][1]);
    if (wr == 1) PG8_BAR;
    PG8_WAIT_V(2); PG8_BAR;
    PG8_STAGEB(PG8_SB(1, 0), cB + kstep); PG8_STAGE(PG8_SA(1, 0), cA + kstep, vA[0][0], vA[0][1]); PG8_STAGEB(PG8_SB(1, 1), cB + hstep + kstep);
    PG8_WAIT_V(6); PG8_BAR;
    for (;;) {
        const bool has_next = S.next(ui + 1, nxt);
        const char* nA = cA; const char* nB = cB;
#pragma unroll
        for (int h = 0; h < 2; ++h) { vN[h][0] = vA[h][0]; vN[h][1] = vA[h][1]; }
        if (has_next) { nA = nxt.a; nB = nxt.b; S.voff(nxt, K, sR, sC, vN); }
        for (int t = 0; t < nt; t += 2) {
            const bool last = (t == nt - 2);
            const char* a1 = cA + (size_t)(t + 1) * kstep;
            const char* a2 = last ? nA : cA + (size_t)(t + 2) * kstep; const char* b2 = last ? nB : cB + (size_t)(t + 2) * kstep;
            const char* a3 = a2 + kstep; const char* b3 = b2 + kstep;
            const unsigned w00 = last ? vN[0][0] : vA[0][0], w01 = last ? vN[0][1] : vA[0][1], w10 = last ? vN[1][0] : vA[1][0], w11 = last ? vN[1][1] : vA[1][1];
            PG8_LDB(B0, 0, 0); PG8_LDB(B1, 0, 1); PG8_SCHED; PG8_LDA(At, 0, 0); PG8_STAGE(PG8_SA(1, 1), a1, vA[1][0], vA[1][1]);
            PG8_WAIT_V(8); PG8_WAIT_L(0); PG8_BAR; PG8_MMA(0, 0, At, B0); PG8_MMA(0, 1, At, B1); PG8_BAR; PG8_SCHED;
            PG8_LDA(At, 0, 1); PG8_STAGEB(PG8_SB(0, 0), b2); PG8_STAGEB(PG8_SB(0, 1), b2 + hstep); PG8_STAGE(PG8_SA(0, 0), a2, w00, w01);
            PG8_WAIT_V(8); PG8_WAIT_L(0); PG8_BAR; PG8_MMA(1, 0, At, B0); PG8_MMA(1, 1, At, B1); PG8_BAR; PG8_SCHED;
            PG8_LDB(B0, 1, 0); PG8_LDB(B1, 1, 1); PG8_SCHED; PG8_LDA(At, 1, 0); PG8_STAGE(PG8_SA(0, 1), a2, w10, w11);
            PG8_WAIT_V(8); PG8_WAIT_L(0); PG8_BAR; PG8_MMA(0, 0, At, B0); PG8_MMA(0, 1, At, B1); PG8_BAR; PG8_SCHED;
            PG8_LDA(At, 1, 1); PG8_STAGEB(PG8_SB(1, 0), b3); PG8_STAGEB(PG8_SB(1, 1), b3 + hstep); PG8_STAGE(PG8_SA(1, 0), a3, w00, w01);
            PG8_WAIT_V(8); PG8_WAIT_L(0); PG8_BAR; PG8_MMA(1, 0, At, B0); PG8_MMA(1, 1, At, B1); PG8_BAR; PG8_SCHED;
        }
        if constexpr (ALIGN_EPI) { if (wr == 0) PG8_BAR; }
        E(acc, cur, wr, wc, fr, fq);
        if (!has_next) break;
#pragma unroll
        for (int a = 0; a < 2; ++a)
#pragma unroll
            for (int b = 0; b < 2; ++b)
#pragma unroll
                for (int m = 0; m < 4; ++m)
#pragma unroll
                    for (int n = 0; n < 2; ++n) acc[a][b][m][n] = (f32x4){0.f, 0.f, 0.f, 0.f};
        cur = nxt; cA = nA; cB = nB; ++ui;
#pragma unroll
        for (int h = 0; h < 2; ++h) { vA[h][0] = vN[h][0]; vA[h][1] = vN[h][1]; }
        if constexpr (ALIGN_EPI) { if (wr == 1) PG8_BAR; }
    }
    PG8_WAIT_V(0);
    if constexpr (!ALIGN_EPI) { if (wr == 0) PG8_BAR; }
    PG8_BAR;
#undef PG8_SA
#undef PG8_SB
#undef PG8_STAGE
#undef PG8_STAGEB
#undef PG8_LDA
#undef PG8_LDB
#undef PG8_MMA
#undef PG8_WAIT_V
#undef PG8_WAIT_L
#undef PG8_BAR
#undef PG8_SCHED
}
}
namespace pg8 {
__device__ __forceinline__ void st8(bf16_t* p, const f32x4 v0, const f32x4 v1) { u32x4 w; w.x = cvt_pk_bf16(v0[0], v0[1]); w.y = cvt_pk_bf16(v0[2], v0[3]); w.z = cvt_pk_bf16(v1[0], v1[1]); w.w = cvt_pk_bf16(v1[2], v1[3]); *(u32x4*)p = w; }
__device__ __forceinline__ void st8nt(bf16_t* p, const f32x4 v0, const f32x4 v1) { u32x4 w; w.x = cvt_pk_bf16(v0[0], v0[1]); w.y = cvt_pk_bf16(v0[2], v0[3]); w.z = cvt_pk_bf16(v1[0], v1[1]); w.w = cvt_pk_bf16(v1[2], v1[3]); __builtin_nontemporal_store(w, (u32x4*)p); }
__device__ __forceinline__ f32x4 sig4(const f32x4 v) { return (f32x4){sigmoidf_fast(v[0]), sigmoidf_fast(v[1]), sigmoidf_fast(v[2]), sigmoidf_fast(v[3])}; }
#ifdef G1_NT_STORES
#define ST8G1 st8nt
#else
#define ST8G1 st8
#endif
struct EpiG1 {
    bf16_t* act; size_t astride; const float __attribute__((address_space(1)))* qg; float c2; int skip;
    long kgoff;
    __device__ __forceinline__ void operator()(const f32x4 (&acc)[2][2][4][2], const Unit& u, int wr, int wc, int fr, int fq) const {
        if (skip) return;
        const int row0 = u.pm * BM + wr * 64 + fr, pn = u.pn;
        if (pn < 8) {
            bf16_t* base = act + astride + pn * 128 + wc * 32 + 8 * fq;
#pragma unroll
            for (int ai = 0; ai < 2; ++ai)
#pragma unroll
                for (int m = 0; m < 4; ++m) ST8G1(base + (size_t)(row0 + ai * HALF + m * 16) * 1024, acc[ai][0][m][0] * acc[ai][1][m][0], acc[ai][0][m][1] * acc[ai][1][m][1]);
        } else if (pn >= 12 && pn < 20) {
            const bool isq = pn < 16; const float __attribute__((address_space(1)))* g = qg + (isq ? 0 : kgoff); bf16_t* base = act + (isq ? 3 : 4) * astride + (4 * (pn & 3) + wc) * 64 + 8 * fq;
            f32x4 gv[2][2];
#pragma unroll
            for (int bj = 0; bj < 2; ++bj)
#pragma unroll
                for (int n = 0; n < 2; ++n) gv[bj][n] = *(const f32x4 __attribute__((address_space(1)))*)(g + 32 * bj + 8 * fq + 4 * n);
            const float sc = isq ? c2 : 1.0f;
#pragma unroll
            for (int ai = 0; ai < 2; ++ai)
#pragma unroll
                for (int m = 0; m < 4; ++m) {
                    float ss = 0.f;
#pragma unroll
                    for (int bj = 0; bj < 2; ++bj)
#pragma unroll
                        for (int n = 0; n < 2; ++n) { const f32x4 x = acc[ai][bj][m][n]; ss += (x[0] * x[0] + x[1] * x[1]) + (x[2] * x[2] + x[3] * x[3]); }
                    { const int ln = fq * 16 + fr; ss += shx(ss, 16, ln); ss += shx(ss, 32, ln); }
                    const float rs = __builtin_amdgcn_rsqf(ss * (1.0f / 64.0f) + 1e-6f) * sc;
                    bf16_t* rowp = base + (size_t)(row0 + ai * HALF + m * 16) * 1024;
#pragma unroll
                    for (int bj = 0; bj < 2; ++bj) ST8G1(rowp + 32 * bj, acc[ai][bj][m][0] * gv[bj][0] * rs, acc[ai][bj][m][1] * gv[bj][1] * rs);
                }
        } else {
            const bool gate = pn >= 24;
            const int bi = pn < 12 ? 2 : pn < 24 ? 5 : pn < 28 ? 6 : 7;
            bf16_t* base = act + bi * astride + (pn & 3) * 256 + wc * 32 + 8 * fq;
#pragma unroll
            for (int ai = 0; ai < 2; ++ai)
#pragma unroll
                for (int m = 0; m < 4; ++m) { bf16_t* rowp = base + (size_t)(row0 + ai * HALF + m * 16) * 1024;
#pragma unroll
                    for (int bj = 0; bj < 2; ++bj) { f32x4 v0 = acc[ai][bj][m][0], v1 = acc[ai][bj][m][1]; if (gate) { v0 = sig4(v0); v1 = sig4(v1); } ST8G1(rowp + bj * HALF, v0, v1); } }
        }
    }
};
struct EpiG2 {
    bf16_t* MG; const bf16_t* SGA; size_t gstride;
    __device__ __forceinline__ void operator()(const f32x4 (&acc)[2][2][4][2], const Unit& u, int wr, int wc, int fr, int fq) const {
        const int row0 = u.pm * BM + wr * 64 + fr, col0 = u.pn * BM + wc * 32 + 8 * fq; const bf16_t* G = SGA + (u.kind ? gstride : 0);
#pragma unroll
        for (int ai = 0; ai < 2; ++ai)
#pragma unroll
            for (int m = 0; m < 4; ++m) { const size_t off = (size_t)(row0 + ai * HALF + m * 16) * 1024 + col0;
#pragma unroll
                for (int bj = 0; bj < 2; ++bj) { const u32x4 g = *(const u32x4*)(G + off + bj * HALF);
                    f32x4 v0 = acc[ai][bj][m][0] * (f32x4){bf_lo(g.x), bf_hi(g.x), bf_lo(g.y), bf_hi(g.y)}, v1 = acc[ai][bj][m][1] * (f32x4){bf_lo(g.z), bf_hi(g.z), bf_lo(g.w), bf_hi(g.w)};
                    if (u.kind) { const u32x4 t = *(const u32x4*)(MG + off + bj * HALF); v0 += (f32x4){bf_lo(t.x), bf_hi(t.x), bf_lo(t.y), bf_hi(t.y)}; v1 += (f32x4){bf_lo(t.z), bf_hi(t.z), bf_lo(t.w), bf_hi(t.w)}; }
                    st8(MG + off + bj * HALF, v0, v1); }
                asm volatile("" ::: "memory"); }
    }
};
struct EpiG3 {
    bf16_t* YB;
    __device__ __forceinline__ void operator()(const f32x4 (&acc)[2][2][4][2], const Unit& u, int wr, int wc, int fr, int fq) const {
        bf16_t* base = YB + (size_t)(u.pm * BM + wr * 64 + fr) * 1024 + u.pn * BM + wc * 32 + 8 * fq;
#pragma unroll
        for (int ai = 0; ai < 2; ++ai)
#pragma unroll
            for (int m = 0; m < 4; ++m)
#pragma unroll
                for (int bj = 0; bj < 2; ++bj) st8(base + (size_t)(ai * HALF + m * 16) * 1024 + bj * HALF, acc[ai][bj][m][0], acc[ai][bj][m][1]);
    }
};
struct EpiM1 {
    bf16_t* HACT;
    __device__ __forceinline__ void operator()(const f32x4 (&acc)[2][2][4][2], const Unit& u, int wr, int wc, int fr, int fq) const {
        bf16_t* base = HACT + (size_t)(u.pm * BM + wr * 64 + fr) * 512 + u.pn * 128 + wc * 32 + 8 * fq;
#pragma unroll
        for (int ai = 0; ai < 2; ++ai)
#pragma unroll
            for (int m = 0; m < 4; ++m) { const f32x4 g0 = acc[ai][0][m][0], g1 = acc[ai][0][m][1];
                st8(base + (size_t)(ai * HALF + m * 16) * 512, g0 * sig4(g0) * acc[ai][1][m][0], g1 * sig4(g1) * acc[ai][1][m][1]); }
    }
};
struct EpiM2 {
    bf16_t* Y;
    __device__ __forceinline__ void operator()(const f32x4 (&acc)[2][2][4][2], const Unit& u, int wr, int wc, int fr, int fq) const {
        bf16_t* base = Y + (size_t)(u.pm * BM + wr * 64 + fr) * 1024 + u.pn * BM + wc * 32 + 8 * fq;
#pragma unroll
        for (int ai = 0; ai < 2; ++ai)
#pragma unroll
            for (int m = 0; m < 4; ++m)
#pragma unroll
                for (int bj = 0; bj < 2; ++bj) st8(base + (size_t)(ai * HALF + m * 16) * 1024 + bj * HALF, acc[ai][bj][m][0], acc[ai][bj][m][1]);
    }
};

}
#include <hip/hip_bf16.h>
namespace attn_body {
using bf16=__hip_bfloat16;
using bf16x8=__attribute__((ext_vector_type(8)))short;
using s16x4=__attribute__((ext_vector_type(4)))short;
using f32x16=__attribute__((ext_vector_type(16)))float;
using f32x4=__attribute__((ext_vector_type(4)))float;
using u32x4=__attribute__((ext_vector_type(4)))unsigned;
constexpr int NHEAD=16,SEQ=8192,D=64,DM=NHEAD*D;
constexpr int NW=8,QBLK=32,QB=QBLK*NW,KVBLK=64,NQB=SEQ/QB;
constexpr int META_ROW=16384;
__device__ __forceinline__ int crow(int r,int hi){return (r&3)+8*(r>>2)+4*hi;}
#define SBAR() __builtin_amdgcn_sched_barrier(0)
__device__ __forceinline__ void cmask(f32x16&p0,f32x16&p1,int jb,int qrel,int hi){
  const float NEG=-INFINITY; int kb=64*jb+4*hi;
  #pragma unroll
  for(int r=0;r<16;++r){int kv=kb+(r&3)+8*(r>>2); if(kv>qrel)p0[r]=NEG; if(kv+32>qrel)p1[r]=NEG;}
}
constexpr int NSLOT=3, SLOTB=8192, MAXT=132;
constexpr int LDS_K=0, LDS_V=NSLOT*SLOTB, LDS_WS=2*NSLOT*SLOTB, LDS_OST=LDS_WS+NW*64*4, LDS_BL=LDS_OST+NW*4096, LDS_BYTES=LDS_BL+MAXT*256;
constexpr float C2=0.125f*1.4426950408889634f;
__device__ __forceinline__ void glds16(const void*sbase,unsigned voff,unsigned lds_dst){unsigned keep;
  asm volatile("s_mov_b32 %0, m0\n\ts_mov_b32 m0, %3\n\ts_nop 0\n\tglobal_load_lds_dwordx4 %1, %2\n\ts_mov_b32 m0, %0":"=&s"(keep):"v"(voff),"s"(sbase),"s"(lds_dst):"memory");}
typedef float f32x2_t __attribute__((ext_vector_type(2))); typedef __bf16 bf16x2_t __attribute__((ext_vector_type(2)));
__device__ __forceinline__ unsigned cvtpk_s(float lo,float hi){f32x2_t v={lo,hi};bf16x2_t b=__builtin_convertvector(v,bf16x2_t);return __builtin_bit_cast(unsigned,b);}
#define WAIT_BAR(N) asm volatile("s_waitcnt vmcnt(" #N ") lgkmcnt(0)\n\ts_barrier":::"memory")
typedef __attribute__((address_space(3))) const char* lds_cptr;
typedef short v4i16_t __attribute__((ext_vector_type(4)));
__device__ __forceinline__ void kload8(bf16x8*kf,lds_cptr kp){
  kf[0]=*(const __attribute__((address_space(3))) bf16x8*)(kp);      kf[1]=*(const __attribute__((address_space(3))) bf16x8*)(kp+512);
  kf[2]=*(const __attribute__((address_space(3))) bf16x8*)(kp+2048); kf[3]=*(const __attribute__((address_space(3))) bf16x8*)(kp+2560);
  kf[4]=*(const __attribute__((address_space(3))) bf16x8*)(kp+4096); kf[5]=*(const __attribute__((address_space(3))) bf16x8*)(kp+4608);
  kf[6]=*(const __attribute__((address_space(3))) bf16x8*)(kp+6144); kf[7]=*(const __attribute__((address_space(3))) bf16x8*)(kp+6656);
}
__device__ __forceinline__ void kload2(bf16x8*kf,lds_cptr kp,int j){ kf[2*j]=*(const __attribute__((address_space(3))) bf16x8*)(kp+j*2048); kf[2*j+1]=*(const __attribute__((address_space(3))) bf16x8*)(kp+j*2048+512); }
__device__ __forceinline__ s16x4 vtr(lds_cptr p){ return __builtin_bit_cast(s16x4,__builtin_amdgcn_ds_read_tr16_b64_v4i16((__attribute__((address_space(3))) v4i16_t*)p)); }
__device__ __forceinline__ void binit(f32x16&p0,f32x16&p1,lds_cptr bl,float at){
  #pragma unroll
  for(int g=0;g<4;++g){ const f32x4 a=*(const __attribute__((address_space(3))) f32x4*)(bl+32*g), b=*(const __attribute__((address_space(3))) f32x4*)(bl+128+32*g);
    #pragma unroll
    for(int i=0;i<4;++i){p0[4*g+i]=a[i]+at;p1[4*g+i]=b[i]+at;} }
}
__device__ __forceinline__ void pv(f32x16*o,int vb,bf16x8 pa0,bf16x8 pa1,bf16x8 pa2,bf16x8 pa3){
  #pragma unroll
  for(int d0=0;d0<2;++d0){s16x4 lo[4],hi[4];
    #pragma unroll
    for(int ks=0;ks<4;++ks){
      asm volatile("ds_read_b64_tr_b16 %0,%1 offset:%c2":"=&v"(lo[ks]):"v"(vb),"i"(d0*4096+ks*1024):"memory");
      asm volatile("ds_read_b64_tr_b16 %0,%1 offset:%c2":"=&v"(hi[ks]):"v"(vb),"i"(d0*4096+ks*1024+512):"memory");}
    asm volatile("s_waitcnt lgkmcnt(0)":::"memory");SBAR();
    #define PK(k) (bf16x8){lo[k][0],lo[k][1],lo[k][2],lo[k][3],hi[k][0],hi[k][1],hi[k][2],hi[k][3]}
    o[d0]=__builtin_amdgcn_mfma_f32_32x32x16_bf16(pa0,PK(0),o[d0],0,0,0);
    o[d0]=__builtin_amdgcn_mfma_f32_32x32x16_bf16(pa1,PK(1),o[d0],0,0,0);
    o[d0]=__builtin_amdgcn_mfma_f32_32x32x16_bf16(pa2,PK(2),o[d0],0,0,0);
    o[d0]=__builtin_amdgcn_mfma_f32_32x32x16_bf16(pa3,PK(3),o[d0],0,0,0);
    #undef PK
  }
}
#ifndef ATTN_STORE16
#define ATTN_STORE16(p,v) (*(u32x4*)(p)=(v))
#endif
__device__ __forceinline__ void attn_unit(const int tid,int b,int h,int qb,const float TH,const bf16*Q,const bf16*__restrict__ K,const bf16*__restrict__ V,bf16*O,const float*__restrict__ cb,const float*__restrict__ cbm,float m0,char*shm){
  const int lane=tid&63,r32=lane&31,hi=lane>>5; const int wid=__builtin_amdgcn_readfirstlane(tid>>6);
  const long rowbase=(long)b*SEQ; const int q0=qb*QB;
  const bf16*Qw=Q+(rowbase+q0+wid*QBLK)*DM+h*D;
  const bf16*Kh=K+rowbase*DM+h*D,*Vh=V+rowbase*DM+h*D;
  const unsigned lds0=(unsigned)(uintptr_t)shm;
  float*wsf=(float*)(shm+LDS_WS)+wid*64;
  bf16x8 qr[4];
  #pragma unroll
  for(int d0=0;d0<4;++d0)qr[d0]=*reinterpret_cast<const bf16x8*>(&Qw[(long)r32*DM+d0*16+hi*8]);
  const float at=cb[q0+wid*QBLK+r32]-m0;
  int ts,PRE;
  { const float cbq=cb[q0]; const int nj=4*qb;
    const bool f0=lane<nj&&(cbq-cb[64*lane+63]<-TH), f1=lane+64<nj&&(cbq-cb[64*(lane+64)+63]<-TH);
    ts=__builtin_popcountll(__builtin_amdgcn_ballot_w64(f0))+__builtin_popcountll(__builtin_amdgcn_ballot_w64(f1));
    const int has_meta=(ts==0)?1:0; int dummy=0;
    if((has_meta+4*qb+4-ts)&1){ if(ts>0)--ts; else dummy=1; }
    PRE=has_meta+dummy; }
  const int NT=(q0+QB)/KVBLK-ts+PRE;
  const unsigned koff=(unsigned)(lane*DM+wid*8)*2u, voff=(unsigned)((16*(wid&3)+(lane>>2))*DM+(wid>>2)*32+(lane&3)*8)*2u;
  const long tb0=(long)(ts-PRE)*KVBLK*DM;
  const long dmeta=((long)META_ROW-rowbase)*DM;
  const unsigned kdst=lds0+LDS_K+wid*1024, vdst=lds0+LDS_V+wid*1024;
  #define TOFF(t) (((t)<PRE)?dmeta:tb0+(long)(t)*KVBLK*DM)
  #define DMA_K(t,slot) glds16(Kh+TOFF(t),koff,(unsigned)__builtin_amdgcn_readfirstlane(kdst+(slot)))
  #define DMA_V(t,slot) glds16(Vh+TOFF(t),voff,(unsigned)__builtin_amdgcn_readfirstlane(vdst+(slot)))
  bf16x8 kf[8];
  const lds_cptr shm3=(lds_cptr)shm; const lds_cptr kp0=shm3+LDS_K+hi*1024+r32*16; const lds_cptr vp0=shm3+LDS_V+((lane>>4)&1)*32+(lane&3)*8+(4*hi+((lane&15)>>2))*64;
  lds_cptr blp=shm3+LDS_BL+16*hi;
  DMA_K(0,0);DMA_V(0,0);DMA_K(1,SLOTB);
  float l_reg=0.f;f32x16 o[2];o[0]=f32x16{};o[1]=f32x16{};
  const int qrel=wid*QBLK+r32;
  #define CMASK(P0,P1,t) do{int jb_=(t)-(NT-4); if(jb_>=0)cmask(P0,P1,jb_,qrel,hi);}while(0)
  f32x16 pA0,pA1,pB0,pB1;
  int sl_prev=0,sl_cur=0,sl_next=SLOTB;
  #define ROT() do{sl_prev=sl_cur;sl_cur=sl_next;sl_next=(sl_next==(NSLOT-1)*SLOTB)?0:sl_next+SLOTB;}while(0)
  DMA_K(2,2*SLOTB);
  { float*BLf=(float*)(shm+LDS_BL);
    for(int i=tid;i<NT*64;i+=NW*64){ const int ti=i>>6,j=i&63; float v;
      if(ti<PRE-1)v=-INFINITY; else if(ti==PRE-1)v=(j<16)?-cbm[j]:-INFINITY; else v=-cb[(ti-PRE+ts)*64+j];
      BLf[i]=v; } }
  WAIT_BAR(3);
  binit(pA0,pA1,blp,at); blp+=256;
  { const lds_cptr kb=kp0;
    #pragma unroll
    for(int d0=0;d0<4;++d0){
      const bf16x8 b0=*(const __attribute__((address_space(3))) bf16x8*)(kb+d0*2048);
      const bf16x8 b1=*(const __attribute__((address_space(3))) bf16x8*)(kb+d0*2048+512);
      pA0=__builtin_amdgcn_mfma_f32_32x32x16_bf16(b0,qr[d0],pA0,0,0,0);pA1=__builtin_amdgcn_mfma_f32_32x32x16_bf16(b1,qr[d0],pA1,0,0,0);} }
  CMASK(pA0,pA1,0);
  _Pragma("unroll") for(int r=0;r<16;++r){pA0[r]=__builtin_amdgcn_exp2f(pA0[r]);pA1[r]=__builtin_amdgcn_exp2f(pA1[r]);}
  binit(pB0,pB1,blp,at); blp+=256;
  WAIT_BAR(0);
  DMA_K(3,0);DMA_V(1,SLOTB);
  ROT();
  kload8(kf,kp0+sl_cur);
  WAIT_BAR(2);
  s16x4 vlo[8],vhi[8]; u32x4 pw0,pw1,pw2,pw3;
  #define PKW(P,B) cvtpk_s(P[B],P[B+1])
  #define PAF(k) __builtin_bit_cast(bf16x8,pw##k)
  #define VFR(i) (bf16x8){vlo[i][0],vlo[i][1],vlo[i][2],vlo[i][3],vhi[i][0],vhi[i][1],vhi[i][2],vhi[i][3]}
  #define PIN(x) asm volatile("":"+v"(x))
  #define GAPA(MF,A0,A1,A2,A3,W0,W1,PW) do{ MF; sacc+=A0; sacc+=A1; sacc+=A2; sacc+=A3; PIN(sacc); W0; W1; PIN(PW); SBAR(); }while(0)
  #define EX(v) __builtin_amdgcn_exp2f(v)
  #define GAPB(MF,X,B) do{ MF; X[B]=EX(X[B]); X[B+1]=EX(X[B+1]); X[B+2]=EX(X[B+2]); X[B+3]=EX(X[B+3]); PIN(X); SBAR(); }while(0)
  #define VRD(i) do{ vlo[i]=vtr(vp_+(((i)>>2)*4096+((i)&3)*1024)); vhi[i]=vtr(vp_+(((i)>>2)*4096+((i)&3)*1024+512)); }while(0)
  #define KRD(G,j) do{ if(G){ kload2(kf,kp0+sl_next,j); SBAR(); } }while(0)
  #define BRD(G,P,g) do{ if(G){ const f32x4 t_=*(const __attribute__((address_space(3))) f32x4*)(blp+(((g)>>2)*128+((g)&3)*32)); P[4*((g)&3)]=t_[0];P[4*((g)&3)+1]=t_[1];P[4*((g)&3)+2]=t_[2];P[4*((g)&3)+3]=t_[3]; } }while(0)
  #define BAD(G,P,g) do{ if(G){ P[4*((g)&3)]+=at;P[4*((g)&3)+1]+=at;P[4*((g)&3)+2]+=at;P[4*((g)&3)+3]+=at; PIN(P); } }while(0)
  #define STEP(C0,C1,P0,P1,t,GK,GV,GL,GB) do{ SBAR(); \
    const lds_cptr vp_=vp0+sl_prev; \
    VRD(0); SBAR(); float sacc=(P0[0]+P0[1]); \
    GAPA(C0=__builtin_amdgcn_mfma_f32_32x32x16_bf16(kf[0],qr[0],C0,0,0,0), P0[2],P0[3],P0[4],P0[5],     pw0[0]=PKW(P0,0), pw0[1]=PKW(P0,2), pw0); \
    VRD(4); SBAR(); GAPA(C1=__builtin_amdgcn_mfma_f32_32x32x16_bf16(kf[1],qr[0],C1,0,0,0), P0[6],P0[7],P0[8],P0[9],     pw0[2]=PKW(P0,4), pw0[3]=PKW(P0,6), pw0); \
    VRD(1); SBAR(); GAPA(C0=__builtin_amdgcn_mfma_f32_32x32x16_bf16(kf[2],qr[1],C0,0,0,0),   P0[10],P0[11],P0[12],P0[13], pw1[0]=PKW(P0,8), pw1[1]=PKW(P0,10), pw1); \
    VRD(5); SBAR(); GAPA(C1=__builtin_amdgcn_mfma_f32_32x32x16_bf16(kf[3],qr[1],C1,0,0,0),   P0[14],P0[15],P1[0],P1[1],   pw1[2]=PKW(P0,12),pw1[3]=PKW(P0,14), pw1); \
    VRD(2); SBAR(); GAPA(C0=__builtin_amdgcn_mfma_f32_32x32x16_bf16(kf[4],qr[2],C0,0,0,0),   P1[2],P1[3],P1[4],P1[5],     pw2[0]=PKW(P1,0), pw2[1]=PKW(P1,2), pw2); \
    VRD(6); SBAR(); GAPA(C1=__builtin_amdgcn_mfma_f32_32x32x16_bf16(kf[5],qr[2],C1,0,0,0),   P1[6],P1[7],P1[8],P1[9],     pw2[2]=PKW(P1,4), pw2[3]=PKW(P1,6), pw2); \
    VRD(3); SBAR(); GAPA(C0=__builtin_amdgcn_mfma_f32_32x32x16_bf16(kf[6],qr[3],C0,0,0,0),   P1[10],P1[11],P1[12],P1[13], pw3[0]=PKW(P1,8), pw3[1]=PKW(P1,10), pw3); \
    VRD(7); SBAR(); GAPA(C1=__builtin_amdgcn_mfma_f32_32x32x16_bf16(kf[7],qr[3],C1,0,0,0),   P1[14],P1[15],0.f,0.f,       pw3[2]=PKW(P1,12),pw3[3]=PKW(P1,14), pw3); \
    l_reg+=sacc; \
    if(GK){DMA_K((t)+3,sl_cur);} if(GV){DMA_V((t)+1,sl_next);} \
    CMASK(C0,C1,t); \
    SBAR(); \
    BRD(GB,P0,0); GAPB(o[0]=__builtin_amdgcn_mfma_f32_32x32x16_bf16(PAF(0),VFR(0),o[0],0,0,0), C0,0); \
    BRD(GB,P0,1); BAD(GB,P0,0); GAPB(o[1]=__builtin_amdgcn_mfma_f32_32x32x16_bf16(PAF(0),VFR(4),o[1],0,0,0), C0,4); \
    BRD(GB,P0,2); BAD(GB,P0,1); KRD(GL,0); GAPB(o[0]=__builtin_amdgcn_mfma_f32_32x32x16_bf16(PAF(1),VFR(1),o[0],0,0,0), C0,8); \
    BRD(GB,P0,3); BAD(GB,P0,2); KRD(GL,1); GAPB(o[1]=__builtin_amdgcn_mfma_f32_32x32x16_bf16(PAF(1),VFR(5),o[1],0,0,0), C0,12); \
    BRD(GB,P1,4); BAD(GB,P0,3); KRD(GL,2); GAPB(o[0]=__builtin_amdgcn_mfma_f32_32x32x16_bf16(PAF(2),VFR(2),o[0],0,0,0), C1,0); \
    BRD(GB,P1,5); BAD(GB,P1,4); KRD(GL,3); GAPB(o[1]=__builtin_amdgcn_mfma_f32_32x32x16_bf16(PAF(2),VFR(6),o[1],0,0,0), C1,4); \
    BRD(GB,P1,6); BAD(GB,P1,5); GAPB(o[0]=__builtin_amdgcn_mfma_f32_32x32x16_bf16(PAF(3),VFR(3),o[0],0,0,0), C1,8); \
    BRD(GB,P1,7); BAD(GB,P1,6); GAPB(o[1]=__builtin_amdgcn_mfma_f32_32x32x16_bf16(PAF(3),VFR(7),o[1],0,0,0), C1,12); \
    BAD(GB,P1,7); if(GB){blp+=256;} \
    }while(0)
  int t=1;
  #undef CMASK
  #define CMASK(P0,P1,t) do{}while(0)
  for(;t+5<NT;t+=2){
    STEP(pB0,pB1,pA0,pA1,t,true,true,true,true);     WAIT_BAR(2); ROT();
    STEP(pA0,pA1,pB0,pB1,t+1,true,true,true,true);   WAIT_BAR(2); ROT();
  }
  #undef CMASK
  #define CMASK(P0,P1,t) do{int jb_=(t)-(NT-4); if(jb_>=0)cmask(P0,P1,jb_,qrel,hi);}while(0)
  #define ENDW(tt) do{ if((tt)+3<NT){WAIT_BAR(2);} else if((tt)+2<NT){WAIT_BAR(1);} else {WAIT_BAR(0);} }while(0)
  for(;t+1<NT;t+=2){
    STEP(pB0,pB1,pA0,pA1,t,(t+3<NT),(t+1<NT),(t+1<NT),(t+1<NT));       ENDW(t);   ROT();
    STEP(pA0,pA1,pB0,pB1,t+1,(t+4<NT),(t+2<NT),(t+2<NT),(t+2<NT));     ENDW(t+1); ROT();
  }
  STEP(pB0,pB1,pA0,pA1,NT-1,false,false,false,false);
  { float sacc=pB0[0]+pB0[1]; _Pragma("unroll") for(int r=2;r<16;++r)sacc+=pB0[r]; _Pragma("unroll") for(int r=0;r<16;++r)sacc+=pB1[r]; l_reg+=sacc;
    pw0=(u32x4){PKW(pB0,0),PKW(pB0,2),PKW(pB0,4),PKW(pB0,6)};pw1=(u32x4){PKW(pB0,8),PKW(pB0,10),PKW(pB0,12),PKW(pB0,14)};pw2=(u32x4){PKW(pB1,0),PKW(pB1,2),PKW(pB1,4),PKW(pB1,6)};pw3=(u32x4){PKW(pB1,8),PKW(pB1,10),PKW(pB1,12),PKW(pB1,14)};
    SBAR(); pv(o,(int)(unsigned)(uintptr_t)(vp0+sl_cur),PAF(0),PAF(1),PAF(2),PAF(3)); }
  #undef PKW
  #undef PAF
  #undef VFR
  #undef PIN
  #undef GAPA
  #undef GAPB
  #undef EX
  #undef VRD
  #undef KRD
  #undef BRD
  #undef BAD
  #undef STEP
  #undef ENDW
  {auto rr=__builtin_amdgcn_permlane32_swap(__float_as_uint(l_reg),__float_as_uint(l_reg),false,false);l_reg=__uint_as_float(rr[0])+__uint_as_float(rr[1]);}
  if(hi==0)wsf[32+r32]=l_reg;asm volatile("s_waitcnt lgkmcnt(0)":::"memory");
  float rli[16];
  #pragma unroll
  for(int r=0;r<16;++r)rli[r]=__builtin_amdgcn_rcpf(wsf[32+crow(r,hi)]);
  bf16*Ow=O+(rowbase+q0+wid*QBLK)*DM+h*D;
  { bf16*stg=(bf16*)(shm+LDS_OST)+wid*2048;
    #pragma unroll
    for(int r=0;r<16;++r){const int orow=crow(r,hi);
      #pragma unroll
      for(int d0=0;d0<2;++d0)stg[orow*64+d0*32+r32]=__float2bfloat16(o[d0][r]*rli[r]);}
    asm volatile("s_waitcnt lgkmcnt(0)":::"memory");
    #pragma unroll
    for(int i=0;i<4;++i){const int row=i*8+(lane>>3),ch=lane&7; const u32x4 v=*(const u32x4*)(stg+row*64+ch*8); ATTN_STORE16(Ow+(long)row*DM+ch*8,v);} }
  asm volatile("s_waitcnt lgkmcnt(0)\n\ts_barrier":::"memory");
  #undef DMA_K
  #undef DMA_V
  #undef TOFF
  #undef CMASK
  #undef ROT
}
constexpr int ATTN_LDS_BYTES=LDS_BYTES;
#undef SBAR
#undef WAIT_BAR
}
constexpr int NWAVES = 8;
constexpr int BATCH = 2, SEQ = 8192, D = 1024, NH = 16, HD = 64, NMETA = 16, INC = 8208, NE = 32, DE = 512, DEPTH = 2;
constexpr int M = BATCH * SEQ;
constexpr int MROW = M;
constexpr int NTOK = M + NMETA;
constexpr int MP = 16640;
constexpr int SLOTS = 41216;
constexpr float EPS = 1e-6f, LOG2E = 1.4426950408889634f;
constexpr size_t MiB = 1u << 20;
constexpr size_t WS_CTL = 0, CTL_ZERO_BYTES = 1 * MiB;
constexpr size_t WS_FL = 1 * MiB;
constexpr size_t WS_CB = WS_FL + (size_t)MP * 16 * 4;
constexpr size_t WS_CBM = WS_CB + (size_t)32 * SEQ * 4;
constexpr size_t WS_PM = WS_CBM + 1024;
constexpr size_t WS_HNM = WS_PM + (size_t)16 * INC * 4;
constexpr size_t WS_YAINM = WS_HNM + 65536, WS_OM = WS_YAINM + 65536, WS_MGM = WS_OM + 65536;
constexpr size_t WS_RE = WS_MGM + 65536;
constexpr size_t WS_RP = WS_RE + (size_t)MP * 8;
constexpr size_t WS_RW = WS_RP + (size_t)MP * 8;
constexpr size_t WS_LIST = WS_RW + (size_t)MP * 8;
constexpr size_t WS_SMALL_END = WS_LIST + (size_t)NE * MP * 4;
static_assert(WS_SMALL_END <= 16 * MiB, "small buffers");
constexpr size_t WS_WD0 = 16 * MiB, WD_LAYER = 22 * MiB;
constexpr size_t WO_WC = 16 * MiB, WO_WA = 18 * MiB, WO_WM = 20 * MiB;
constexpr size_t WS_WGU = 60 * MiB, WS_WDN = 124 * MiB;
constexpr size_t WS_H = 156 * MiB;
constexpr size_t WS_ACT = 221 * MiB, ACT_STRIDE = (size_t)MP * D * 2;
constexpr size_t WS_XN = WS_ACT, WS_Z = WS_ACT + ACT_STRIDE, WS_BG = WS_ACT + 2 * ACT_STRIDE, WS_Q = WS_ACT + 3 * ACT_STRIDE, WS_K = WS_ACT + 4 * ACT_STRIDE, WS_V = WS_ACT + 5 * ACT_STRIDE,
                 WS_SGA = WS_ACT + 6 * ACT_STRIDE, WS_SGB = WS_ACT + 7 * ACT_STRIDE, WS_YAIN = WS_ACT + 8 * ACT_STRIDE, WS_END = WS_ACT + 9 * ACT_STRIDE;
constexpr size_t WS_YB = WS_YAIN;
constexpr size_t WS_MG = WS_Z;
constexpr size_t WS_HACT = WS_BG;
constexpr size_t WS_Y = WS_K;
static_assert(WS_HACT + (size_t)SLOTS * DE * 2 <= WS_K && WS_Y + (size_t)SLOTS * D * 2 <= WS_SGB, "MoE overlays");
constexpr int CW_TMO = 0, CW_CODE = 1, CW_BAR = 4096, CW_CNT = 16384, CW_AQ = 32768;
constexpr int RING_OFF = 0, RING_BYTES = 131072;
constexpr int LDSCTL_OFF = 162816, MISC_OFF = LDSCTL_OFF + 320;
constexpr int LDS_BYTES = 163840;
constexpr int TOFF_OFF = MISC_OFF + 128;
static_assert(TOFF_OFF + 160 <= LDSCTL_OFF + 768 && LDSCTL_OFF + 768 + 19 * 8 <= LDS_BYTES && attn_body::ATTN_LDS_BYTES <= RING_BYTES, "LDS map");

#define GAS __attribute__((address_space(1)))
#define LAS __attribute__((address_space(3)))
typedef unsigned short bf16;
typedef unsigned v4u __attribute__((ext_vector_type(4)));
typedef unsigned v2u __attribute__((ext_vector_type(2)));
typedef float f32x4 __attribute__((ext_vector_type(4)));
typedef GAS unsigned gu32;
#define RLX_AGENT __ATOMIC_RELAXED, __HIP_MEMORY_SCOPE_AGENT
#define LDS_WAIT() asm volatile("s_waitcnt lgkmcnt(0)" ::: "memory")
#define VM_WAIT() asm volatile("s_waitcnt vmcnt(0)" ::: "memory")
__device__ __forceinline__ unsigned f2bf(float f) { unsigned u = __builtin_bit_cast(unsigned, f); return (u + 0x7fffu + ((u >> 16) & 1u)) >> 16; }
__device__ __forceinline__ unsigned pk2(float lo, float hi) { return f2bf(lo) | (f2bf(hi) << 16); }
__device__ __forceinline__ float bflo(unsigned w) { return __uint_as_float(w << 16); }
__device__ __forceinline__ float bfhi(unsigned w) { return __uint_as_float(w & 0xffff0000u); }

#define XB_TMO      128
#define XB_XCNT(j)  (256  + 64 * (j))
#define XB_XSUB(j)  (1280 + 64 * (j))
#define XB_XGEN(j)  (2304 + 64 * (j))
#define XB_TOP      3328
#define XB_TOPGEN   3392
#define XCD_BAR_WORDS 3456
#define XB_SPIN_CAP (1u << 18)
__device__ __forceinline__ unsigned xb_ld(unsigned* p)              { return __hip_atomic_load(p, __ATOMIC_RELAXED, __HIP_MEMORY_SCOPE_AGENT); }
__device__ __forceinline__ unsigned xb_add(unsigned* p, unsigned v) { return __hip_atomic_fetch_add(p, v, __ATOMIC_RELAXED, __HIP_MEMORY_SCOPE_AGENT); }
__device__ __forceinline__ unsigned xb_xcc_id() { return (unsigned)__builtin_amdgcn_s_getreg((3 << 11) | 20) & 0xFu; }
#define XB_SPIN(cond, bar) do { unsigned _sp = 0; while (cond) { __builtin_amdgcn_s_sleep(1); \
    if ((++_sp & 255u) == 0u) { if (xb_ld(&(bar)[XB_TMO])) break; if (_sp > XB_SPIN_CAP) { atomicAdd(&(bar)[XB_TMO], 1u); break; } } } } while (0)
struct XcdBarrier { unsigned* bar; unsigned x; volatile LAS unsigned* st; };
__device__ __forceinline__ XcdBarrier xcd_barrier_post(unsigned* bar, volatile LAS unsigned* st) {
    XcdBarrier b; b.bar = bar; b.x = xb_xcc_id(); b.st = st;
    if (threadIdx.x == 0) (void)xb_add(&bar[XB_XCNT(b.x)], 1u);
    return b;
}
__device__ __forceinline__ void xcd_barrier_complete(unsigned* bar, unsigned x, unsigned& nloc, unsigned& nx) {
    const unsigned G = gridDim.x * gridDim.y * gridDim.z;
    unsigned sum, cnt, mine, sp = 0u;
    for (;;) {
        sum = 0u; cnt = 0u; mine = 0u;
#pragma unroll
        for (unsigned j = 0; j < 16; ++j) { const unsigned c = xb_ld(&bar[XB_XCNT(j)]); sum += c; cnt += (c > 0u) ? 1u : 0u; mine = (j == x) ? c : mine; }
        if (sum == G) break;
        __builtin_amdgcn_s_sleep(1);
        if ((++sp & 255u) == 0u) { if (xb_ld(&bar[XB_TMO])) break; if (sp > XB_SPIN_CAP) { atomicAdd(&bar[XB_TMO], 1u); break; } }
    }
    nloc = mine > 0u ? mine : 1u; nx = cnt > 0u ? cnt : 1u;
}
__device__ __forceinline__ void xcd_barrier(const XcdBarrier& b) {
    asm volatile("s_waitcnt vmcnt(0)" ::: "memory");
    __syncthreads();
    if (threadIdx.x == 0) {
        unsigned* bar = b.bar;
        __builtin_amdgcn_s_waitcnt(0);
        unsigned nloc = b.st[0], nx = b.st[1];
        if (nloc == 0u) { xcd_barrier_complete(bar, b.x, nloc, nx); b.st[0] = nloc; b.st[1] = nx; }
        const unsigned old = xb_add(&bar[XB_XSUB(b.x)], 1u);
        const unsigned gen = old / nloc;
        if (old + 1u == (gen + 1u) * nloc) {
            __builtin_amdgcn_fence(__ATOMIC_RELEASE, "agent");
            asm volatile("s_waitcnt vmcnt(0)" ::: "memory");
            const unsigned og = xb_add(&bar[XB_TOP], 1u);
            const unsigned tg = og / nx;
            if (og + 1u == (tg + 1u) * nx) xb_add(&bar[XB_TOPGEN], 1u);
            else XB_SPIN(xb_ld(&bar[XB_TOPGEN]) == tg, bar);
            __builtin_amdgcn_fence(__ATOMIC_ACQUIRE, "agent");
            xb_add(&bar[XB_XGEN(b.x)], 1u);
            asm volatile("s_waitcnt vmcnt(0)" ::: "memory");
        } else {
            XB_SPIN(xb_ld(&bar[XB_XGEN(b.x)]) == gen, bar);
            __builtin_amdgcn_fence(__ATOMIC_ACQUIRE, "agent");
            asm volatile("s_waitcnt vmcnt(0)" ::: "memory");
        }
    }
    __syncthreads();
}

struct Frame {
    LAS unsigned char* lds; volatile LAS unsigned* MISC; gu32* ctl; unsigned char* ws;
    int tid, lane, wave, vcu, G, gw, NGW;
    float* out;
};
constexpr int INP_OFF = LDSCTL_OFF + 768;
typedef const float GAS* gcf;
__device__ __forceinline__ gcf inp_ld(Frame& F, int i) {
    (void)F; unsigned z = 0; asm volatile("" : "+s"(z));
    const __attribute__((address_space(4))) unsigned long long* kp = (const __attribute__((address_space(4))) unsigned long long*)__builtin_amdgcn_kernarg_segment_ptr();
    return (gcf)kp[i + z]; }
#define INP(i) inp_ld(F, i)
__device__ __forceinline__ float wave_sum_l(float v, int lane) {
    v = pg8::row16_sum(v); v += pg8::shx(v, 16, lane); v += pg8::shx(v, 32, lane);
    return v;
}
__device__ __forceinline__ float wave_max_l(float v, int lane) {
#pragma unroll
    for (int o = 1; o < 64; o <<= 1) v = fmaxf(v, pg8::shx(v, o, lane));
    return v;
}
#define wave_sum(v) wave_sum_l(v, F.lane)
#define wave_max(v) wave_max_l(v, F.lane)
__device__ __forceinline__ void tr_block(gcf src, int ld, bf16* dst, int Kd, LAS float* scr, int lane) {
    float t[32];
    gcf sp = src + (size_t)(lane >> 5) * ld + (lane & 31);
#pragma unroll
    for (int i = 0; i < 32; ++i) t[i] = sp[(size_t)(2 * i) * ld];
#pragma unroll
    for (int i = 0; i < 32; ++i) scr[(2 * i + (lane >> 5)) * 33 + (lane & 31)] = t[i];
    LDS_WAIT(); asm volatile("" ::: "memory");
    const int c = lane & 7;
#pragma unroll
    for (int j = 0; j < 4; ++j) { const int n = (lane >> 3) + 8 * j; const LAS float* s = scr + (8 * c) * 33 + n;
        v4u o; o.x = pk2(s[0 * 33], s[1 * 33]); o.y = pk2(s[2 * 33], s[3 * 33]); o.z = pk2(s[4 * 33], s[5 * 33]); o.w = pk2(s[6 * 33], s[7 * 33]);
        *(GAS v4u*)(dst + (size_t)n * Kd + 8 * c) = o; }
    LDS_WAIT(); asm volatile("" ::: "memory");
}
__device__ __forceinline__ int win_src_col(int n0) {
    const int pn = n0 >> 8, p = n0 & 255;
    if (pn < 8) return ((p >> 7) ? 2048 : 1024) + 128 * pn + (p & 127);
    if (pn < 12) return 256 * (pn - 8) + p;
    if (pn < 20) return (pn < 16 ? 3072 : 4096) + 256 * (pn & 3) + 64 * ((p >> 5) & 3) + 32 * (p >> 7);
    if (pn < 24) return 5120 + 256 * (pn & 3) + p;
    if (pn < 28) return 6160 + 256 * (pn & 3) + p;
    return 7184 + 256 * (pn & 3) + p;
}
constexpr int IT_WIN = 16 * 256, IT_SQ = 16 * 32, IT_DENSE = IT_WIN + 3 * IT_SQ;
constexpr int IT_GU = 16 * 32, IT_DN = 8 * 32, IT_EXP = IT_GU + IT_DN, IT_EXPL = NE * IT_EXP;
__device__ __forceinline__ void conv_dense_item(Frame& F, int l, int it, LAS float* scr) {
    unsigned char* wl = F.ws + WS_WD0 + (size_t)l * WD_LAYER;
    if (it < IT_WIN) { const int kb = it >> 8, nb = it & 255; tr_block(INP(3) + (size_t)l * D * INC + (size_t)(64 * kb) * INC + win_src_col(32 * nb), INC, (bf16*)wl + (size_t)(32 * nb) * D + 64 * kb, D, scr, F.lane); return; }
    it -= IT_WIN; const int w = it / IT_SQ, r = it % IT_SQ, kb = r >> 5, nb = r & 31;
    const size_t so = (size_t)l * D * D + (size_t)(64 * kb) * D + 32 * nb, dof = (size_t)(32 * nb) * D + 64 * kb;
    if (w == 0) tr_block(INP(6) + so, D, (bf16*)(wl + WO_WC) + dof, D, scr, F.lane);
    else if (w == 1) tr_block(INP(9) + so, D, (bf16*)(wl + WO_WA) + dof, D, scr, F.lane);
    else tr_block(INP(10) + so, D, (bf16*)(wl + WO_WM) + dof, D, scr, F.lane);
}
__device__ __forceinline__ void conv_expert_item(Frame& F, int l, int it, LAS float* scr) {
    const int e = it / IT_EXP; int r = it % IT_EXP;
    if (r < IT_GU) { const int kb = r >> 5, nb = r & 31, n0 = 32 * nb, ct = n0 >> 8, p = n0 & 255;
        const size_t so = ((size_t)l * NE + e) * D * DE + (size_t)(64 * kb) * DE + 128 * ct + (p & 127); bf16* dst = (bf16*)(F.ws + WS_WGU) + (size_t)e * D * D + (size_t)n0 * D + 64 * kb;
        if (p >> 7) tr_block(INP(17) + so, DE, dst, D, scr, F.lane); else tr_block(INP(16) + so, DE, dst, D, scr, F.lane);
        return; }
    r -= IT_GU; const int kb = r >> 5, nb = r & 31;
    tr_block(INP(18) + ((size_t)l * NE + e) * DE * D + (size_t)(64 * kb) * D + 32 * nb, D, (bf16*)(F.ws + WS_WDN) + (size_t)e * D * DE + (size_t)(32 * nb) * DE + 64 * kb, DE, scr, F.lane);
}
__device__ __forceinline__ void build_toff(Frame& F, int l) {
    LAS int* toff = (LAS int*)(F.lds + TOFF_OFF);
    if (F.tid < 64) {
        int t = F.lane < NE ? (((int)__hip_atomic_load(F.ctl + CW_CNT + 64 * (32 * l + F.lane), RLX_AGENT) + 255) >> 8) : 0; const int mine = t;
#pragma unroll
        for (int o = 1; o < 32; o <<= 1) { const int u = __builtin_amdgcn_ds_bpermute(((F.lane - o) & 63) << 2, t); if (F.lane >= o) t += u; }
        if (F.lane < NE) toff[F.lane] = t - mine;
        if (F.lane == NE - 1) toff[NE] = t; }
    __syncthreads();
}
namespace pg8 {
struct SchedDense {
    const char* A; const char* B; int nM, nN, G, c, K;
    __device__ __forceinline__ bool next(int i, Unit& u) const { const int L = i * G + c; if (L >= nM * nN) return false; int pm, pn; tile_of(L, nM, nN, pm, pn); u.pm = pm; u.pn = pn; u.kind = 0; u.aux = 0;
        u.a = A + (size_t)pm * BM * K * 2; u.b = B + (size_t)pn * BM * K * 2; return true; }
    __device__ __forceinline__ void voff(const Unit&, int K_, const int (&R)[2], const int (&C)[2], unsigned (&vo)[2][2]) const {
#pragma unroll
        for (int h = 0; h < 2; ++h)
#pragma unroll
            for (int i = 0; i < 2; ++i) vo[h][i] = (unsigned)((R[i] + HALF * h) * K_ + C[i]) * 2u; }
};
struct SchedPair {
    const char *A0, *B0; long dA, dB; int c, lim;
    __device__ __forceinline__ bool next(int i, Unit& u) const { if (i >= lim) return false; int pm, pn; tile_of(c, 64, 4, pm, pn); u.pm = pm; u.pn = pn; u.kind = i; u.aux = 0;
        u.a = A0 + (i ? dA : 0) + (size_t)pm * BM * 1024 * 2; u.b = B0 + (i ? dB : 0) + (size_t)pn * BM * 1024 * 2; return true; }
    __device__ __forceinline__ void voff(const Unit&, int K_, const int (&R)[2], const int (&C)[2], unsigned (&vo)[2][2]) const {
#pragma unroll
        for (int h = 0; h < 2; ++h)
#pragma unroll
            for (int i = 0; i < 2; ++i) vo[h][i] = (unsigned)((R[i] + HALF * h) * K_ + C[i]) * 2u; }
};
struct SchedMoe {
    const char* A; const char* B; const int* list; const unsigned* cnt; const PG8_LAS int* toff; int G, c, K; size_t bstride; bool gather;
    __device__ __forceinline__ bool next(int i, Unit& u) const {
        const int L = i * G + c, total = __builtin_amdgcn_readfirstlane(toff[32]); if (L >= 4 * total) return false;
        const int rt = L >> 2, ct = L & 3; int e = 0; while (__builtin_amdgcn_readfirstlane(toff[e + 1]) <= rt) ++e;
        u.pm = rt; u.pn = ct; u.kind = e; u.aux = rt - __builtin_amdgcn_readfirstlane(toff[e]);
        u.a = gather ? A : A + (size_t)rt * BM * K * 2; u.b = B + (size_t)e * bstride + (size_t)ct * BM * K * 2; return true; }
    __device__ __forceinline__ void voff(const Unit& u, int K_, const int (&R)[2], const int (&C)[2], unsigned (&vo)[2][2]) const {
        const int n = (int)cnt[64 * u.kind];
#pragma unroll
        for (int h = 0; h < 2; ++h)
#pragma unroll
            for (int i = 0; i < 2; ++i) { int row = R[i] + HALF * h;
                if (gather) { const int r = u.aux * BM + row; row = r < n ? (list[(size_t)u.kind * 16640 + r] >> 1) : 0; }
                vo[h][i] = (unsigned)(row * K_ + C[i]) * 2u; } }
};
}

__device__ __forceinline__ int slot_of(Frame& F, int tok, int k) {
    const LAS int* toff = (const LAS int*)(F.lds + TOFF_OFF);
    const int e = ((const int*)(F.ws + WS_RE))[tok * 2 + k], p = ((const int*)(F.ws + WS_RP))[tok * 2 + k];
    return 256 * toff[e] + p;
}
struct RowRaw { f32x4 h[4]; v2u a[4], b[4], y[4]; float w0, w1; };
struct RowMeta { int s0, s1; float w0, w1; };
__device__ __forceinline__ RowMeta row_meta(Frame& F, int l, int nrows) {
    RowMeta m; m.s0 = 0; m.s1 = 0; m.w0 = 0.f; m.w1 = 0.f;
    const int r = F.gw + F.lane * F.NGW;
    if (l > 0 && r < nrows) { m.s0 = slot_of(F, r, 0); m.s1 = slot_of(F, r, 1); m.w0 = ((const float*)(F.ws + WS_RW))[r * 2]; m.w1 = ((const float*)(F.ws + WS_RW))[r * 2 + 1]; }
    return m;
}
__device__ __forceinline__ void row_issue(Frame& F, int l, int row, const RowMeta& m, int i, RowRaw& r) {
    if (l == 0) { gcf src = row >= M ? INP(1) + (size_t)(row - M) * D : INP(0) + (size_t)row * D;
#pragma unroll
        for (int j = 0; j < 4; ++j) { r.h[j] = ((const f32x4 GAS*)src)[F.lane + 64 * j]; r.a[j] = (v2u){0u, 0u}; r.b[j] = (v2u){0u, 0u}; r.y[j] = (v2u){0u, 0u}; }
        r.w0 = 0.f; r.w1 = 0.f; return; }
    const int s0 = __builtin_amdgcn_readlane(m.s0, i), s1 = __builtin_amdgcn_readlane(m.s1, i);
    r.w0 = __int_as_float(__builtin_amdgcn_readlane(__float_as_int(m.w0), i)); r.w1 = __int_as_float(__builtin_amdgcn_readlane(__float_as_int(m.w1), i));
    const float* hr = (const float*)(F.ws + WS_H) + (size_t)row * D;
    const bf16* y0 = (const bf16*)(F.ws + WS_Y) + (size_t)s0 * D; const bf16* y1 = (const bf16*)(F.ws + WS_Y) + (size_t)s1 * D; const bf16* yb = (const bf16*)(F.ws + WS_YB) + (size_t)row * D;
#pragma unroll
    for (int j = 0; j < 4; ++j) { r.h[j] = ((const f32x4*)hr)[F.lane + 64 * j]; r.a[j] = ((const v2u*)y0)[F.lane + 64 * j]; r.b[j] = ((const v2u*)y1)[F.lane + 64 * j]; r.y[j] = ((const v2u*)yb)[F.lane + 64 * j]; }
}
__device__ __forceinline__ void row_combine(const RowRaw& r, f32x4 (&v)[4]) {
#pragma unroll
    for (int j = 0; j < 4; ++j) v[j] = (r.h[j] + (f32x4){bflo(r.y[j].x), bfhi(r.y[j].x), bflo(r.y[j].y), bfhi(r.y[j].y)}) + r.w0 * (f32x4){bflo(r.a[j].x), bfhi(r.a[j].x), bflo(r.a[j].y), bfhi(r.a[j].y)} + r.w1 * (f32x4){bflo(r.b[j].x), bfhi(r.b[j].x), bflo(r.b[j].y), bfhi(r.b[j].y)};
}
__device__ __forceinline__ void phase_t1(Frame& F, int l) {
    LAS float* wf = (LAS float*)(F.lds);
    { gcf win = INP(3) + (size_t)l * D * INC + 6144;
      float t[32];
#pragma unroll
      for (int u = 0; u < 32; ++u) { const int i = F.tid + u * (NWAVES * 64); t[u] = win[(size_t)(i >> 4) * INC + (i & 15)]; }
#pragma unroll
      for (int u = 0; u < 32; ++u) wf[(F.tid & 15) * D + (F.tid >> 4) + 32 * u] = t[u]; }
    if (l > 0) build_toff(F, l - 1); else __syncthreads();
    gcf g1 = INP(2) + (size_t)l * D; gcf bfg = INP(4) + l * 16;
    float* H = (float*)(F.ws + WS_H); bf16* XN = (bf16*)(F.ws + WS_XN); float* FL = (float*)(F.ws + WS_FL); float* HNM = (float*)(F.ws + WS_HNM);
#ifndef REP_ROWS
#define REP_ROWS 0
#endif
    for (int rr_ = (l == 0 ? REP_ROWS : 0); rr_ >= 0; --rr_)
    { const RowMeta meta = row_meta(F, l, NTOK); const int nr = (NTOK - F.gw + F.NGW - 1) / F.NGW; RowRaw cur; row_issue(F, l, F.gw, meta, 0, cur);
    for (int ri = 0; ri < nr; ++ri) { const int row = F.gw + ri * F.NGW;
        RowRaw nxt = cur; if (ri + 1 < nr) row_issue(F, l, row + F.NGW, meta, ri + 1, nxt);
        f32x4 v[4]; row_combine(cur, v); cur = nxt;
        float ss = 0.f;
#pragma unroll
        for (int j = 0; j < 4; ++j) { ((f32x4*)(H + (size_t)row * D))[F.lane + 64 * j] = v[j]; ss += (v[j].x * v[j].x + v[j].y * v[j].y) + (v[j].z * v[j].z + v[j].w * v[j].w); }
        const float rstd = __builtin_amdgcn_rsqf(wave_sum(ss) * (1.f / D) + EPS);
#pragma unroll
        for (int j = 0; j < 4; ++j) { v[j] = v[j] * rstd * ((const f32x4 GAS*)g1)[F.lane + 64 * j];
            v2u o; o.x = pk2(v[j].x, v[j].y); o.y = pk2(v[j].z, v[j].w); ((v2u*)(XN + (size_t)row * D))[F.lane + 64 * j] = o;
            if (row >= M) ((f32x4*)(HNM + (size_t)(row - M) * D))[F.lane + 64 * j] = v[j]; }
        float mine = 0.f;
#pragma unroll 1
        for (int jg = 0; jg < 16; jg += 4) { float s4[4];
#pragma unroll
            for (int q = 0; q < 4; ++q) { float s = 0.f;
#pragma unroll
                for (int j = 0; j < 4; ++j) { const f32x4 w = *(const LAS f32x4*)(wf + (jg + q) * D + 4 * F.lane + 256 * j); s += (v[j].x * w.x + v[j].y * w.y) + (v[j].z * w.z + v[j].w * w.w); }
                s4[q] = s; }
#pragma unroll
            for (int q = 0; q < 4; ++q) s4[q] = pg8::row16_sum(s4[q]);
#pragma unroll
            for (int o = 16; o < 64; o <<= 1) {
#pragma unroll
                for (int q = 0; q < 4; ++q) s4[q] += pg8::shx(s4[q], o, F.lane); }
#pragma unroll
            for (int q = 0; q < 4; ++q) mine = (F.lane == jg + q) ? s4[q] : mine; }
        if (F.lane < 16) { const float f = mine + bfg[F.lane]; FL[(size_t)row * 16 + F.lane] = fminf(f, 0.f) * LOG2E - __builtin_amdgcn_logf(1.0f + __builtin_amdgcn_exp2f(-fabsf(f) * LOG2E)); }
    } }
    LAS float* scr = (LAS float*)(F.lds + 65536 + F.wave * 8448);
#ifndef REP_CONV
#define REP_CONV 0
#endif
    for (int rc = 0; rc <= REP_CONV; ++rc) {
    if (l == 0) {
        for (int it = F.gw; it < 2 * IT_DENSE; it += F.NGW) conv_dense_item(F, it / IT_DENSE, it % IT_DENSE, scr);
    }
    for (int it = F.gw; it < IT_EXPL; it += F.NGW) conv_expert_item(F, l, it, scr);
    }
}
__device__ __forceinline__ LAS float* meta_slice(Frame& F, const float* A, gcf W, int ld, int col0, int slot) {
    LAS float* Al = (LAS float*)F.lds; LAS float* red = (LAS float*)(F.lds + 65536); LAS float* out = (LAS float*)(F.lds + 98304 + 4096 * slot);
    __syncthreads();
    { float t[32];
#pragma unroll
      for (int u = 0; u < 32; ++u) t[u] = A[F.tid + u * (NWAVES * 64)];
#pragma unroll
      for (int u = 0; u < 32; ++u) Al[(F.tid + 512 * (u & 1)) * 16 + (u >> 1)] = t[u]; }
    __syncthreads();
    float acc[16];
#pragma unroll
    for (int r = 0; r < 16; ++r) acc[r] = 0.f;
    gcf wp = W + col0 + F.lane; const int k0 = F.wave * 128;
#pragma unroll 1
    for (int kb = k0; kb < k0 + 128; kb += 32) { float w[32];
#pragma unroll
        for (int u = 0; u < 32; ++u) w[u] = wp[(size_t)(kb + u) * ld];
#pragma unroll
        for (int u = 0; u < 32; ++u) {
#pragma unroll
            for (int q = 0; q < 4; ++q) { const f32x4 a = *(const LAS f32x4*)(Al + (kb + u) * 16 + 4 * q); acc[4 * q] += a.x * w[u]; acc[4 * q + 1] += a.y * w[u]; acc[4 * q + 2] += a.z * w[u]; acc[4 * q + 3] += a.w * w[u]; } } }
#pragma unroll
    for (int r = 0; r < 16; ++r) red[(F.wave * 16 + r) * 64 + F.lane] = acc[r];
    __syncthreads();
#pragma unroll
    for (int q = 0; q < 2; ++q) { const int o = F.tid * 2 + q; float s = 0.f;
#pragma unroll
        for (int g = 0; g < 8; ++g) s += red[g * 1024 + o];
        out[o] = s; }
    __syncthreads();
    return out;
}
__device__ __forceinline__ void g1_side(Frame& F, int l) {
    const float* FL = (const float*)(F.ws + WS_FL);
    int c = (int)blockIdx.x - 128;
    if (c >= 0 && c < 32) {
        const int b = c >> 4, h = c & 15; LAS float* wsum = (LAS float*)(F.lds);
        float x[16]; float run = 0.f;
#pragma unroll
        for (int i = 0; i < 16; ++i) { run += FL[((size_t)b * SEQ + F.tid * 16 + i) * 16 + h]; x[i] = run; }
        float inc = run;
#pragma unroll
        for (int o = 1; o < 64; o <<= 1) { const float t = __int_as_float(__builtin_amdgcn_ds_bpermute(((F.lane - o) & 63) << 2, __float_as_int(inc))); if (F.lane >= o) inc += t; }
        if (F.lane == 63) wsum[F.wave] = inc;
        __syncthreads();
        float base = inc - run;
        for (int w = 0; w < F.wave; ++w) base += wsum[w];
        float* CB = (float*)(F.ws + WS_CB) + (size_t)c * SEQ + F.tid * 16;
#pragma unroll
        for (int i = 0; i < 16; ++i) CB[i] = base + x[i];
        if (c < 16 && F.tid == 0) { float cm[16]; float r2 = 0.f;
#pragma unroll
            for (int j = 0; j < 16; ++j) { r2 += FL[(size_t)(MROW + j) * 16 + c]; cm[j] = r2; }
#pragma unroll
            for (int j = 0; j < 16; ++j) ((float*)(F.ws + WS_CBM))[c * 16 + j] = cm[j] - r2; }
        __syncthreads();
    }
    c = (int)blockIdx.x;
    if (c < 128) {
        const int col0 = c < 96 ? 64 * c : 6160 + 64 * (c - 96);
        LAS float* out = meta_slice(F, (const float*)(F.ws + WS_HNM), INP(3) + (size_t)l * D * INC, INC, col0, 0);
        float* PM = (float*)(F.ws + WS_PM);
#pragma unroll
        for (int rr = 0; rr < 2; ++rr) { const int r = 2 * F.wave + rr; float v = out[r * 64 + F.lane];
            if (col0 >= 3072 && col0 < 5120) { const float ss = wave_sum(v * v); const float g = (col0 < 4096 ? INP(7) : INP(8))[l * 64 + F.lane]; v = v * __builtin_amdgcn_rsqf(ss * (1.f / 64.f) + EPS) * g; }
            if (col0 >= 6160) v = pg8::sigmoidf_fast(v);
            PM[(size_t)r * INC + col0 + F.lane] = v;
            if (col0 >= 4096 && col0 < 5120) ((bf16*)(F.ws + WS_K))[(size_t)(MROW + r) * D + (col0 - 4096) + F.lane] = (bf16)f2bf(v);
            if (col0 >= 5120 && col0 < 6144) ((bf16*)(F.ws + WS_V))[(size_t)(MROW + r) * D + (col0 - 5120) + F.lane] = (bf16)f2bf(v); }
        __syncthreads();
    }
}
__device__ __forceinline__ void a1_side(Frame& F, int l) {
    gcf cw = INP(5) + (size_t)l * 3 * D; const float* PM = (const float*)(F.ws + WS_PM);
    const bf16* Z = (const bf16*)(F.ws + WS_Z); const bf16* BG = (const bf16*)(F.ws + WS_BG); bf16* YAIN = (bf16*)(F.ws + WS_YAIN);
    for (int ci = F.gw; ci < M / 8; ci += F.NGW) {
        const int m0 = ci * 8, t0 = m0 & (SEQ - 1);
#pragma unroll
        for (int j = 0; j < 2; ++j) { const int d0 = 8 * F.lane + 512 * j;
            float w0[8], w1[8], w2[8], zp2[8], zp1[8];
#pragma unroll
            for (int i = 0; i < 8; ++i) { w0[i] = cw[d0 + i]; w1[i] = cw[D + d0 + i]; w2[i] = cw[2 * D + d0 + i]; }
            if (t0 == 0) {
#pragma unroll
                for (int i = 0; i < 8; ++i) { zp2[i] = PM[(size_t)14 * INC + 1024 + d0 + i] * PM[(size_t)14 * INC + 2048 + d0 + i]; zp1[i] = PM[(size_t)15 * INC + 1024 + d0 + i] * PM[(size_t)15 * INC + 2048 + d0 + i]; }
            } else { const v4u a = *(const v4u*)(Z + (size_t)(m0 - 2) * D + d0), b = *(const v4u*)(Z + (size_t)(m0 - 1) * D + d0);
                zp2[0] = bflo(a.x); zp2[1] = bfhi(a.x); zp2[2] = bflo(a.y); zp2[3] = bfhi(a.y); zp2[4] = bflo(a.z); zp2[5] = bfhi(a.z); zp2[6] = bflo(a.w); zp2[7] = bfhi(a.w);
                zp1[0] = bflo(b.x); zp1[1] = bfhi(b.x); zp1[2] = bflo(b.y); zp1[3] = bfhi(b.y); zp1[4] = bflo(b.z); zp1[5] = bfhi(b.z); zp1[6] = bflo(b.w); zp1[7] = bfhi(b.w); }
            v4u zr[8], gr[8];
#pragma unroll
            for (int r = 0; r < 8; ++r) { zr[r] = *(const v4u*)(Z + (size_t)(m0 + r) * D + d0); gr[r] = *(const v4u*)(BG + (size_t)(m0 + r) * D + d0); }
#pragma unroll
            for (int r = 0; r < 8; ++r) { const v4u zz = zr[r], gg = gr[r];
                float z[8], g[8], y[8];
                z[0] = bflo(zz.x); z[1] = bfhi(zz.x); z[2] = bflo(zz.y); z[3] = bfhi(zz.y); z[4] = bflo(zz.z); z[5] = bfhi(zz.z); z[6] = bflo(zz.w); z[7] = bfhi(zz.w);
                g[0] = bflo(gg.x); g[1] = bfhi(gg.x); g[2] = bflo(gg.y); g[3] = bfhi(gg.y); g[4] = bflo(gg.z); g[5] = bfhi(gg.z); g[6] = bflo(gg.w); g[7] = bfhi(gg.w);
#pragma unroll
                for (int i = 0; i < 8; ++i) { y[i] = g[i] * (w0[i] * zp2[i] + w1[i] * zp1[i] + w2[i] * z[i]); zp2[i] = zp1[i]; zp1[i] = z[i]; }
                v4u o; o.x = pk2(y[0], y[1]); o.y = pk2(y[2], y[3]); o.z = pk2(y[4], y[5]); o.w = pk2(y[6], y[7]);
                *(GAS v4u*)(YAIN + (size_t)(m0 + r) * D + d0) = o; }
        }
    }
}
__device__ __forceinline__ void g2_side(Frame& F, int l) {
    if (blockIdx.x >= 16) return;
    const int col0 = 64 * blockIdx.x; const float* PM = (const float*)(F.ws + WS_PM);
    LAS float* ya = meta_slice(F, (const float*)(F.ws + WS_YAINM), INP(6) + (size_t)l * D * D, D, col0, 0);
    LAS float* yb = meta_slice(F, (const float*)(F.ws + WS_OM), INP(9) + (size_t)l * D * D, D, col0, 1);
#pragma unroll
    for (int q = 0; q < 2; ++q) { const int o = F.tid * 2 + q, r = o >> 6, cc = o & 63;
        ((float*)(F.ws + WS_MGM))[(size_t)r * D + col0 + cc] = PM[(size_t)r * INC + 6160 + col0 + cc] * ya[o] + PM[(size_t)r * INC + 7184 + col0 + cc] * yb[o]; }
    __syncthreads();
}
__device__ __forceinline__ void g3_side(Frame& F, int l) {
    if (blockIdx.x >= 16) return;
    const int col0 = 64 * blockIdx.x;
    LAS float* y = meta_slice(F, (const float*)(F.ws + WS_MGM), INP(10) + (size_t)l * D * D, D, col0, 0);
#pragma unroll
    for (int q = 0; q < 2; ++q) { const int o = F.tid * 2 + q, r = o >> 6, cc = o & 63; ((bf16*)(F.ws + WS_YB))[(size_t)(MROW + r) * D + col0 + cc] = (bf16)f2bf(y[o]); }
    __syncthreads();
}
__device__ __forceinline__ void phase_t2(Frame& F, int l, int bank, size_t dump) {
    LAS float* wr = (LAS float*)F.lds;
    { gcf wg = INP(12) + (size_t)l * D * 4; gcf we = INP(14) + (size_t)l * D * NE;
#pragma unroll 1
      for (int b0 = 0; b0 < 64; b0 += 16) { float t[16];
#pragma unroll
          for (int u = 0; u < 16; ++u) t[u] = we[F.tid + (b0 + u) * (NWAVES * 64)];
#pragma unroll
          for (int u = 0; u < 16; ++u) wr[((F.tid >> 5) + 16 * (b0 + u)) * 36 + 4 + (F.tid & 31)] = t[u]; }
      { float t[8];
#pragma unroll
          for (int u = 0; u < 8; ++u) t[u] = wg[F.tid + u * (NWAVES * 64)];
#pragma unroll
          for (int u = 0; u < 8; ++u) wr[((F.tid >> 2) + 128 * u) * 36 + (F.tid & 3)] = t[u]; } }
    LAS int* lcnt = (LAS int*)(F.lds + 147456); LAS int* lbase = lcnt + 32; LAS int* rec = lbase + 32; LAS float* recw = (LAS float*)(rec + 80 * 4);
    if (F.tid < 32) lcnt[F.tid] = 0;
    __syncthreads();
    gcf g2 = INP(11) + (size_t)l * D; gcf bg = INP(13) + l * 4; gcf be = INP(15) + l * NE;
    const float* H = (const float*)(F.ws + WS_H); bf16* XN = (bf16*)(F.ws + WS_XN); const bf16* YB = (const bf16*)(F.ws + WS_YB);
    const int c = blockIdx.x, npair = (c < 16 && F.wave == 0) ? 5 : 4;
    for (int it = 0; it < npair; ++it) {
        int sl[2], row[2];
        if (it < 4) { sl[0] = 8 * F.wave + 2 * it; sl[1] = sl[0] + 1; row[0] = 64 * c + sl[0]; row[1] = row[0] + 1; } else { sl[0] = 64; sl[1] = 64; row[0] = MROW + c; row[1] = MROW + c; }
        float hn[2][16], ss[2] = {0.f, 0.f};
#pragma unroll
        for (int r = 0; r < 2; ++r)
#pragma unroll
            for (int jj = 0; jj < 16; ++jj) { hn[r][jj] = H[(size_t)row[r] * D + F.lane + 64 * jj] + __uint_as_float((unsigned)YB[(size_t)row[r] * D + F.lane + 64 * jj] << 16); ss[r] += hn[r][jj] * hn[r][jj]; }
        ss[0] = pg8::row16_sum(ss[0]); ss[1] = pg8::row16_sum(ss[1]);
#pragma unroll
        for (int o = 16; o < 64; o <<= 1) { const float t0 = pg8::shx(ss[0], o, F.lane), t1 = pg8::shx(ss[1], o, F.lane); ss[0] += t0; ss[1] += t1; }
        float acc[2][36];
#pragma unroll
        for (int r = 0; r < 2; ++r) { const float rstd = __builtin_amdgcn_rsqf(ss[r] * (1.f / D) + EPS);
#pragma unroll
            for (int jj = 0; jj < 16; ++jj) { hn[r][jj] = hn[r][jj] * rstd * g2[F.lane + 64 * jj]; XN[(size_t)row[r] * D + F.lane + 64 * jj] = (bf16)f2bf(hn[r][jj]); }
#pragma unroll
            for (int q = 0; q < 36; ++q) acc[r][q] = 0.f; }
        { f32x4 wn[9];
#pragma unroll
          for (int q = 0; q < 9; ++q) wn[q] = *(const LAS f32x4*)(wr + F.lane * 36 + 4 * q);
#pragma unroll
          for (int jj = 0; jj < 16; ++jj) { f32x4 w[9];
#pragma unroll
            for (int q = 0; q < 9; ++q) w[q] = wn[q];
            if (jj < 15) {
#pragma unroll
                for (int q = 0; q < 9; ++q) wn[q] = *(const LAS f32x4*)(wr + (F.lane + 64 * (jj + 1)) * 36 + 4 * q); }
#pragma unroll
            for (int r = 0; r < 2; ++r)
#pragma unroll
                for (int q = 0; q < 9; ++q) { acc[r][4 * q] += hn[r][jj] * w[q].x; acc[r][4 * q + 1] += hn[r][jj] * w[q].y; acc[r][4 * q + 2] += hn[r][jj] * w[q].z; acc[r][4 * q + 3] += hn[r][jj] * w[q].w; }
            asm volatile("" ::: "memory"); } }
#pragma unroll
        for (int r = 0; r < 2; ++r)
#pragma unroll
            for (int q = 0; q < 36; ++q) acc[r][q] = pg8::row16_sum(acc[r][q]);
#pragma unroll
        for (int o = 16; o < 64; o <<= 1) {
            float t[2][36];
#pragma unroll
            for (int r = 0; r < 2; ++r)
#pragma unroll
                for (int q = 0; q < 36; ++q) t[r][q] = pg8::shx(acc[r][q], o, F.lane);
#pragma unroll
            for (int r = 0; r < 2; ++r)
#pragma unroll
                for (int q = 0; q < 36; ++q) acc[r][q] += t[r][q]; }
#pragma unroll
        for (int r = 0; r < 2; ++r) {
            if (r == 1 && it == 4) break;
            float gl[4]; int gi = 0;
#pragma unroll
            for (int j = 0; j < 4; ++j) gl[j] = acc[r][j] + bg[j];
            float gb = gl[0];
#pragma unroll
            for (int j = 1; j < 4; ++j) if (gl[j] > gb) { gb = gl[j]; gi = j; }
            float gs = 0.f;
#pragma unroll
            for (int j = 0; j < 4; ++j) gs += __builtin_amdgcn_exp2f((gl[j] - gb) * LOG2E);
            const float gw = 1.f / gs;
            float el[8];
#pragma unroll
            for (int j = 0; j < 8; ++j) el[j] = (gi == 0 ? acc[r][4 + j] : gi == 1 ? acc[r][12 + j] : gi == 2 ? acc[r][20 + j] : acc[r][28 + j]) + be[gi * 8 + j];
            int i1 = 0; float b1 = el[0];
#pragma unroll
            for (int j = 1; j < 8; ++j) if (el[j] > b1) { b1 = el[j]; i1 = j; }
            int i2 = -1; float b2 = -INFINITY;
#pragma unroll
            for (int j = 0; j < 8; ++j) if (j != i1 && (i2 < 0 || el[j] > b2)) { b2 = el[j]; i2 = j; }
            const float p2 = __builtin_amdgcn_exp2f((b2 - b1) * LOG2E), w1 = gw / (1.f + p2), w2 = gw * p2 / (1.f + p2);
            if (F.lane == 0) { const int e1 = gi * 8 + i1, e2 = gi * 8 + i2, s_ = sl[r];
                rec[s_ * 4 + 0] = e1; rec[s_ * 4 + 1] = __hip_atomic_fetch_add(lcnt + e1, 1, __ATOMIC_RELAXED, __HIP_MEMORY_SCOPE_WORKGROUP);
                rec[s_ * 4 + 2] = e2; rec[s_ * 4 + 3] = __hip_atomic_fetch_add(lcnt + e2, 1, __ATOMIC_RELAXED, __HIP_MEMORY_SCOPE_WORKGROUP);
                recw[s_ * 2] = w1; recw[s_ * 2 + 1] = w2; }
        }
    }
    __syncthreads();
    int tid2; asm volatile("v_mbcnt_lo_u32_b32 %0, -1, 0\n\tv_mbcnt_hi_u32_b32 %0, -1, %0" : "=v"(tid2)); tid2 += F.wave * 64;
    if (tid2 < 32) { const int n = lcnt[tid2]; lbase[tid2] = n ? (int)__hip_atomic_fetch_add(F.ctl + CW_CNT + 64 * (32 * bank + tid2), (unsigned)n, RLX_AGENT) : 0; }
    __syncthreads();
    if (tid2 < 65 && (tid2 < 64 || c < 16)) { const int sl = tid2, tok = sl < 64 ? 64 * c + sl : MROW + c;
#pragma unroll
        for (int k = 0; k < 2; ++k) { const int e = rec[sl * 4 + 2 * k], pos = lbase[e] + rec[sl * 4 + 2 * k + 1];
            ((int*)(F.ws + dump + WS_LIST))[(size_t)e * MP + pos] = 2 * tok + k; ((int*)(F.ws + dump + WS_RE))[2 * tok + k] = e; ((int*)(F.ws + dump + WS_RP))[2 * tok + k] = pos; ((float*)(F.ws + dump + WS_RW))[2 * tok + k] = recw[sl * 2 + k]; } }
}
__device__ __forceinline__ void a1_meta(Frame& F, int l) {
    if (blockIdx.x >= 16) return;
    const int h = blockIdx.x; gcf cw = INP(5) + (size_t)l * 3 * D; const float* PM = (const float*)(F.ws + WS_PM);
    float* YAINM = (float*)(F.ws + WS_YAINM); float* OM = (float*)(F.ws + WS_OM); const float* CBM = (const float*)(F.ws + WS_CBM);
#pragma unroll
    for (int q2 = 0; q2 < 2; ++q2) { const int o = F.tid * 2 + q2, r = o >> 6, d = 64 * h + (o & 63); float y = 0.f;
#pragma unroll
        for (int q = 0; q < 3; ++q) { const int rr = r - 2 + q; if (rr >= 0) y += PM[(size_t)rr * INC + 1024 + d] * PM[(size_t)rr * INC + 2048 + d] * cw[q * D + d]; }
        YAINM[(size_t)r * D + d] = PM[(size_t)r * INC + d] * y; }
    LAS float* sc = (LAS float*)F.lds;
    __syncthreads();
    if (F.tid < 256) { const int r = F.tid >> 4, s = F.tid & 15; const f32x4* q = (const f32x4*)(PM + (size_t)r * INC + 3072 + 64 * h); const f32x4* k = (const f32x4*)(PM + (size_t)s * INC + 4096 + 64 * h); float dsum = 0.f;
#pragma unroll
        for (int d = 0; d < 16; ++d) { const f32x4 a = q[d], b = k[d]; dsum += (a.x * b.x + a.y * b.y) + (a.z * b.z + a.w * b.w); }
        sc[F.tid] = (s <= r) ? dsum * attn_body::C2 + (CBM[h * 16 + r] - CBM[h * 16 + s]) : -INFINITY; }
    __syncthreads();
    if (F.tid < 16) { float mx = -INFINITY, ls = 0.f;
#pragma unroll
        for (int s = 0; s < 16; ++s) mx = fmaxf(mx, sc[F.tid * 16 + s]);
        float p[16];
#pragma unroll
        for (int s = 0; s < 16; ++s) { p[s] = __builtin_amdgcn_exp2f(sc[F.tid * 16 + s] - mx); ls += p[s]; }
        const float il = 1.f / ls;
#pragma unroll
        for (int s = 0; s < 16; ++s) sc[F.tid * 16 + s] = p[s] * il; }
    __syncthreads();
#pragma unroll
    for (int q2 = 0; q2 < 2; ++q2) { const int o = F.tid * 2 + q2, r = o >> 6, d = o & 63; float acc = 0.f;
#pragma unroll
        for (int s = 0; s < 16; ++s) acc += sc[r * 16 + s] * PM[(size_t)s * INC + 5120 + 64 * h + d];
        OM[(size_t)r * D + 64 * h + d] = acc; }
    __syncthreads();
}
__device__ __forceinline__ void phase_attn(Frame& F, int l, int qbank, char* lds_generic) {
    const float mq = wave_max(fabsf(INP(7)[l * 64 + F.lane])), mk = wave_max(fabsf(INP(8)[l * 64 + F.lane]));
    const float m0 = 8.f * LOG2E * mq * mk * 1.02f + 0.25f;
    const float TH = 2.f * m0 + 40.f;
    const attn_body::bf16* Q = (const attn_body::bf16*)(F.ws + WS_Q); const attn_body::bf16* K = (const attn_body::bf16*)(F.ws + WS_K); const attn_body::bf16* V = (const attn_body::bf16*)(F.ws + WS_V);
    volatile LAS int* qslot = (volatile LAS int*)(F.lds + LDSCTL_OFF + 640);
    gu32* qhead = F.ctl + CW_AQ + 64 * qbank;
    if (F.tid == 0) *qslot = (int)__hip_atomic_fetch_add(qhead, 1u, RLX_AGENT);
    __syncthreads();
    int p = __builtin_amdgcn_readfirstlane(*qslot);
    while (p < 1024) {
        int pnext = 0; if (F.tid == 0) pnext = (int)__hip_atomic_fetch_add(qhead, 1u, RLX_AGENT);
        const int qb = 31 - (p >> 5), bh = p & 31; const float* cbh = (const float*)(F.ws + WS_CB) + (size_t)bh * SEQ;
        attn_body::attn_unit(F.tid, bh >> 4, bh & 15, qb, TH, Q, K, V, (attn_body::bf16*)(F.ws + WS_XN), cbh, (const float*)(F.ws + WS_CBM) + (bh & 15) * 16, m0, lds_generic);
        if (F.tid == 0) *qslot = pnext;
        asm volatile("s_waitcnt vmcnt(0) lgkmcnt(0)\n\ts_barrier" ::: "memory");
        p = __builtin_amdgcn_readfirstlane(*qslot);
    }
}
__device__ __forceinline__ void phase_out(Frame& F) {
    build_toff(F, 1);
#ifdef PROBE_PH
    const float pscale = 1.0f + 0.1f * rintf((float)(unsigned)(__hip_atomic_load((GAS unsigned long long*)(F.ctl + 32) + (PROBE_PH + 1), RLX_AGENT) - __hip_atomic_load((GAS unsigned long long*)(F.ctl + 32) + PROBE_PH, RLX_AGENT)) * (1.0f / (100.0f * PROBE_DIV)));
#else
    const float pscale = 1.0f;
#endif
    { const RowMeta meta = row_meta(F, 1, M); const int nr = (M - F.gw + F.NGW - 1) / F.NGW; RowRaw cur; row_issue(F, 1, F.gw, meta, 0, cur);
    for (int ri = 0; ri < nr; ++ri) { const int row = F.gw + ri * F.NGW;
        RowRaw nxt = cur; if (ri + 1 < nr) row_issue(F, 1, row + F.NGW, meta, ri + 1, nxt);
        f32x4 v[4]; row_combine(cur, v); cur = nxt;
#pragma unroll
        for (int j = 0; j < 4; ++j) ((f32x4*)(F.out + (size_t)row * D))[F.lane + 64 * j] = v[j] * pscale; } }
}

#ifndef MK_N_LAUNCHES
#define MK_N_LAUNCHES 1
#endif
constexpr int N_PHASES = 17;
struct Args { const float* in[19]; float* out; unsigned char* ws; int ph_lo, ph_hi, li, two; };
__global__ void __launch_bounds__(NWAVES * 64, 2) fwd_kernel(Args args) {
    extern __shared__ __attribute__((aligned(16))) unsigned char lds[];
    Frame F;
    F.lds = (LAS unsigned char*)lds; F.MISC = (volatile LAS unsigned*)(F.lds + MISC_OFF);
    F.tid = threadIdx.x; F.lane = F.tid & 63; F.wave = __builtin_amdgcn_readfirstlane(F.tid >> 6);
    F.G = gridDim.x; { const int bx = blockIdx.x; F.vcu = (F.G % 8 == 0) ? (bx % 8) * (F.G / 8) + bx / 8 : bx; }
    F.gw = F.vcu * NWAVES + F.wave; F.NGW = F.G * NWAVES;
    F.ws = args.ws; F.ctl = (gu32*)(args.ws + WS_CTL); F.out = args.out;
    for (int u = F.tid; u < (LDS_BYTES - LDSCTL_OFF) / 4; u += NWAVES * 64) ((LAS unsigned*)(F.lds + LDSCTL_OFF))[u] = 0u;
    __syncthreads();
    XcdBarrier bar = xcd_barrier_post((unsigned*)(F.ctl + CW_BAR) + args.li * XCD_BAR_WORDS, F.MISC + 8);
#ifdef PROBE_PH
    if (blockIdx.x == 0 && F.tid == 0) __hip_atomic_store((GAS unsigned long long*)(F.ctl + 32), __builtin_amdgcn_s_memrealtime(), RLX_AGENT);
#endif
    const int lo = args.ph_lo, hi = args.ph_hi; int ph = 0; const int wave_s = F.wave;
#ifndef REP_PH
#define REP_PH (-1)
#endif
#ifndef REP_N
#define REP_N 0
#endif
#ifndef SUBMASK
#define SUBMASK 7
#endif
#ifndef PHMASK
#define PHMASK 0x1ff
#endif
#if defined(PROBE_PH) || defined(MK_PROBE_BUILD) || defined(MK_PREFIX_PROBE) || (MK_N_LAUNCHES != 1) || (REP_PH >= 0) || (REP_BAR > 0)
#define PHB(k) if (((PHMASK >> (k)) & 1) && lo <= ph && ph < hi) { for (int rep_ = (ph == REP_PH ? REP_N : 0); rep_ >= 0; --rep_) { { int ot_; asm volatile("v_mbcnt_lo_u32_b32 %0, -1, 0\n\tv_mbcnt_hi_u32_b32 %0, -1, %0" : "=v"(ot_)); ot_ += wave_s * 64; F.tid = ot_; F.lane = ot_ & 63; F.wave = __builtin_amdgcn_readfirstlane(ot_ >> 6); F.gw = F.vcu * NWAVES + F.wave; size_t z_ = 0; asm volatile("" : "+s"(z_)); F.ws = args.ws + z_; F.ctl = (gu32*)(F.ws + WS_CTL); }
#else
#define PHB(k) { constexpr int rep_ = 0; (void)rep_; { int ot_; asm volatile("v_mbcnt_lo_u32_b32 %0, -1, 0\n\tv_mbcnt_hi_u32_b32 %0, -1, %0" : "=v"(ot_)); ot_ += wave_s * 64; F.tid = ot_; F.lane = ot_ & 63; F.wave = __builtin_amdgcn_readfirstlane(ot_ >> 6); F.gw = F.vcu * NWAVES + F.wave; size_t z_ = 0; asm volatile("" : "+s"(z_)); F.ws = args.ws + z_; F.ctl = (gu32*)(F.ws + WS_CTL); }
#endif
#ifdef PROBE_PH
#define PH_STAMP() do { if (blockIdx.x == 0 && F.tid == 0) __hip_atomic_store((GAS unsigned long long*)(F.ctl + 32) + (ph + 1), __builtin_amdgcn_s_memrealtime(), RLX_AGENT); } while (0)
#else
#define PH_STAMP() do {} while (0)
#endif
#ifndef EPI_SKIP_REP
#define EPI_SKIP_REP 0
#endif
#ifndef REP_BAR
#define REP_BAR 0
#endif
#if defined(PROBE_PH) || defined(MK_PROBE_BUILD) || defined(MK_PREFIX_PROBE) || (MK_N_LAUNCHES != 1) || (REP_PH >= 0) || (REP_BAR > 0)
#define PH_END   } if (ph + 1 < hi) xcd_barrier(bar); if (REP_BAR > 0 && ph == 3) { for (int rb_ = 0; rb_ < REP_BAR; ++rb_) xcd_barrier(bar); } PH_STAMP(); } ++ph;
#define PH_END_LAST PH_END
#else
#define PH_END   xcd_barrier(bar); }
#define PH_END_LAST }
#endif
    if (lo == 0) {
        for (int i = F.gw * 64 + F.lane; i < 2 * 64 * D / 8; i += F.NGW * 64) { const int wbuf = i / (64 * D / 8), r = i % (64 * D / 8);
            ((GAS v4u*)(F.ws + (wbuf ? WS_V : WS_K) + (size_t)MROW * D * 2))[r] = (v4u){0u, 0u, 0u, 0u}; } }
    for (int l = 0; l < DEPTH; ++l) {
        unsigned char* wl = F.ws + WS_WD0 + (size_t)l * WD_LAYER;
        PHB(0) phase_t1(F, l); PH_END
        PHB(1) if (SUBMASK & 1) g1_side(F, l); if (SUBMASK & 2)
            { pg8::SchedDense S{(const char*)(F.ws + WS_XN), (const char*)wl, 64, 32, F.G, (int)blockIdx.x, D};
              pg8::EpiG1 E{(bf16*)(F.ws + WS_ACT), ACT_STRIDE / 2, INP(7) + l * 64, attn_body::C2, EPI_SKIP_REP ? (int)(rep_ > 0) : 0, (long)(INP(8) - INP(7))};
              pg8::gemm_phase<pg8::EpiG1, pg8::SchedDense, true>(F.tid, F.lds + RING_OFF, D, S, E); }
        PH_END
        PHB(2) if (SUBMASK & 1) a1_side(F, l); if (SUBMASK & 2) a1_meta(F, l); if (SUBMASK & 4) phase_attn(F, l, l + 2 * rep_, (char*)lds + RING_OFF); PH_END
        PHB(3) if (SUBMASK & 1) g2_side(F, l); if (SUBMASK & 2)
            { pg8::SchedPair S{(const char*)(F.ws + WS_YAIN), (const char*)(wl + WO_WC), (long)WS_XN - (long)WS_YAIN, (long)WO_WA - (long)WO_WC, (int)blockIdx.x, args.two};
              pg8::EpiG2 E{(bf16*)(F.ws + WS_MG), (const bf16*)(F.ws + WS_SGA), ACT_STRIDE / 2};
              if (blockIdx.x < 256) pg8::gemm_phase<pg8::EpiG2, pg8::SchedPair, true>(F.tid, F.lds + RING_OFF, D, S, E); }
        PH_END
        PHB(4) g3_side(F, l);
            { pg8::SchedDense S{(const char*)(F.ws + WS_MG), (const char*)(wl + WO_WM), 64, 4, F.G, (int)blockIdx.x, D};
              pg8::EpiG3 E{(bf16*)(F.ws + WS_YB)};
              pg8::gemm_phase<pg8::EpiG3, pg8::SchedDense, true>(F.tid, F.lds + RING_OFF, D, S, E); }
        PH_END
        PHB(5) phase_t2(F, l, l + 2 * (int)(rep_ > 0), (size_t)(rep_ > 0) << 23); PH_END
        PHB(6) build_toff(F, l);
            { pg8::SchedMoe S{(const char*)(F.ws + WS_XN), (const char*)(F.ws + WS_WGU), (const int*)(F.ws + WS_LIST), (const unsigned*)(F.ctl + CW_CNT + 64 * 32 * l), (const LAS int*)(F.lds + TOFF_OFF), F.G, F.vcu, D, (size_t)D * D * 2, true};
              pg8::EpiM1 E{(bf16*)(F.ws + WS_HACT)};
              pg8::gemm_phase<pg8::EpiM1, pg8::SchedMoe, true>(F.tid, F.lds + RING_OFF, D, S, E); }
        PH_END
        PHB(7) build_toff(F, l);
            { pg8::SchedMoe S{(const char*)(F.ws + WS_HACT), (const char*)(F.ws + WS_WDN), (const int*)(F.ws + WS_LIST), (const unsigned*)(F.ctl + CW_CNT + 64 * 32 * l), (const LAS int*)(F.lds + TOFF_OFF), F.G, F.vcu, DE, (size_t)D * DE * 2, false};
              pg8::EpiM2 E{(bf16*)(F.ws + WS_Y)};
              pg8::gemm_phase<pg8::EpiM2, pg8::SchedMoe, true>(F.tid, F.lds + RING_OFF, DE, S, E); }
        PH_END
    }
    PHB(8) phase_out(F); PH_END_LAST
#undef PHB
#undef PH_END
#undef PH_END_LAST
}

extern "C" void kernel_launch(void* const* d_in, const int* in_sizes, int n_in, void* d_out, int out_size, void* d_ws, size_t ws_size, hipStream_t stream) {
    static int grid = 0;
    if (grid == 0) {
        if (n_in != 19 || in_sizes[0] != M * D || out_size != M * D || ws_size < WS_END) { fprintf(stderr, "kernel_launch: unexpected shapes / workspace (n_in %d, in0 %d, out %d, ws %zu, need %zu); nothing launched\n", n_in, n_in > 0 ? in_sizes[0] : -1, out_size, ws_size, (size_t)WS_END); grid = -1; return; }
        int dev = 0, cus = 0, per_cu = 0;
        if (hipGetDevice(&dev) != hipSuccess || hipDeviceGetAttribute(&cus, hipDeviceAttributeMultiprocessorCount, dev) != hipSuccess) { grid = -1; return; }
        if (hipFuncSetAttribute((const void*)fwd_kernel, hipFuncAttributeMaxDynamicSharedMemorySize, LDS_BYTES) != hipSuccess) { fprintf(stderr, "kernel_launch: hipFuncSetAttribute failed\n"); grid = -1; return; }
        if (hipOccupancyMaxActiveBlocksPerMultiprocessor(&per_cu, (const void*)fwd_kernel, NWAVES * 64, LDS_BYTES) != hipSuccess || per_cu < 1) fprintf(stderr, "kernel_launch: note: occupancy query reports %d workgroups per CU\n", per_cu);
        (void)hipGetLastError();
        grid = cus;
        if (grid != 256) fprintf(stderr, "kernel_launch: note: %d CUs (tuned for 256)\n", grid);
    }
    if (grid < 0) return;
    if (hipMemsetAsync((char*)d_ws + WS_CTL, 0, CTL_ZERO_BYTES, stream) != hipSuccess) return;
    Args a{};
    for (int i = 0; i < 19; ++i) a.in[i] = (const float*)d_in[i];
    a.out = (float*)d_out; a.ws = (unsigned char*)d_ws; a.two = 2;
#if MK_N_LAUNCHES == 1
    a.ph_lo = 0; a.ph_hi = N_PHASES; a.li = 0;
    hipLaunchKernelGGL(fwd_kernel, dim3(grid), dim3(NWAVES * 64), LDS_BYTES, stream, a);
#ifdef MK_PREFIX_PROBE
    if (hipMemsetAsync((char*)d_ws + WS_CTL, 0, CTL_ZERO_BYTES, stream) != hipSuccess) return;
    a.ph_lo = 0; a.ph_hi = MK_PREFIX_PROBE; a.li = 1;
    hipLaunchKernelGGL(fwd_kernel, dim3(grid), dim3(NWAVES * 64), LDS_BYTES, stream, a);
#endif
#else
    for (int p = 0; p < N_PHASES; ++p) { a.ph_lo = p; a.ph_hi = p + 1; a.li = 0; hipLaunchKernelGGL(fwd_kernel, dim3(grid), dim3(NWAVES * 64), LDS_BYTES, stream, a); }
#endif
}
```
